# Optimizing an MI355X kernel written in HIP

```python
import jax, jax.numpy as jnp
from jax import lax
import numpy as np

D_MODEL = 1024
BATCH = 4
SEQ = 4096
DEPTH = 2
DEC_BATCH = 32
DEC_SEQ = 8
PAST_LEN = 8192
PAGE_SIZE = 128

D_FF = 2816
PLE_DIM = 256
RMS_EPS = 1e-6
RWKV_HEAD_DIM = 64
RWKV_HEADS = D_MODEL // RWKV_HEAD_DIM
DECAY_LORA = 64
ICLR_LORA = 64
GATE_LORA = 160
LNX_EPS = 64e-5
ATTN_HEAD_DIM = 64
ATTN_HEADS = D_MODEL // ATTN_HEAD_DIM
KV_HEADS = 4
Q_PER_KV = ATTN_HEADS // KV_HEADS
DILATION_GROUPS = ((128, 1), (512, 4), (2048, 16))
N_GROUPS = len(DILATION_GROUPS)
MAX_WINDOW = max(w for w, _ in DILATION_GROUPS)
Q_BLOCK = 128
REL_BUCKETS = 32
REL_MAX_DIST = 2048
NEG_INF = -1e30

kernel_name = 'yoco_rwkv7_dilated_window_step'


def rms_norm(x, g):
    xf = x.astype(jnp.float32)
    y = xf * lax.rsqrt(jnp.mean(xf * xf, axis=-1, keepdims=True) + RMS_EPS)
    return (y * g.astype(jnp.float32)).astype(x.dtype)


def swiglu(x, wi, wo):
    gate, up = jnp.split(x @ wi, 2, axis=-1)
    return (jax.nn.silu(gate) * up) @ wo


def t5_buckets(dist):
    d = np.asarray(dist, dtype=np.int64)
    max_exact = REL_BUCKETS // 2
    large = max_exact + (np.log(np.maximum(d, 1) / max_exact) / np.log(REL_MAX_DIST / max_exact)
                         * (REL_BUCKETS - max_exact)).astype(np.int32)
    large = np.minimum(large, REL_BUCKETS - 1)
    return np.where(d < max_exact, d, large).astype(np.int32)


def rwkv7_time_mix(xn, shift_prev, s0, mix, w_rkv, w_o, w0, w1, w2, a0, a1, a2, g1, g2,
                   k_k, k_a, r_k, lnx_w, lnx_b):
    f32 = jnp.float32
    B, T, D = xn.shape
    H, N = RWKV_HEADS, RWKV_HEAD_DIM
    x_prev = jnp.concatenate([shift_prev[:, None].astype(xn.dtype), xn[:, :-1]], axis=1)
    xx = x_prev - xn
    xr, xw, xk, xv, xa, xg = (xn + xx * mix[j] for j in range(6))
    r = (xr @ w_rkv[0]).astype(f32).reshape(B, T, H, N)
    k = (xk @ w_rkv[1]).astype(f32)
    v = (xv @ w_rkv[2]).astype(f32).reshape(B, T, H, N)
    w_log = -jax.nn.softplus(-(w0 + jnp.tanh(xw @ w1) @ w2).astype(f32)) - 0.5
    decay = jnp.exp(-jnp.exp(w_log)).reshape(B, T, H, N)
    a = jax.nn.sigmoid((a0 + (xa @ a1) @ a2).astype(f32))
    g = jax.nn.sigmoid(xg @ g1) @ g2
    kk = (k * k_k.astype(f32)).reshape(B, T, H, N)
    kk = kk / jnp.maximum(jnp.sqrt(jnp.sum(kk * kk, -1, keepdims=True)), 1e-12)
    k = (k * (1.0 + (a - 1.0) * k_a.astype(f32))).reshape(B, T, H, N)
    b = kk * a.reshape(B, T, H, N)

    def step(S, inp):
        r_t, w_t, k_t, v_t, kk_t, b_t = inp
        sa = jnp.einsum('bhij,bhj->bhi', S, -kk_t)
        S = S * w_t[:, :, None, :] + sa[..., None] * b_t[:, :, None, :] + v_t[..., None] * k_t[:, :, None, :]
        return S, jnp.einsum('bhij,bhj->bhi', S, r_t)

    xs = tuple(jnp.moveaxis(t, 1, 0) for t in (r, decay, k, v, kk, b))
    s_T, ys = lax.scan(step, s0.astype(f32), xs)
    y = jnp.moveaxis(ys, 0, 1)
    mu = jnp.mean(y, -1, keepdims=True)
    var = jnp.mean(jnp.square(y - mu), -1, keepdims=True)
    y = ((y - mu) * lax.rsqrt(var + LNX_EPS)).reshape(B, T, D) * lnx_w.astype(f32) + lnx_b.astype(f32)
    y = y + (jnp.sum(r * k * r_k.astype(f32), -1, keepdims=True) * v).reshape(B, T, D)
    return (y.astype(xn.dtype) * g) @ w_o, s_T, xn[:, -1]


def dilated_window_attention(q, k_ext, v_ext, valid_ext, rel_bias):
    f32 = jnp.float32
    B, T = q.shape[:2]
    qb = Q_BLOCK if T % Q_BLOCK == 0 else T
    n_blk = T // qb
    idxs, biases = [], []
    for g, (win, dil) in enumerate(DILATION_GROUPS):
        offs = dil * np.arange(win // dil + 1)
        idxs.append(MAX_WINDOW + np.arange(qb)[:, None] - offs[None, :])
        bias = rel_bias[t5_buckets(offs)][:, g * ATTN_HEADS:(g + 1) * ATTN_HEADS].astype(f32)
        biases.append(bias.T.reshape(KV_HEADS, Q_PER_KV, -1))

    def block(bi):
        start = bi * qb
        q_blk = lax.dynamic_slice_in_dim(q, start, qb, axis=1)
        k_blk = lax.dynamic_slice_in_dim(k_ext, start, MAX_WINDOW + qb, axis=1)
        v_blk = lax.dynamic_slice_in_dim(v_ext, start, MAX_WINDOW + qb, axis=1)
        m_blk = lax.dynamic_slice_in_dim(valid_ext, start, MAX_WINDOW + qb, axis=0)
        outs, lses = [], []
        for g in range(N_GROUPS):
            idx = idxs[g]
            kg, vg = k_blk[:, idx], v_blk[:, idx]
            logits = jnp.einsum('bqhrd,bqjhd->bqhrj', q_blk[:, :, g], kg, preferred_element_type=f32) + biases[g]
            logits = jnp.where(m_blk[idx][None, :, None, None, :], logits, NEG_INF)
            mx = jnp.max(logits, -1, keepdims=True)
            pr = jnp.exp(logits - mx)
            den = jnp.sum(pr, -1, keepdims=True)
            outs.append(jnp.einsum('bqhrj,bqjhd->bqhrd', pr, vg, preferred_element_type=f32) / den)
            lses.append(mx + jnp.log(den))
        wts = jax.nn.softmax(jnp.stack(lses, 0), axis=0)
        return sum(wts[g] * outs[g] for g in range(N_GROUPS))

    out = lax.map(block, jnp.arange(n_blk))
    return jnp.moveaxis(out, 0, 1).reshape(B, T, ATTN_HEADS * ATTN_HEAD_DIM)


def trunk(x, p, wkv0, shift0, kv_past, w):
    B, T, _ = x.shape
    n_a = DEPTH // 2
    h = x
    wkv_out, shift_out = [], []
    kv_rows = kv_ext = valid_ext = None
    for i in range(DEPTH):
        if i == n_a:
            kv_rows = (rms_norm(h, w['kv_norm']) @ w['w_kv']).reshape(B, T, 2, KV_HEADS, ATTN_HEAD_DIM)
            pad = MAX_WINDOW - kv_past.shape[1]
            kv_ext = jnp.concatenate([jnp.zeros((B, pad, 2, KV_HEADS, ATTN_HEAD_DIM), h.dtype),
                                      kv_past.astype(h.dtype), kv_rows], axis=1)
            valid_ext = jnp.asarray(np.arange(MAX_WINDOW + T) >= pad)
        h = h + 0.5 * swiglu(rms_norm(h, w['norm_w'][i, 0]), w['ffn1_wi'][i], w['ffn1_wo'][i])
        hn = rms_norm(h, w['norm_w'][i, 1])
        if i < n_a:
            mix, s_new, sh_new = rwkv7_time_mix(
                hn, shift0[i], wkv0[i], w['rwkv_mix'][i], w['rwkv_wrkv'][i], w['rwkv_wo'][i],
                w['rwkv_w0'][i], w['rwkv_w1'][i], w['rwkv_w2'][i], w['rwkv_a0'][i], w['rwkv_a1'][i],
                w['rwkv_a2'][i], w['rwkv_g1'][i], w['rwkv_g2'][i], w['rwkv_kk'][i], w['rwkv_ka'][i],
                w['rwkv_rk'][i], w['rwkv_lnx_w'][i], w['rwkv_lnx_b'][i])
            wkv_out.append(s_new.astype(x.dtype))
            shift_out.append(sh_new)
        else:
            j = i - n_a
            q = (hn @ w['attn_wq'][j]).reshape(B, T, N_GROUPS, KV_HEADS, Q_PER_KV, ATTN_HEAD_DIM) * (ATTN_HEAD_DIM ** -0.5)
            att = dilated_window_attention(q, kv_ext[:, :, 0], kv_ext[:, :, 1], valid_ext, w['rel_bias'])
            mix = att.astype(h.dtype) @ w['attn_wo'][j]
        h = h + mix
        h = h + 0.5 * swiglu(rms_norm(h, w['norm_w'][i, 2]), w['ffn2_wi'][i], w['ffn2_wo'][i])
        h = h + jax.nn.sigmoid(rms_norm(h, w['norm_w'][i, 3]) @ w['pe_gate'][i]) * (p[i] @ w['pe_proj'][i])
    return rms_norm(h, w['final_norm']), jnp.stack(wkv_out), jnp.stack(shift_out), kv_rows


def setup_inputs(seed: int = 0) -> dict:
    key = jax.random.key(seed)
    ks = iter(jax.random.split(key, 40))
    def nrm(shape, scale=1.0):
        return scale * jax.random.normal(next(ks), shape, jnp.float32)
    def unif(shape, lo, hi):
        return jax.random.uniform(next(ks), shape, jnp.float32, minval=lo, maxval=hi)
    n_a = DEPTH // 2
    n_b = DEPTH - n_a
    H, N = RWKV_HEADS, RWKV_HEAD_DIM
    kv_len = min(MAX_WINDOW, PAST_LEN)
    D = D_MODEL
    return {
        'x_prompt': nrm((BATCH, SEQ, D)),
        'x_sample': nrm((DEC_BATCH, DEC_SEQ, D)),
        'state_wkv': nrm((n_a, DEC_BATCH, H, N, N), 0.3),
        'state_shift': nrm((n_a, DEC_BATCH, D)),
        'cache_kv': nrm((DEC_BATCH, kv_len, 2, KV_HEADS, ATTN_HEAD_DIM)),
        'p_prompt': nrm((DEPTH, BATCH, SEQ, PLE_DIM)),
        'p_sample': nrm((DEPTH, DEC_BATCH, DEC_SEQ, PLE_DIM)),
        'norm_w': 1.0 + nrm((DEPTH, 4, D), 0.1),
        'ffn1_wi': nrm((DEPTH, D, 2 * D_FF), D ** -0.5),
        'ffn1_wo': nrm((DEPTH, D_FF, D), D_FF ** -0.5),
        'ffn2_wi': nrm((DEPTH, D, 2 * D_FF), D ** -0.5),
        'ffn2_wo': nrm((DEPTH, D_FF, D), D_FF ** -0.5),
        'pe_proj': nrm((DEPTH, PLE_DIM, D), PLE_DIM ** -0.5),
        'pe_gate': nrm((DEPTH, D, D), D ** -0.5),
        'rwkv_mix': unif((n_a, 6, D), 0.0, 1.0),
        'rwkv_wrkv': nrm((n_a, 3, D, D), D ** -0.5),
        'rwkv_wo': nrm((n_a, D, D), D ** -0.5),
        'rwkv_w0': unif((n_a, D), -4.0, 0.0),
        'rwkv_w1': nrm((n_a, D, DECAY_LORA), D ** -0.5),
        'rwkv_w2': nrm((n_a, DECAY_LORA, D), 0.1 * DECAY_LORA ** -0.5),
        'rwkv_a0': nrm((n_a, D), 0.1),
        'rwkv_a1': nrm((n_a, D, ICLR_LORA), D ** -0.5),
        'rwkv_a2': nrm((n_a, ICLR_LORA, D), 0.3 * ICLR_LORA ** -0.5),
        'rwkv_g1': nrm((n_a, D, GATE_LORA), D ** -0.5),
        'rwkv_g2': nrm((n_a, GATE_LORA, D), GATE_LORA ** -0.5),
        'rwkv_kk': 0.85 + nrm((n_a, D), 0.05),
        'rwkv_ka': 1.0 + nrm((n_a, D), 0.05),
        'rwkv_rk': nrm((n_a, H, N), 0.1),
        'rwkv_lnx_w': 1.0 + nrm((n_a, D), 0.1),
        'rwkv_lnx_b': nrm((n_a, D), 0.01),
        'attn_wq': nrm((n_b, D, N_GROUPS * ATTN_HEADS * ATTN_HEAD_DIM), D ** -0.5),
        'attn_wo': nrm((n_b, ATTN_HEADS * ATTN_HEAD_DIM, D), (ATTN_HEADS * ATTN_HEAD_DIM) ** -0.5),
        'kv_norm': 1.0 + nrm((D,), 0.1),
        'w_kv': nrm((D, 2 * KV_HEADS * ATTN_HEAD_DIM), D ** -0.5),
        'rel_bias': nrm((REL_BUCKETS, N_GROUPS * ATTN_HEADS), 0.5),
        'final_norm': 1.0 + nrm((D,), 0.1),
    }


def reference(x_prompt, x_sample, state_wkv, state_shift, cache_kv, p_prompt, p_sample,
              norm_w, ffn1_wi, ffn1_wo, ffn2_wi, ffn2_wo, pe_proj, pe_gate,
              rwkv_mix, rwkv_wrkv, rwkv_wo, rwkv_w0, rwkv_w1, rwkv_w2, rwkv_a0, rwkv_a1, rwkv_a2,
              rwkv_g1, rwkv_g2, rwkv_kk, rwkv_ka, rwkv_rk, rwkv_lnx_w, rwkv_lnx_b,
              attn_wq, attn_wo, kv_norm, w_kv, rel_bias, final_norm):
    w = dict(norm_w=norm_w, ffn1_wi=ffn1_wi, ffn1_wo=ffn1_wo, ffn2_wi=ffn2_wi, ffn2_wo=ffn2_wo,
             pe_proj=pe_proj, pe_gate=pe_gate, rwkv_mix=rwkv_mix, rwkv_wrkv=rwkv_wrkv, rwkv_wo=rwkv_wo,
             rwkv_w0=rwkv_w0, rwkv_w1=rwkv_w1, rwkv_w2=rwkv_w2, rwkv_a0=rwkv_a0, rwkv_a1=rwkv_a1,
             rwkv_a2=rwkv_a2, rwkv_g1=rwkv_g1, rwkv_g2=rwkv_g2, rwkv_kk=rwkv_kk, rwkv_ka=rwkv_ka,
             rwkv_rk=rwkv_rk, rwkv_lnx_w=rwkv_lnx_w, rwkv_lnx_b=rwkv_lnx_b, attn_wq=attn_wq,
             attn_wo=attn_wo, kv_norm=kv_norm, w_kv=w_kv, rel_bias=rel_bias, final_norm=final_norm)
    n_a = DEPTH // 2
    B, T, _ = x_prompt.shape
    wkv0 = jnp.zeros((n_a, B, RWKV_HEADS, RWKV_HEAD_DIM, RWKV_HEAD_DIM), jnp.float32)
    shift0 = jnp.zeros((n_a, B, D_MODEL), x_prompt.dtype)
    kv0 = jnp.zeros((B, 0, 2, KV_HEADS, ATTN_HEAD_DIM), x_prompt.dtype)
    y_prompt, wkv_prompt, shift_prompt, kv_rows_p = trunk(x_prompt, p_prompt, wkv0, shift0, kv0, w)
    kv_prompt = kv_rows_p[:, T - min(MAX_WINDOW, T):]
    y_sample, wkv_sample, shift_sample, kv_sample = trunk(x_sample, p_sample, state_wkv, state_shift, cache_kv, w)
    return (y_prompt, y_sample, wkv_prompt, shift_prompt, kv_prompt, wkv_sample, shift_sample, kv_sample)
```

```cpp
#include <hip/hip_runtime.h>
#include <cstdio>
#include <cstdint>

#define LAS __attribute__((address_space(3)))
typedef unsigned short bf16_t;
typedef short bf16x8 __attribute__((ext_vector_type(8)));
typedef float f32x4 __attribute__((ext_vector_type(4)));
typedef float f32x2 __attribute__((ext_vector_type(2)));
typedef float f32x16 __attribute__((ext_vector_type(16)));
typedef unsigned u32x4 __attribute__((ext_vector_type(4)));
typedef unsigned u32x2 __attribute__((ext_vector_type(2)));
typedef __bf16 bf16x2_t __attribute__((ext_vector_type(2)));

constexpr int D = 1024, FF = 2816, MP = 16384, MS = 256, M = MP + MS, TP = 4096, TS = 8;
constexpr int NTHREADS = 512;
constexpr float RMS_EPS = 1e-6f;
constexpr size_t O_YP = 0, O_YS = 16777216, O_WKVP = 17039360, O_SHP = 17301504, O_KVP = 17305600, O_WKVS = 21499904, O_SHS = 23597056, O_KVS = 23629824;
constexpr size_t SL = (size_t)M * 1024 * 2;
constexpr size_t W_F1I = 0;
constexpr size_t W_F2I = W_F1I + 2 * (size_t)5632 * 1024 * 2;
constexpr size_t W_F1O = W_F2I + 2 * (size_t)5632 * 1024 * 2;
constexpr size_t W_F2O = W_F1O + 2 * (size_t)1024 * 2816 * 2;
constexpr size_t W_PEG = W_F2O + 2 * (size_t)1024 * 2816 * 2;
constexpr size_t W_PEP = W_PEG + 2 * (size_t)1024 * 1024 * 2;
constexpr size_t W_RKV = W_PEP + 2 * (size_t)1024 * 256 * 2;
constexpr size_t W_L1 = W_RKV + (size_t)3072 * 1024 * 2;
constexpr size_t W_L2W = W_L1 + (size_t)768 * 1024 * 2;
constexpr size_t W_L2A = W_L2W + (size_t)1024 * 128 * 2;
constexpr size_t W_L2G = W_L2A + (size_t)1024 * 128 * 2;
constexpr size_t W_RWO = W_L2G + (size_t)1024 * 256 * 2;
constexpr size_t W_Q = W_RWO + (size_t)1024 * 1024 * 2;
constexpr size_t W_KV = W_Q + (size_t)3072 * 1024 * 2;
constexpr size_t W_AO = W_KV + (size_t)512 * 1024 * 2;
constexpr size_t W_END = W_AO + (size_t)1024 * 1024 * 2;
constexpr size_t O_HB0 = (W_END + 4095) & ~(size_t)4095;
constexpr size_t O_HB1 = O_HB0 + SL;
constexpr size_t O_SSQ0 = O_HB1 + SL;
constexpr size_t O_SSQ1 = O_SSQ0 + (size_t)M * 16 * 4;
constexpr size_t O_PB = O_SSQ1 + (size_t)M * 16 * 4;
constexpr size_t O_R2 = O_PB + 2 * (size_t)M * 256 * 2;
constexpr size_t R2_BYTES = (size_t)128 << 20;
constexpr size_t O_R4 = O_R2 + R2_BYTES;
constexpr size_t O_CTL = O_R4 + 6 * SL;
constexpr size_t CTL_BYTES = 65536;
constexpr size_t O_PAR = O_CTL + 32768;
constexpr size_t WS_END = O_CTL + CTL_BYTES;
constexpr size_t O_ACT = O_R2;
constexpr size_t O_RKVB = O_R2;
constexpr size_t O_MW = O_R2 + (size_t)M * 3072 * 2;
constexpr size_t O_MA = O_MW + (size_t)M * 128 * 2;
constexpr size_t O_MG = O_MA + (size_t)M * 128 * 2;
constexpr size_t O_YG = O_R2;
static_assert(O_MG + (size_t)M * 256 * 2 <= O_R2 + R2_BYTES, "R2");
constexpr size_t O_WL = O_R4, O_AL = O_R4 + SL, O_GG = O_R4 + 2 * SL, O_Y = O_R4 + 3 * SL, O_BON = O_R4 + 4 * SL, O_PP = O_R4 + 5 * SL;
constexpr size_t O_Q = O_R4, O_ATT = O_R4 + 3 * SL, O_KB = O_R4 + 4 * SL, O_VT = O_KB + (size_t)MP * 256 * 2;
constexpr size_t O_VB = O_R2 + ((size_t)96 << 20);
static_assert(O_VB >= O_ACT + (size_t)M * FF * 2 && O_VB + (size_t)MP * 256 * 2 <= O_R2 + R2_BYTES, "VB");
constexpr size_t VT_COPY = (size_t)MP * 256;
constexpr size_t O_KT = O_R2 + ((size_t)104 << 20);
static_assert(O_KT >= O_VB + (size_t)MP * 256 * 2 && O_KT + 3 * VT_COPY * 2 <= O_R2 + R2_BYTES, "KT");
static_assert(O_VT + 3 * VT_COPY * 2 <= O_R4 + 5 * SL, "R4 slot 4");

struct Params { const float* in[36]; float* out; unsigned char* ws; };
typedef const Params __attribute__((address_space(4)))* KPtr;
__device__ __forceinline__ int tid_fresh() { int t = threadIdx.x; asm volatile("" : "+v"(t)); return t; }
__device__ __forceinline__ int bid_fresh() { int t = blockIdx.x; asm volatile("" : "+s"(t)); return t; }
__device__ __forceinline__ int gdim_fresh() { int t = gridDim.x; asm volatile("" : "+s"(t)); return t; }
__device__ __forceinline__ KPtr kp_fresh() { KPtr p = (KPtr)__builtin_amdgcn_kernarg_segment_ptr(); asm volatile("" : "+s"(p)); return p; }

__device__ __forceinline__ unsigned pk2(float lo, float hi) { f32x2 v = {lo, hi}; bf16x2_t b = __builtin_convertvector(v, bf16x2_t); return __builtin_bit_cast(unsigned, b); }
__device__ __forceinline__ float bf2f(unsigned short h) { return __builtin_bit_cast(float, (unsigned)h << 16); }
__device__ __forceinline__ float bflo(unsigned w) { return __builtin_bit_cast(float, w << 16); }
__device__ __forceinline__ float bfhi(unsigned w) { return __builtin_bit_cast(float, w & 0xffff0000u); }
template <int CTRL> __device__ __forceinline__ float dpp_mov(float x) { return __builtin_bit_cast(float, __builtin_amdgcn_update_dpp(0, __builtin_bit_cast(int, x), CTRL, 0xF, 0xF, true)); }
__device__ __forceinline__ float row_sum16(float x) {
    x += dpp_mov<0x128>(x); x += dpp_mov<0x124>(x); x += dpp_mov<0x122>(x); x += dpp_mov<0x121>(x); return x;
}
__device__ __forceinline__ float wave_sum(float v) {
#pragma unroll
    for (int o = 1; o < 64; o <<= 1) v += __shfl_xor(v, o);
    return v;
}
__device__ __forceinline__ float rstd_of(const float* ssq, int row) {
    const f32x4* p = (const f32x4*)(ssq + (size_t)row * 16);
    const f32x4 a = p[0], b = p[1], c = p[2], d = p[3];
    const float s = ((a.x + a.y) + (a.z + a.w)) + ((b.x + b.y) + (b.z + b.w)) + ((c.x + c.y) + (c.z + c.w)) + ((d.x + d.y) + (d.z + d.w));
    return __builtin_amdgcn_rsqf(s * (1.0f / 1024.0f) + RMS_EPS);
}
struct F8 { float v[8]; };
__device__ __forceinline__ F8 unpack8(u32x4 w) { F8 r; r.v[0] = bflo(w.x); r.v[1] = bfhi(w.x); r.v[2] = bflo(w.y); r.v[3] = bfhi(w.y); r.v[4] = bflo(w.z); r.v[5] = bfhi(w.z); r.v[6] = bflo(w.w); r.v[7] = bfhi(w.w); return r; }
__device__ __forceinline__ u32x4 pack8(const F8& f) { u32x4 w; w.x = pk2(f.v[0], f.v[1]); w.y = pk2(f.v[2], f.v[3]); w.z = pk2(f.v[4], f.v[5]); w.w = pk2(f.v[6], f.v[7]); return w; }
__device__ __forceinline__ F8 load8f(const float* p) { const f32x4 a = *(const f32x4*)p, b = *(const f32x4*)(p + 4); F8 r; r.v[0] = a.x; r.v[1] = a.y; r.v[2] = a.z; r.v[3] = a.w; r.v[4] = b.x; r.v[5] = b.y; r.v[6] = b.z; r.v[7] = b.w; return r; }
__device__ __forceinline__ float row_sum8(float x) {
    x += dpp_mov<0xB1>(x); x += dpp_mov<0x4E>(x); x += dpp_mov<0x141>(x); return x;
}
__device__ __forceinline__ float sigmoidf_(float x) { return __builtin_amdgcn_rcpf(1.0f + __expf(-x)); }

constexpr int LDS_BYTES_ALL = 147456, LDS_CTL_OFF = LDS_BYTES_ALL - 2048;
constexpr int BM = 256, BK = 64, HALF = 128, HTB = HALF * BK * 2, STAGE_BYTES = 8 * HTB, NXCD = 8, WGM = 8;
__host__ __device__ __forceinline__ int lds_byte(int r, int c) { const int st = (r >> 4) * 2 + (c >> 5), rr = r & 15, cc = c & 31, ob = rr * 64 + cc * 2; return st * 1024 + (ob ^ (((ob >> 9) & 1) << 5)); }
__host__ __device__ __forceinline__ void stage_rc(int b, int& R, int& C) { const int st = b / 1024, sb = b % 1024, swz = sb ^ (((sb >> 9) & 1) << 5); R = (st >> 1) * 16 + swz / 64; C = (st & 1) * 32 + (swz % 64) / 2; }

enum { EPI_SWIGLU = 0, EPI_RESID = 1, EPI_PE = 2, EPI_BF16 = 3, EPI_KV = 4 };
struct Unit { const char* A; const char* B; int pitchA, pitchB, nt, si, pm, pn, wait, eph; };
struct Epi { int epi; void* o0; const float* ssq_in; float* ssq_out; const bf16_t* pbuf; float scale; int opitch, ocol0, ncols, act; };

enum { PH_PRO = 0, PH_F1I0, PH_F1O0, PH_MIX, PH_RKV, PH_L2, PH_SCAN, PH_POST, PH_RWO, PH_F2I0, PH_F2O0, PH_PE0,
       PH_F1I1, PH_F1O1, PH_QKV, PH_ATTN, PH_AO, PH_F2I1, PH_F2O1, PH_PE1, PH_FINAL, NPH };

__device__ __forceinline__ bool get_gemm(unsigned char* ws, int ph, int si, Unit& u, int& nN) {
    size_t a = 0, b = 0; int pA = 2048, pB = 2048, nt = 16; nN = 4;
    switch (ph) {
    case PH_F1I0: case PH_F2I0: case PH_F1I1: case PH_F2I1: {
        if (si > 0) return false;
        const int l = (ph == PH_F1I1 || ph == PH_F2I1) ? 1 : 0; const bool f2 = (ph == PH_F2I0 || ph == PH_F2I1);
        a = O_HB0; b = (f2 ? W_F2I : W_F1I) + (size_t)l * 5632 * 1024 * 2; nN = 22; break; }
    case PH_F1O0: case PH_F1O1: {
        if (si > 0) return false;
        a = O_ACT; b = W_F1O + (size_t)(ph == PH_F1O1 ? 1 : 0) * 1024 * 2816 * 2; pA = 5632; pB = 5632; nt = 44; break; }
    case PH_F2O0: case PH_F2O1: {
        const int l = (ph == PH_F2O1) ? 1 : 0;
        if (si == 0) { a = O_ACT; b = W_F2O + (size_t)l * 1024 * 2816 * 2; pA = 5632; pB = 5632; nt = 44; }
        else if (si == 1) { a = O_PB + (size_t)l * M * 256 * 2; b = W_PEP + (size_t)l * 1024 * 256 * 2; pA = 512; pB = 512; nt = 4; }
        else return false;
        break; }
    case PH_RKV: {
        if (si < 3) { const int xi = (si == 0) ? 0 : (si == 1 ? 2 : 3); a = O_R4 + (size_t)xi * SL; b = W_RKV + (size_t)si * 1024 * 1024 * 2; }
        else if (si < 6) { const int j = si - 3; const int xi = (j == 0) ? 1 : (j == 1 ? 4 : 5); a = O_R4 + (size_t)xi * SL; b = W_L1 + (size_t)j * 256 * 1024 * 2; nN = 1; }
        else return false;
        break; }
    case PH_L2: {
        if (si == 0) { a = O_MG; b = W_L2G; pA = 512; pB = 512; nt = 4; }
        else if (si == 1) { a = O_MW; b = W_L2W; pA = 256; pB = 256; nt = 2; }
        else if (si == 2) { a = O_MA; b = W_L2A; pA = 256; pB = 256; nt = 2; }
        else return false;
        break; }
    case PH_RWO: if (si > 0) return false; a = O_YG; b = W_RWO; break;
    case PH_AO: if (si > 0) return false; a = O_ATT; b = W_AO; break;
    case PH_PE0: case PH_PE1: if (si > 0) return false; a = O_HB1; b = W_PEG + (size_t)(ph == PH_PE1 ? 1 : 0) * 1024 * 1024 * 2; break;
    case PH_QKV: {
        if (si == 0) { a = O_HB1; b = W_Q; nN = 12; }
        else if (si == 1) { a = O_HB0; b = W_KV; nN = 2; }
        else return false;
        break; }
    default: return false;
    }
    u.A = (const char*)(ws + a); u.B = (const char*)(ws + b); u.pitchA = pA; u.pitchB = pB; u.nt = nt; u.si = si; u.wait = 0; u.eph = ph; return true;
}
__device__ __forceinline__ void get_epi(unsigned char* ws, int ph, int si, Epi& s) {
    s.epi = EPI_BF16; s.o0 = nullptr; s.ssq_in = nullptr; s.ssq_out = nullptr; s.pbuf = nullptr; s.scale = 1.f; s.opitch = 1024; s.ocol0 = 0; s.ncols = 1024; s.act = 0;
    const float* ssq0 = (const float*)(ws + O_SSQ0); const float* ssq1 = (const float*)(ws + O_SSQ1);
    switch (ph) {
    case PH_F1I0: case PH_F2I0: case PH_F1I1: case PH_F2I1: s.epi = EPI_SWIGLU; s.o0 = ws + O_ACT; s.ssq_in = ssq0; break;
    case PH_F1O0: case PH_F1O1: s.epi = EPI_RESID; s.scale = 0.5f; s.o0 = ws + O_HB1; s.ssq_out = (float*)(ws + O_SSQ1); break;
    case PH_F2O0: case PH_F2O1:
        if (si == 0) { s.epi = EPI_RESID; s.scale = 0.5f; s.o0 = ws + O_HB1; s.ssq_out = (float*)(ws + O_SSQ1); }
        else { s.o0 = ws + O_PP; }
        break;
    case PH_RKV:
        if (si < 3) { s.o0 = ws + O_RKVB; s.opitch = 3072; s.ocol0 = si * 1024; }
        else { const int j = si - 3; s.o0 = ws + (j == 0 ? O_MW : (j == 1 ? O_MA : O_MG)); s.opitch = (j == 2) ? 256 : 128; s.ncols = s.opitch; s.act = (j == 0) ? 1 : (j == 1 ? 0 : 2); }
        break;
    case PH_L2: s.o0 = ws + (si == 0 ? O_GG : (si == 1 ? O_WL : O_AL)); s.act = (si == 0) ? 0 : (si == 1 ? 3 : 4); break;
    case PH_RWO: case PH_AO: s.epi = EPI_RESID; s.o0 = ws + O_HB0; s.ssq_out = (float*)(ws + O_SSQ0); break;
    case PH_PE0: case PH_PE1: s.epi = EPI_PE; s.o0 = ws + O_HB0; s.ssq_in = ssq1; s.ssq_out = (float*)(ws + O_SSQ0); s.pbuf = (const bf16_t*)(ws + O_PP); break;
    case PH_QKV:
        if (si == 0) { s.o0 = ws + O_Q; s.opitch = 3072; s.ncols = 3072; s.ssq_in = ssq1; }
        else { s.epi = EPI_KV; s.ssq_in = ssq0; }
        break;
    default: break;
    }
}

__device__ __forceinline__ void decode_tile(int L, int nM, int nN, int& pm, int& pn) {
    const int nwg = nM * nN;
    int wgid = L; { const int q = nwg / NXCD, r = nwg % NXCD, xcd = wgid % NXCD, off = wgid / NXCD; wgid = (xcd < r ? xcd * (q + 1) : r * (q + 1) + (xcd - r) * q) + off; }
    const int nig = WGM * nN, gid = wgid / nig, fm = gid * WGM, gsz = (nM - fm) < WGM ? (nM - fm) : WGM;
    pm = fm + ((wgid % nig) % gsz); pn = (wgid % nig) / gsz;
}
constexpr int CW_DEP = 4096;
__device__ __forceinline__ bool is_wi(int ph) { return ph == PH_F1I0 || ph == PH_F2I0 || ph == PH_F1I1 || ph == PH_F2I1; }
__device__ __forceinline__ bool is_wo(int ph) { return ph == PH_F1O0 || ph == PH_F2O0 || ph == PH_F1O1 || ph == PH_F2O1; }
__device__ __forceinline__ bool next_unit(unsigned char* ws, int ph, int i, int G, int c, Unit& u, int pass2) {
    int nN;
    if (pass2) {
        if (G == 256 && ph == PH_F2I1 && c >= 252 && i == 0) { get_gemm(ws, PH_PE1, 0, u, nN); u.pm = 64; u.pn = c - 252; u.wait = 8; u.eph = PH_PE1; return true; }
        return false;
    }
    if (G == 256 && is_wi(ph)) {
        const int pre = (ph == PH_F2I0) ? PH_RWO : (ph == PH_F1I1 ? PH_PE0 : (ph == PH_F2I1 ? PH_AO : -1));
        int L; int wt = 0;
        if (c >= 252) {
            if (i < 3) L = i * 256 + c;
            else if (i == 3) { get_gemm(ws, ph + 1, 0, u, nN); u.pm = 64; u.pn = c - 252; u.wait = 1; u.eph = ph + 1; return true; }
            else return false;
        } else if (pre >= 0 && c >= 248) {
            if (i == 0) { get_gemm(ws, pre, 0, u, nN); u.pm = 64; u.pn = c - 248; u.eph = pre; return true; }
            L = (i - 1) * 256 + c;
            if (L >= 1430) return false;
        } else {
            L = i * 256 + c;
            if (pre >= 0 && c < 22) L = (i + 1) * 256 + c;
            else if (pre >= 0 && c >= 160 && c < 182) { if (i == 2) { L = c - 160; wt = 2; } else if (i > 2) L = (i - 1) * 256 + c; }
            if (L >= 1430) {
                if (i == 5 && c >= 150 && c < 158) { const int k = c - 150; L = (3 + (k >> 2)) * 256 + 252 + (k & 3); }
                else if (pre >= 0 && (i == 5 || i == 6) && c >= 158 && c < 248 && !(c >= 160 && c < 182)) {
                    const int e = c < 160 ? c - 158 : c - 180, k = e * 2 + (i - 5);
                    if (k >= 130) return false;
                    const int fo = (ph == PH_F1I1) ? PH_F2O1 : (ph == PH_F2I1 ? PH_F2O1 : PH_F2O0);
                    const int idx = (ph == PH_F2I1) ? 126 + k : (ph == PH_F1I1 && k >= 126 ? k + 130 : k);
                    get_gemm(ws, fo, 1, u, nN); u.eph = fo; u.pm = idx >> 2; u.pn = idx & 3; return true;
                } else return false;
            }
        }
        get_gemm(ws, ph, 0, u, nN);
        if (L < 22) { u.pm = 64; u.pn = L; u.wait = wt; } else decode_tile(L - 22, 64, 22, u.pm, u.pn);
        return true;
    }
    int L = i * G + c;
    for (int si = 0; si < 6; ++si) {
        if (!get_gemm(ws, ph, si, u, nN)) return false;
        const int nM = (G == 256 && (is_wo(ph) || ph == PH_RWO || ph == PH_PE0 || ph == PH_PE1 || ph == PH_AO) && si == 0) ? 64 : M / BM;
        if (G == 256 && (ph == PH_F2O0 || ph == PH_F2O1) && si == 1) {
            const int first = (ph == PH_F2O0) ? 130 : 260, cnt = 260 - first;
            if (L < cnt) { const int idx = first + L; u.pm = idx >> 2; u.pn = idx & 3; return true; }
            L -= cnt; continue;
        }
        const int nwg = nM * nN;
        if (L < nwg) { decode_tile(L, nM, nN, u.pm, u.pn); return true; }
        L -= nwg;
    }
    return false;
}

template <int ACT>
__device__ __forceinline__ void epi_act(unsigned char* ws, f32x4 (&acc)[2][2][4][2], const Epi& s, const Unit& u, bf16_t* ob, int row0, int wc, int fq) {
#pragma unroll
    for (int bj = 0; bj < 2; ++bj) {
        const int lc = u.pn * BM + bj * HALF + wc * 32 + fq * 8;
        if (lc >= s.ncols) continue;
        float pa_[8], pb_[8];
#pragma unroll
        for (int q8 = 0; q8 < 8; ++q8) { pa_[q8] = 0.f; pb_[q8] = 0.f; }
        if (ACT >= 3) {
            const float* par = (const float*)(ws + O_PAR) + (ACT == 3 ? 0 : 2048) + lc;
            const f32x4 x0 = *(const f32x4*)par, x1 = *(const f32x4*)(par + 4);
            pa_[0] = x0.x; pa_[1] = x0.y; pa_[2] = x0.z; pa_[3] = x0.w; pa_[4] = x1.x; pa_[5] = x1.y; pa_[6] = x1.z; pa_[7] = x1.w;
            if (ACT == 3) { const f32x4 y0 = *(const f32x4*)(par + 1024), y1 = *(const f32x4*)(par + 1028);
                pb_[0] = y0.x; pb_[1] = y0.y; pb_[2] = y0.z; pb_[3] = y0.w; pb_[4] = y1.x; pb_[5] = y1.y; pb_[6] = y1.z; pb_[7] = y1.w; }
        }
#pragma unroll
        for (int ai = 0; ai < 2; ++ai)
#pragma unroll
            for (int m = 0; m < 4; ++m) {
                const int row = row0 + ai * HALF + m * 16;
                float o[8];
#pragma unroll
                for (int n = 0; n < 2; ++n)
#pragma unroll
                    for (int e = 0; e < 4; ++e) {
                        float v = acc[ai][bj][m][n][e];
                        if (ACT == 1) { const float t = __expf(2.f * v); v = 1.f - 2.f * __builtin_amdgcn_rcpf(t + 1.f); }
                        else if (ACT == 2) v = sigmoidf_(v);
                        else if (ACT == 3) v = sigmoidf_(v + pa_[n * 4 + e]) - pb_[n * 4 + e];
                        else v = sigmoidf_(v + pa_[n * 4 + e]);
                        o[n * 4 + e] = v;
                    }
                u32x4 w; w.x = pk2(o[0], o[1]); w.y = pk2(o[2], o[3]); w.z = pk2(o[4], o[5]); w.w = pk2(o[6], o[7]);
                *(u32x4*)(ob + (size_t)row * s.opitch + s.ocol0 + lc) = w;
            }
    }
}

template <bool PE>
__device__ __forceinline__ void epi_resid(unsigned char* ws, f32x4 (&acc)[2][2][4][2], const Epi& s, const Unit& u, const LAS float* rtab, int row0, int lrow0, int wc, int fq, float zs) {
    bf16_t* hb = (bf16_t*)s.o0; const bf16_t* hin = (const bf16_t*)(ws + (hb == (bf16_t*)(ws + O_HB1) ? O_HB0 : O_HB1));
    const int colb = u.pn * BM + wc * 32 + fq * 8;
    const float sc = s.scale * zs;
    u32x4 hn[2], pn_[2];
#pragma unroll
    for (int bj = 0; bj < 2; ++bj) {
        const size_t off = (size_t)row0 * D + colb + bj * HALF;
        hn[bj] = *(const u32x4*)(hin + off); pn_[bj] = (u32x4){0u, 0u, 0u, 0u};
        if (PE) pn_[bj] = *(const u32x4*)(s.pbuf + off);
    }
#pragma unroll
    for (int g = 0; g < 8; ++g) {
        const int ai = g >> 2, m = g & 3;
        const int row = row0 + ai * HALF + m * 16;
        u32x4 hc[2], pc[2];
#pragma unroll
        for (int bj = 0; bj < 2; ++bj) { hc[bj] = hn[bj]; pc[bj] = pn_[bj]; }
        if (g < 7) {
            const int rown = row0 + ((g + 1) >> 2) * HALF + ((g + 1) & 3) * 16;
#pragma unroll
            for (int bj = 0; bj < 2; ++bj) {
                const size_t off = (size_t)rown * D + colb + bj * HALF;
                hn[bj] = *(const u32x4*)(hin + off);
                if (PE) pn_[bj] = *(const u32x4*)(s.pbuf + off);
            }
        }
        float rs = 1.f; if (PE) rs = rtab[lrow0 + ai * HALF + m * 16];
        float sq = 0.f;
#pragma unroll
        for (int bj = 0; bj < 2; ++bj) {
            const size_t off = (size_t)row * D + colb + bj * HALF;
            const unsigned hw[4] = {hc[bj].x, hc[bj].y, hc[bj].z, hc[bj].w}, pw[4] = {pc[bj].x, pc[bj].y, pc[bj].z, pc[bj].w};
            unsigned ow[4];
#pragma unroll
            for (int n = 0; n < 2; ++n) {
                const f32x4 a = acc[ai][bj][m][n];
                f32x4 h = (f32x4){bflo(hw[2 * n]), bfhi(hw[2 * n]), bflo(hw[2 * n + 1]), bfhi(hw[2 * n + 1])};
                if (PE) {
                    h.x += zs * sigmoidf_(a.x * rs) * bflo(pw[2 * n]); h.y += zs * sigmoidf_(a.y * rs) * bfhi(pw[2 * n]);
                    h.z += zs * sigmoidf_(a.z * rs) * bflo(pw[2 * n + 1]); h.w += zs * sigmoidf_(a.w * rs) * bfhi(pw[2 * n + 1]);
                } else { h = h + a * sc; }
                ow[2 * n] = pk2(h.x, h.y); ow[2 * n + 1] = pk2(h.z, h.w);
                sq += (h.x * h.x + h.y * h.y) + (h.z * h.z + h.w * h.w);
            }
            *(u32x4*)(hb + off) = (u32x4){ow[0], ow[1], ow[2], ow[3]};
        }
        sq += __shfl_xor(sq, 16); sq += __shfl_xor(sq, 32);
        if (fq == 0) s.ssq_out[(size_t)row * 16 + u.pn * 4 + wc] = sq;
    }
}

__device__ __forceinline__ void epilogue(unsigned char* ws, float* outp, int ph, f32x4 (&acc)[2][2][4][2], const Unit& u, int wr, int wc, int fr, int fq, LAS unsigned char* lds, float zs) {
    Epi s; get_epi(ws, u.eph, u.si, s);
    const LAS float* rtab = (const LAS float*)(lds + LDS_CTL_OFF + 1024);
    if (s.ssq_in) {
        const int t = threadIdx.x;
        if (t < 256) ((LAS float*)(lds + LDS_CTL_OFF + 1024))[t] = rstd_of(s.ssq_in, u.pm * BM + t);
        __syncthreads();
    }
    const int lrow0 = wr * 64 + fr;
    const int row0 = u.pm * BM + wr * 64 + fr;
    if (s.epi == EPI_SWIGLU) {
        bf16_t* act = (bf16_t*)s.o0;
        const int col = u.pn * 128 + wc * 32 + fq * 8;
#pragma unroll
        for (int ai = 0; ai < 2; ++ai)
#pragma unroll
            for (int m = 0; m < 4; ++m) {
                const int row = row0 + ai * HALF + m * 16;
                const float rs = rtab[lrow0 + ai * HALF + m * 16];
                float o[8];
#pragma unroll
                for (int n = 0; n < 2; ++n)
#pragma unroll
                    for (int e = 0; e < 4; ++e) { const float g = acc[ai][0][m][n][e] * rs, up = acc[ai][1][m][n][e] * rs; o[n * 4 + e] = g * sigmoidf_(g) * up; }
                u32x4 w; w.x = pk2(o[0], o[1]); w.y = pk2(o[2], o[3]); w.z = pk2(o[4], o[5]); w.w = pk2(o[6], o[7]);
                if (u.pm == 64) {
                    unsigned long long* p8 = (unsigned long long*)(act + (size_t)row * FF + col);
                    __hip_atomic_store(p8, ((unsigned long long)w.y << 32) | w.x, __ATOMIC_RELAXED, __HIP_MEMORY_SCOPE_AGENT);
                    __hip_atomic_store(p8 + 1, ((unsigned long long)w.w << 32) | w.z, __ATOMIC_RELAXED, __HIP_MEMORY_SCOPE_AGENT);
                } else *(u32x4*)(act + (size_t)row * FF + col) = w;
            }
        if (u.pm == 64) {
            asm volatile("s_waitcnt vmcnt(0)" ::: "memory");
            __syncthreads();
            if (threadIdx.x == 0) __hip_atomic_fetch_add((unsigned*)(ws + O_CTL) + CW_DEP + ph * 64, 1u, __ATOMIC_RELAXED, __HIP_MEMORY_SCOPE_AGENT);
        }
    } else if (s.epi == EPI_RESID || s.epi == EPI_PE) {
        if (s.epi == EPI_PE) epi_resid<true>(ws, acc, s, u, rtab, row0, lrow0, wc, fq, zs);
        else epi_resid<false>(ws, acc, s, u, rtab, row0, lrow0, wc, fq, zs);
        if (u.eph != ph && (u.wait == 0 || (u.wait == 1 && ph == PH_F2I1))) {
            asm volatile("s_waitcnt vmcnt(0)" ::: "memory");
            __syncthreads();
            if (threadIdx.x == 0) {
                __builtin_amdgcn_fence(__ATOMIC_RELEASE, "agent");
                asm volatile("s_waitcnt vmcnt(0)" ::: "memory");
                __hip_atomic_fetch_add((unsigned*)(ws + O_CTL) + CW_DEP + ((u.wait == 1 ? 20 : 32) + ph) * 64, 1u, __ATOMIC_RELAXED, __HIP_MEMORY_SCOPE_AGENT);
            }
        }
    } else if (s.epi == EPI_BF16) {
        bf16_t* ob = (bf16_t*)s.o0;
        if (s.act == 0) {
#pragma unroll
            for (int ai = 0; ai < 2; ++ai)
#pragma unroll
                for (int m = 0; m < 4; ++m) {
                    const int row = row0 + ai * HALF + m * 16;
                    float rs = 1.f; if (s.ssq_in) rs = rtab[lrow0 + ai * HALF + m * 16];
#pragma unroll
                    for (int bj = 0; bj < 2; ++bj) {
                        const int lc = u.pn * BM + bj * HALF + wc * 32 + fq * 8;
                        const f32x4 v0 = acc[ai][bj][m][0] * rs, v1 = acc[ai][bj][m][1] * rs;
                        if (lc < s.ncols) {
                            u32x4 w; w.x = pk2(v0.x, v0.y); w.y = pk2(v0.z, v0.w); w.z = pk2(v1.x, v1.y); w.w = pk2(v1.z, v1.w);
                            *(u32x4*)(ob + (size_t)row * s.opitch + s.ocol0 + lc) = w;
                        }
                    }
                }
        } else if (s.act == 1) epi_act<1>(ws, acc, s, u, ob, row0, wc, fq);
        else if (s.act == 2) epi_act<2>(ws, acc, s, u, ob, row0, wc, fq);
        else if (s.act == 3) epi_act<3>(ws, acc, s, u, ob, row0, wc, fq);
        else epi_act<4>(ws, acc, s, u, ob, row0, wc, fq);
    } else {
        bf16_t* kb = (bf16_t*)(ws + O_KB); bf16_t* vt = (bf16_t*)(ws + O_VT);
#pragma unroll
        for (int ai = 0; ai < 2; ++ai)
#pragma unroll
            for (int m = 0; m < 4; ++m) {
                const int row = row0 + ai * HALF + m * 16;
                const float rs = rtab[lrow0 + ai * HALF + m * 16];
                const bool isP = row < MP; const int b = row >> 12, t = row & 4095;
                float* fo = nullptr;
                if (isP) { if (t >= 2048) fo = outp + O_KVP + ((size_t)(b * 2048 + (t - 2048)) * 512) + u.pn * 256; }
                else fo = outp + O_KVS + (size_t)(row - MP) * 512 + u.pn * 256;
#pragma unroll
                for (int bj = 0; bj < 2; ++bj) {
                    const int c = bj * HALF + wc * 32 + fq * 8;
                    const f32x4 v0 = acc[ai][bj][m][0] * rs, v1 = acc[ai][bj][m][1] * rs;
                    if (fo) { *(f32x4*)(fo + c) = v0; *(f32x4*)(fo + c + 4) = v1; }
                    if (isP) {
                        u32x4 w; w.x = pk2(v0.x, v0.y); w.y = pk2(v0.z, v0.w); w.z = pk2(v1.x, v1.y); w.w = pk2(v1.z, v1.w);
                        *(u32x4*)((u.pn == 0 ? kb : (bf16_t*)(ws + O_VB)) + (size_t)row * 256 + c) = w;
                    }
                }
            }
    }
}

__device__ __forceinline__ void gemm_phase(unsigned char* ws, float* outp, LAS unsigned char* lds, int ph, int dry, int pass2) {
    const int tid = tid_fresh(), wid = __builtin_amdgcn_readfirstlane(tid >> 6), lane = tid & 63, wr = wid >> 2, wc = wid & 3, fr = lane & 15, fq = lane >> 4;
    const int G = gdim_fresh(), cidx = bid_fresh();
    int R0, C0; stage_rc(tid * 16, R0, C0);
    const unsigned ldsw = (unsigned)wid * 1024u;
    const int aoff = lds_byte(wr * 64 + fr, fq * 8), boff = lds_byte(wc * 32 + fr, fq * 8);
    const size_t kstep = (size_t)(BK * 2);
#define PG8_SA(b, h) (((b) * 2 + (h)) * HTB)
#define PG8_SB(b, h) ((4 + (b) * 2 + (h)) * HTB)
#define PG8_STAGE(bufoff, gbase, voff, p64) do { \
        __builtin_amdgcn_global_load_lds((const unsigned*)((const char*)(gbase) + (voff)), (LAS unsigned*)(lds + (bufoff) + ldsw), 16, 0, 0); \
        __builtin_amdgcn_global_load_lds((const unsigned*)((const char*)(gbase) + (voff) + (p64)), (LAS unsigned*)(lds + (bufoff) + ldsw + 8192), 16, 0, 0); } while (0)
#define PG8_LDA(dst, b, h) do { _Pragma("unroll") for (int m = 0; m < 4; ++m) _Pragma("unroll") for (int k = 0; k < 2; ++k) dst[m][k] = *(const LAS bf16x8*)(lds + PG8_SA(b, h) + aoff + m * 2048 + k * 1024); } while (0)
#define PG8_LDB(dst, b, h) do { _Pragma("unroll") for (int n = 0; n < 2; ++n) _Pragma("unroll") for (int k = 0; k < 2; ++k) dst[n][k] = *(const LAS bf16x8*)(lds + PG8_SB(b, h) + boff + n * 2048 + k * 1024); } while (0)
#define PG8_MMA(ai, bj, At, Bt) do { __builtin_amdgcn_s_setprio(1); _Pragma("unroll") for (int m = 0; m < 4; ++m) _Pragma("unroll") for (int n = 0; n < 2; ++n) _Pragma("unroll") for (int k = 0; k < 2; ++k) \
        acc[ai][bj][m][n] = __builtin_amdgcn_mfma_f32_16x16x32_bf16(Bt[n][k], At[m][k], acc[ai][bj][m][n], 0, 0, 0); __builtin_amdgcn_s_setprio(0); } while (0)
#define PG8_WAIT_V(n) asm volatile("s_waitcnt vmcnt(" #n ")" ::: "memory")
#define PG8_WAIT_L(n) asm volatile("s_waitcnt lgkmcnt(" #n ")" ::: "memory")
#define PG8_BAR __builtin_amdgcn_s_barrier()
#define PG8_SCHED __builtin_amdgcn_sched_barrier(0)
    Unit cur, nxt; int ui = 0;
    if (!next_unit(ws, ph, 0, G, cidx, cur, pass2)) return;
    f32x4 acc[2][2][4][2];
#pragma unroll
    for (int a = 0; a < 2; ++a)
#pragma unroll
        for (int b = 0; b < 2; ++b)
#pragma unroll
            for (int m = 0; m < 4; ++m)
#pragma unroll
                for (int n = 0; n < 2; ++n) acc[a][b][m][n] = (f32x4){0.f, 0.f, 0.f, 0.f};
    bf16x8 At[4][2], B0[2][2], B1[2][2];
    const char* cA = cur.A + (size_t)cur.pm * 256 * cur.pitchA; const char* cB = cur.B + (size_t)cur.pn * 256 * cur.pitchB;
    unsigned vA = (unsigned)(R0 * cur.pitchA + C0 * 2), vB = (unsigned)(R0 * cur.pitchB + C0 * 2);
    unsigned hA = (unsigned)HALF * cur.pitchA, hB = (unsigned)HALF * cur.pitchB; unsigned pA = 64u * cur.pitchA, pB = 64u * cur.pitchB;
    PG8_STAGE(PG8_SB(0, 0), cB, vB, pB); PG8_STAGE(PG8_SB(0, 1), cB + hB, vB, pB); PG8_STAGE(PG8_SA(0, 0), cA, vA, pA); PG8_STAGE(PG8_SA(0, 1), cA + hA, vA, pA);
    if (wr == 1) PG8_BAR;
    PG8_WAIT_V(2); PG8_BAR;
    PG8_STAGE(PG8_SB(1, 0), cB + kstep, vB, pB); PG8_STAGE(PG8_SA(1, 0), cA + kstep, vA, pA); PG8_STAGE(PG8_SB(1, 1), cB + hB + kstep, vB, pB);
    PG8_WAIT_V(6); PG8_BAR;
    for (;;) {
        const bool has_next = next_unit(ws, ph, ui + 1, G, cidx, nxt, pass2);
        const char* nA = has_next ? nxt.A + (size_t)nxt.pm * 256 * nxt.pitchA : cA; const char* nB = has_next ? nxt.B + (size_t)nxt.pn * 256 * nxt.pitchB : cB;
        const int npA = has_next ? nxt.pitchA : cur.pitchA, npB = has_next ? nxt.pitchB : cur.pitchB;
        const unsigned nvA = (unsigned)(R0 * npA + C0 * 2), nvB = (unsigned)(R0 * npB + C0 * 2);
        const unsigned nhA = (unsigned)HALF * npA, nhB = (unsigned)HALF * npB; const unsigned nppA = 64u * npA, nppB = 64u * npB;
        const int nt = cur.nt;
        for (int t = 0; t < nt; t += 2) {
            const bool last = (t == nt - 2);
            if (last && has_next && nxt.wait) {
                if (wid == 0) {
                    unsigned* dep = (unsigned*)(ws + O_CTL) + CW_DEP + (nxt.wait == 2 ? 32 + ph : (nxt.wait == 4 ? 20 + ph : ph)) * 64; unsigned sp = 0; const unsigned need = (nxt.wait == 1) ? 22u : 4u;
                    while ((unsigned)__builtin_amdgcn_readfirstlane(__hip_atomic_load(dep, __ATOMIC_RELAXED, __HIP_MEMORY_SCOPE_AGENT)) < need) { __builtin_amdgcn_s_sleep(2); if (++sp > (1u << 22)) break; }
                    __builtin_amdgcn_fence(__ATOMIC_ACQUIRE, "agent");
                    asm volatile("s_waitcnt vmcnt(0)" ::: "memory");
                }
                asm volatile("" ::: "memory"); PG8_BAR; asm volatile("" ::: "memory");
            }
            const char* a1 = cA + (size_t)(t + 1) * kstep;
            const char* a2 = last ? nA : cA + (size_t)(t + 2) * kstep; const char* b2 = last ? nB : cB + (size_t)(t + 2) * kstep;
            const char* a3 = a2 + kstep; const char* b3 = b2 + kstep;
            const unsigned vA2 = last ? nvA : vA, vB2 = last ? nvB : vB, pA2 = last ? nppA : pA, pB2 = last ? nppB : pB;
            const unsigned hA2 = last ? nhA : hA, hB2 = last ? nhB : hB;
            PG8_LDB(B0, 0, 0); PG8_LDB(B1, 0, 1); PG8_SCHED; PG8_LDA(At, 0, 0); PG8_STAGE(PG8_SA(1, 1), a1 + hA, vA, pA);
            PG8_WAIT_V(8); PG8_WAIT_L(0); PG8_BAR; PG8_MMA(0, 0, At, B0); PG8_MMA(0, 1, At, B1); PG8_BAR; PG8_SCHED;
            PG8_LDA(At, 0, 1); PG8_STAGE(PG8_SB(0, 0), b2, vB2, pB2); PG8_STAGE(PG8_SB(0, 1), b2 + hB2, vB2, pB2); PG8_STAGE(PG8_SA(0, 0), a2, vA2, pA2);
            PG8_WAIT_V(8); PG8_WAIT_L(0); PG8_BAR; PG8_MMA(1, 0, At, B0); PG8_MMA(1, 1, At, B1); PG8_BAR; PG8_SCHED;
            PG8_LDB(B0, 1, 0); PG8_LDB(B1, 1, 1); PG8_SCHED; PG8_LDA(At, 1, 0); PG8_STAGE(PG8_SA(0, 1), a2 + hA2, vA2, pA2);
            PG8_WAIT_V(8); PG8_WAIT_L(0); PG8_BAR; PG8_MMA(0, 0, At, B0); PG8_MMA(0, 1, At, B1); PG8_BAR; PG8_SCHED;
            PG8_LDA(At, 1, 1); PG8_STAGE(PG8_SB(1, 0), b3, vB2, pB2); PG8_STAGE(PG8_SB(1, 1), b3 + hB2, vB2, pB2); PG8_STAGE(PG8_SA(1, 0), a3, vA2, pA2);
            PG8_WAIT_V(8); PG8_WAIT_L(0); PG8_BAR; PG8_MMA(1, 0, At, B0); PG8_MMA(1, 1, At, B1); PG8_BAR; PG8_SCHED;
        }
        if (wr == 0) PG8_BAR;
        if (dry != 1) epilogue(ws, outp, ph, acc, cur, wr, wc, fr, fq, lds, dry == 2 ? 0.f : 1.f);
        if (!has_next) break;
#pragma unroll
        for (int a = 0; a < 2; ++a)
#pragma unroll
            for (int b = 0; b < 2; ++b)
#pragma unroll
                for (int m = 0; m < 4; ++m)
#pragma unroll
                    for (int n = 0; n < 2; ++n) acc[a][b][m][n] = (f32x4){0.f, 0.f, 0.f, 0.f};
        cur = nxt; cA = nA; cB = nB; vA = nvA; vB = nvB; hA = nhA; hB = nhB; pA = nppA; pB = nppB; ++ui;
        if (wr == 1) PG8_BAR;
    }
    PG8_WAIT_V(0);
    PG8_BAR;
#undef PG8_SA
#undef PG8_SB
#undef PG8_STAGE
#undef PG8_LDA
#undef PG8_LDB
#undef PG8_MMA
#undef PG8_WAIT_V
#undef PG8_WAIT_L
#undef PG8_BAR
#undef PG8_SCHED
}

struct Job { int src, soff, Ksrc, Nsrc, Kdst, Ndst, gidx, goff, map; size_t dst; float scal; };
__device__ __forceinline__ int pinv32(int l) { return 16 * ((l >> 2) & 1) + 4 * (l >> 3) + (l & 3); }
__device__ __forceinline__ Job get_job(int j) {
    Job b; b.gidx = -1; b.goff = 0; b.scal = 1.f; b.map = 0; b.soff = 0;
    if (j < 4) { const int l = j & 1, f2 = j >> 1; b.src = f2 ? 10 : 8; b.soff = l * 1024 * 5632; b.Ksrc = 1024; b.Nsrc = 5632; b.Kdst = 1024; b.Ndst = 5632; b.gidx = 7; b.goff = l * 4096 + (f2 ? 2048 : 0); b.map = 2;
                 b.dst = (f2 ? W_F2I : W_F1I) + (size_t)l * 5632 * 1024 * 2; return b; }
    if (j < 8) { const int l = j & 1, f2 = (j - 4) >> 1; b.src = f2 ? 11 : 9; b.soff = l * 2816 * 1024; b.Ksrc = 2816; b.Nsrc = 1024; b.Kdst = 2816; b.Ndst = 1024; b.map = 1;
                 b.dst = (f2 ? W_F2O : W_F1O) + (size_t)l * 1024 * 2816 * 2; return b; }
    if (j < 10) { const int l = j - 8; b.src = 13; b.soff = l * 1024 * 1024; b.Ksrc = 1024; b.Nsrc = 1024; b.Kdst = 1024; b.Ndst = 1024; b.gidx = 7; b.goff = l * 4096 + 3072; b.map = 1; b.dst = W_PEG + (size_t)l * 1024 * 1024 * 2; return b; }
    if (j < 12) { const int l = j - 10; b.src = 12; b.soff = l * 256 * 1024; b.Ksrc = 256; b.Nsrc = 1024; b.Kdst = 256; b.Ndst = 1024; b.map = 1; b.dst = W_PEP + (size_t)l * 1024 * 256 * 2; return b; }
    if (j < 15) { const int q = j - 12; b.src = 15; b.soff = q * 1024 * 1024; b.Ksrc = 1024; b.Nsrc = 1024; b.Kdst = 1024; b.Ndst = 1024; b.map = 1; b.dst = W_RKV + (size_t)q * 1024 * 1024 * 2; return b; }
    if (j == 15) { b.src = 16; b.Ksrc = 1024; b.Nsrc = 1024; b.Kdst = 1024; b.Ndst = 1024; b.map = 1; b.dst = W_RWO; return b; }
    if (j == 16) { b.src = 18; b.Ksrc = 1024; b.Nsrc = 64; b.Kdst = 1024; b.Ndst = 256; b.map = 1; b.dst = W_L1; return b; }
    if (j == 17) { b.src = 21; b.Ksrc = 1024; b.Nsrc = 64; b.Kdst = 1024; b.Ndst = 256; b.map = 1; b.dst = W_L1 + (size_t)256 * 1024 * 2; return b; }
    if (j == 18) { b.src = 23; b.Ksrc = 1024; b.Nsrc = 160; b.Kdst = 1024; b.Ndst = 256; b.map = 1; b.dst = W_L1 + (size_t)512 * 1024 * 2; return b; }
    if (j == 19) { b.src = 19; b.Ksrc = 64; b.Nsrc = 1024; b.Kdst = 128; b.Ndst = 1024; b.map = 1; b.dst = W_L2W; return b; }
    if (j == 20) { b.src = 22; b.Ksrc = 64; b.Nsrc = 1024; b.Kdst = 128; b.Ndst = 1024; b.map = 1; b.dst = W_L2A; return b; }
    if (j == 21) { b.src = 24; b.Ksrc = 160; b.Nsrc = 1024; b.Kdst = 256; b.Ndst = 1024; b.map = 1; b.dst = W_L2G; return b; }
    if (j == 22) { b.src = 30; b.Ksrc = 1024; b.Nsrc = 3072; b.Kdst = 1024; b.Ndst = 3072; b.map = 1; b.gidx = 7; b.goff = 4096 + 1024; b.scal = 0.125f * 1.4426950408889634f; b.dst = W_Q; return b; }
    if (j == 23) { b.src = 31; b.Ksrc = 1024; b.Nsrc = 1024; b.Kdst = 1024; b.Ndst = 1024; b.map = 1; b.dst = W_AO; return b; }
    b.src = 33; b.Ksrc = 1024; b.Nsrc = 512; b.Kdst = 1024; b.Ndst = 512; b.gidx = 32; b.map = 1; b.dst = W_KV; return b;
}
constexpr int NJOBS = 25;
__device__ __forceinline__ const float* sel_in(KPtr P, int i) { return P->in[i]; }
__device__ __forceinline__ void prologue_phase(KPtr P, LAS unsigned char* lds) {
    const int tid = tid_fresh(), lane = tid & 63, wave = __builtin_amdgcn_readfirstlane(tid >> 6);
    const int bid = bid_fresh(), gdim = gdim_fresh();
    const int gw = bid * 8 + wave, NGW = gdim * 8;
    LAS unsigned char* scr = lds + wave * 9216;
    int base = 0;
    for (int j = 0; j < NJOBS; ++j) {
        const Job jb = get_job(j);
        const int nkb = jb.Kdst / 64, nnb = jb.Ndst / 64, nit = nkb * nnb;
        const float* W = sel_in(P, jb.src) + jb.soff; const float* gv = jb.gidx >= 0 ? sel_in(P, jb.gidx) + jb.goff : nullptr;
        bf16_t* dst = (bf16_t*)(P->ws + jb.dst);
        int first = (gw - (base % NGW) + NGW) % NGW;
        for (int it = first; it < nit; it += NGW) {
            const int kb = it / nnb, nb = it % nnb, k0 = kb * 64, n0 = nb * 64;
            const int nn4 = (lane & 15) * 4, n = n0 + nn4;
            f32x4 v[16];
#pragma unroll
            for (int i = 0; i < 16; ++i) {
                const int k = k0 + 4 * i + (lane >> 4);
                v[i] = (f32x4){0.f, 0.f, 0.f, 0.f};
                if (k < jb.Ksrc && n < jb.Nsrc) v[i] = *(const f32x4*)(W + (size_t)k * jb.Nsrc + n);
            }
#pragma unroll
            for (int i = 0; i < 16; ++i) {
                const int kk = 4 * i + (lane >> 4), k = k0 + kk;
                float sc = jb.scal; if (gv && k < jb.Ksrc) sc *= gv[k];
                const f32x4 x = v[i] * sc;
                LAS bf16_t* sp = (LAS bf16_t*)(scr + nn4 * 144 + kk * 2);
                sp[0] = (bf16_t)(pk2(x.x, 0.f) & 0xffffu); sp[72] = (bf16_t)(pk2(x.y, 0.f) & 0xffffu); sp[144] = (bf16_t)(pk2(x.z, 0.f) & 0xffffu); sp[216] = (bf16_t)(pk2(x.w, 0.f) & 0xffffu);
            }
            asm volatile("s_waitcnt lgkmcnt(0)" ::: "memory");
            int rbase;
            if (jb.map == 2) { const int isUp = n0 >= 2816 ? 1 : 0, j0 = n0 - isUp * 2816; rbase = 256 * (j0 >> 7) + 128 * isUp + (j0 & 127); }
            else rbase = n0;
            const int c = lane & 7;
#pragma unroll
            for (int q = 0; q < 8; ++q) {
                const int nn = (lane >> 3) + 8 * q;
                const u32x4 o = *(const LAS u32x4*)(scr + nn * 144 + c * 16);
                const int drow = rbase + (jb.map ? ((nn & 32) + pinv32(nn & 31)) : nn);
                *(u32x4*)(dst + (size_t)drow * jb.Kdst + k0 + 8 * c) = o;
            }
            asm volatile("s_waitcnt lgkmcnt(0)" ::: "memory");
        }
        base += nit;
    }
    if (bid == 0) { float* par = (float*)(P->ws + O_PAR); for (int e = tid; e < 1024; e += NTHREADS) { const float w0v = P->in[17][e]; par[e] = w0v; par[1024 + e] = sigmoidf_(w0v); par[2048 + e] = P->in[20][e]; } }
    bf16_t* hb0 = (bf16_t*)(P->ws + O_HB0); float* ssq0 = (float*)(P->ws + O_SSQ0);
    for (int row = gw; row < M; row += NGW) {
        const float* src = row < MP ? P->in[0] + (size_t)row * D : P->in[1] + (size_t)(row - MP) * D;
        float sq = 0.f;
#pragma unroll
        for (int j = 0; j < 2; ++j) {
            const int c = 8 * lane + 512 * j;
            const F8 v = load8f(src + c);
            *(u32x4*)(hb0 + (size_t)row * D + c) = pack8(v);
#pragma unroll
            for (int q = 0; q < 8; ++q) sq += v.v[q] * v.v[q];
        }
        sq = wave_sum(sq);
        if (lane < 16) ssq0[(size_t)row * 16 + lane] = (lane == 0) ? sq : 0.f;
    }
    bf16_t* pb = (bf16_t*)(P->ws + O_PB);
    const size_t nchunk = (size_t)2 * M * 32;
    for (size_t ch = (size_t)bid * NTHREADS + tid; ch < nchunk; ch += (size_t)gdim * NTHREADS) {
        const size_t e = ch * 8; const int l = (int)(e / ((size_t)M * 256)); const size_t r = e - (size_t)l * M * 256; const int row = (int)(r >> 8), col = (int)(r & 255);
        const float* src = row < MP ? P->in[5] + ((size_t)l * MP + row) * 256 + col : P->in[6] + ((size_t)l * MS + (row - MP)) * 256 + col;
        *(u32x4*)(pb + e) = pack8(load8f(src));
    }
}

__device__ __forceinline__ void mix_pass(KPtr P) {
    const int tid = tid_fresh(), lane = tid & 63, wave = tid >> 6; const int gw = bid_fresh() * 8 + wave, NGW = gdim_fresh() * 8;
    const float* ssq = (const float*)(P->ws + O_SSQ1); const bf16_t* H = (const bf16_t*)(P->ws + O_HB1); const float* g1 = P->in[7] + 1024; const float* mix = P->in[14];
#pragma unroll 1
    for (int j = 0; j < 2; ++j) {
        const int c = 8 * lane + 512 * j;
        const F8 g = load8f(g1 + c);
        F8 mq[6];
#pragma unroll
        for (int a6 = 0; a6 < 6; ++a6) mq[a6] = load8f(mix + a6 * 1024 + c);
        for (int row = gw; row < M; row += NGW) {
            int b, t, T; const bool isS = row >= MP;
            if (!isS) { b = row >> 12; t = row & 4095; T = TP; } else { const int jj = row - MP; b = jj >> 3; t = jj & 7; T = TS; }
            const float rs = rstd_of(ssq, row); const float rsp = t > 0 ? rstd_of(ssq, row - 1) : 0.f;
            const F8 hc = unpack8(*(const u32x4*)(H + (size_t)row * D + c));
            F8 xn, xx;
#pragma unroll
            for (int q = 0; q < 8; ++q) xn.v[q] = hc.v[q] * rs * g.v[q];
            if (t > 0) { const F8 hp = unpack8(*(const u32x4*)(H + (size_t)(row - 1) * D + c));
#pragma unroll
                for (int q = 0; q < 8; ++q) xx.v[q] = hp.v[q] * rsp * g.v[q] - xn.v[q]; }
            else if (isS) { const F8 sp = load8f(P->in[3] + (size_t)b * D + c);
#pragma unroll
                for (int q = 0; q < 8; ++q) xx.v[q] = sp.v[q] - xn.v[q]; }
            else {
#pragma unroll
                for (int q = 0; q < 8; ++q) xx.v[q] = -xn.v[q]; }
#pragma unroll
            for (int a6 = 0; a6 < 6; ++a6) {
                F8 v;
#pragma unroll
                for (int q = 0; q < 8; ++q) v.v[q] = xn.v[q] + xx.v[q] * mq[a6].v[q];
                *(u32x4*)((bf16_t*)(P->ws + O_R4 + (size_t)a6 * SL) + (size_t)row * D + c) = pack8(v);
            }
            if (t == T - 1) { float* so = P->out + (isS ? O_SHS : O_SHP) + (size_t)b * D + c;
                *(f32x4*)so = (f32x4){xn.v[0], xn.v[1], xn.v[2], xn.v[3]}; *(f32x4*)(so + 4) = (f32x4){xn.v[4], xn.v[5], xn.v[6], xn.v[7]}; }
        }
    }
}
__device__ __forceinline__ void post_pass(KPtr P) {
    const int tid = tid_fresh(), lane = tid & 63, wave = tid >> 6; const int gw = bid_fresh() * 8 + wave, NGW = gdim_fresh() * 8;
    const bf16_t* Y = (const bf16_t*)(P->ws + O_Y); const bf16_t* BON = (const bf16_t*)(P->ws + O_BON); const bf16_t* GG = (const bf16_t*)(P->ws + O_GG);
    bf16_t* YG = (bf16_t*)(P->ws + O_YG); const float* lw = P->in[28]; const float* lb = P->in[29];
    for (int row = gw; row < M; row += NGW) {
#pragma unroll
        for (int j = 0; j < 2; ++j) {
            const int c = 8 * lane + 512 * j; const size_t off = (size_t)row * D + c;
            const F8 y = unpack8(*(const u32x4*)(Y + off)), bo = unpack8(*(const u32x4*)(BON + off)), gg = unpack8(*(const u32x4*)(GG + off));
            const F8 w8 = load8f(lw + c), b8 = load8f(lb + c);
            float sm = 0.f;
#pragma unroll
            for (int q = 0; q < 8; ++q) sm += y.v[q];
            const float mu = row_sum8(sm) * (1.f / 64.f);
            float sv = 0.f; F8 d;
#pragma unroll
            for (int q = 0; q < 8; ++q) { d.v[q] = y.v[q] - mu; sv += d.v[q] * d.v[q]; }
            const float rs = __builtin_amdgcn_rsqf(row_sum8(sv) * (1.f / 64.f) + 64e-5f);
            F8 o;
#pragma unroll
            for (int q = 0; q < 8; ++q) o.v[q] = (d.v[q] * rs * w8.v[q] + b8.v[q] + bo.v[q]) * gg.v[q];
            *(u32x4*)(YG + off) = pack8(o);
        }
    }
}
__device__ __forceinline__ void final_pass(KPtr P) {
    const int tid = tid_fresh(), lane = tid & 63, wave = tid >> 6; const int gw = bid_fresh() * 8 + wave, NGW = gdim_fresh() * 8;
    const float* ssq = (const float*)(P->ws + O_SSQ0); const float* fn = P->in[35];
    for (int row = gw; row < M; row += NGW) {
        const float rs = rstd_of(ssq, row);
#pragma unroll
        for (int j = 0; j < 2; ++j) {
            const int c = 8 * lane + 512 * j; float* p = P->out + (size_t)row * D + c;
            const F8 h = unpack8(*(const u32x4*)((const bf16_t*)(P->ws + O_HB0) + (size_t)row * D + c)), f = load8f(fn + c);
            *(f32x4*)p = (f32x4){h.v[0] * rs * f.v[0], h.v[1] * rs * f.v[1], h.v[2] * rs * f.v[2], h.v[3] * rs * f.v[3]};
            *(f32x4*)(p + 4) = (f32x4){h.v[4] * rs * f.v[4], h.v[5] * rs * f.v[5], h.v[6] * rs * f.v[6], h.v[7] * rs * f.v[7]};
        }
    }
}

constexpr int TC = 32;
constexpr int SC_BUF = 5 * TC * 256 + TC * 64 + TC * 4;
constexpr int SC_OUT = 2 * SC_BUF;
constexpr int SC_OBUF = 2 * TC * 16 * 4;
__device__ __forceinline__ float wave_sum_fast(float x) {
    x = row_sum16(x);
    const float a = __builtin_bit_cast(float, __builtin_amdgcn_readlane(__builtin_bit_cast(int, x), 0)), b = __builtin_bit_cast(float, __builtin_amdgcn_readlane(__builtin_bit_cast(int, x), 16));
    const float c = __builtin_bit_cast(float, __builtin_amdgcn_readlane(__builtin_bit_cast(int, x), 32)), d = __builtin_bit_cast(float, __builtin_amdgcn_readlane(__builtin_bit_cast(int, x), 48));
    return (a + b) + (c + d);
}
struct PrepRegs { unsigned short lr[TC / 4], lk[TC / 4], lw[TC / 4], la[TC / 4], lv[TC / 4]; };
__device__ __forceinline__ void scan_prep_load(KPtr P, PrepRegs& g, int rowbase, int t0, int T, int h, int qi, int pw, int lane) {
    const bf16_t* RKV = (const bf16_t*)(P->ws + O_RKVB); const bf16_t* WL = (const bf16_t*)(P->ws + O_WL); const bf16_t* AL = (const bf16_t*)(P->ws + O_AL);
    const int ch = h * 64 + lane;
    constexpr int NS = TC / 4;
#pragma unroll
    for (int q = 0; q < NS; ++q) {
        int t = t0 + pw * NS + q; t = t < T ? t : T - 1;
        const size_t row = (size_t)(rowbase + t);
        g.lr[q] = RKV[row * 3072 + ch]; g.lk[q] = RKV[row * 3072 + 1024 + ch]; g.lw[q] = WL[row * 1024 + ch]; g.la[q] = AL[row * 1024 + ch];
        g.lv[q] = RKV[row * 3072 + 2048 + h * 64 + qi * 16 + (lane & 15)];
    }
}
__device__ __forceinline__ void scan_prep_compute(KPtr P, const PrepRegs& g, LAS unsigned char* buf, int h, int pw, int lane) {
    const int ch = h * 64 + lane;
    const float sw0 = ((const float*)(P->ws + O_PAR))[1024 + ch], kkw = P->in[25][ch], kaw = P->in[26][ch], rkw = P->in[27][ch];
    LAS float* fb = (LAS float*)buf;
    constexpr int NS = TC / 4;
#pragma unroll
    for (int q = 0; q < NS; ++q) {
        const int tau = pw * NS + q;
        const float r = bf2f(g.lr[q]), k = bf2f(g.lk[q]), wl = bf2f(g.lw[q]), al = bf2f(g.la[q]);
        const float dec = __builtin_amdgcn_exp2f(-0.8750387f * (sw0 + wl));
        const float a = al;
        const float kkv = k * kkw;
        const float n2 = wave_sum_fast(kkv * kkv);
        const float kkn = kkv * __builtin_amdgcn_rsqf(fmaxf(n2, 1e-24f));
        const float kp = k * (1.f + (a - 1.f) * kaw);
        const float bon = wave_sum_fast(r * kp * rkw);
        fb[0 * TC * 64 + tau * 64 + lane] = -kkn;
        fb[1 * TC * 64 + tau * 64 + lane] = dec;
        fb[2 * TC * 64 + tau * 64 + lane] = kkn * a;
        fb[3 * TC * 64 + tau * 64 + lane] = kp;
        fb[4 * TC * 64 + tau * 64 + lane] = r;
        if (lane < 16) fb[5 * TC * 64 + tau * 16 + lane] = bf2f(g.lv[q]);
        if (lane == 0) fb[5 * TC * 64 + TC * 16 + tau] = bon;
    }
}
__device__ __forceinline__ void scan_flush(KPtr P, const LAS float* ob, int rowbase, int t0, int T, int h, int qi, int p) {
    const int tau = p >> 3, pr = (p & 7) * 2; const int t = t0 + tau;
    if (t < T) {
        const size_t off = (size_t)(rowbase + t) * D + h * 64 + qi * 16 + pr;
        *(unsigned*)((bf16_t*)(P->ws + O_Y) + off) = pk2(ob[tau * 16 + pr], ob[tau * 16 + pr + 1]);
        *(unsigned*)((bf16_t*)(P->ws + O_BON) + off) = pk2(ob[TC * 16 + tau * 16 + pr], ob[TC * 16 + tau * 16 + pr + 1]);
    }
}
typedef short bf16x4 __attribute__((ext_vector_type(4)));
#ifndef NPREP_
#define NPREP_ 6
#endif
constexpr int NPREP = NPREP_;
constexpr int SL_AOP = 0, SL_RT = 2048, SL_UH = 4096, SL_Y0 = 5120, SL_MRB = 6144, SL_BTT = 6656, SL_ZV = 8704, SL_GC = 10752, SL_VTB = 11008, SL_BON = 11520, SL_RN = 11584, SLOT_B = 11776;
constexpr int SC_AT = 0, SC_BT = 2048, SC_KT = 4096, SC_ATT = 6144, SC_KTT = 8192, SC_LAB = 10240, SC_TM = 11264, SC_TM2 = SC_LAB  , SCR_B = 11776;
constexpr int SC_X1 = -SLOT_B + SL_AOP, SC_X2 = -SLOT_B + SL_ZV;
constexpr int CK_FLAGS = NPREP * (SLOT_B + SCR_B);
static_assert(CK_FLAGS + 64 <= LDS_CTL_OFF, "chunked scan LDS");
typedef unsigned short us2 __attribute__((ext_vector_type(2)));
struct CkRegs { us2 rk[16], wa[16], vv[8]; };
__device__ __forceinline__ void ck_load(KPtr P, CkRegs& g, int row0, int h, int qi, int lane) {
    const bf16_t* rk = (const bf16_t*)(P->ws + O_RKVB) + (size_t)row0 * 3072 + h * 64;
    const bf16_t* wl = (const bf16_t*)(P->ws + O_WL) + (size_t)row0 * 1024 + h * 64;
    const bf16_t* al = (const bf16_t*)(P->ws + O_AL) + (size_t)row0 * 1024 + h * 64;
    const bf16_t* vq = rk + 2048 + qi * 16;
    const int l15 = lane & 15;
#pragma unroll
    for (int t = 0; t < 16; ++t) {
        g.rk[t].x = rk[t * 3072 + lane]; g.rk[t].y = rk[t * 3072 + 1024 + lane]; g.wa[t].x = wl[t * 1024 + lane]; g.wa[t].y = al[t * 1024 + lane];
        const unsigned short vv_ = vq[t * 3072 + l15];
        if (t & 1) g.vv[t >> 1].y = vv_; else g.vv[t >> 1].x = vv_;
    }
}
__device__ __forceinline__ unsigned short bf1(float x) { return (unsigned short)(pk2(x, 0.f) & 0xffffu); }
__device__ __forceinline__ bf16x4 pack4(f32x4 v) { u32x2 w; w.x = pk2(v.x, v.y); w.y = pk2(v.z, v.w); return __builtin_bit_cast(bf16x4, w); }
#define MFMA16(a, b, c) __builtin_amdgcn_mfma_f32_16x16x16bf16_1k(a, b, c, 0, 0, 0)
#define MFMA32(a, b, c) __builtin_amdgcn_mfma_f32_16x16x32_bf16(a, b, c, 0, 0, 0)
#define LDSW() asm volatile("s_waitcnt lgkmcnt(0)" ::: "memory")
struct CkPar { float sw0, kkw, kaw, rkw; };
__device__ __forceinline__ void ck_prep_a(const CkPar& cp, const CkRegs& g, LAS unsigned char* slot, LAS unsigned char* scr, int lane) {
    const float sw0 = cp.sw0, kkw = cp.kkw, kaw = cp.kaw, rkw = cp.rkw;
    float gprev = 1.f, pa = 0.f, pb = 0.f, pk = 0.f, pv = 0.f, pr = 0.f, p1 = 0.f, p2 = 0.f;
    unsigned att[8], btt[8], ktt[8], vtb[8];
    const unsigned psel = (lane & 1) ? 0x07060302u : 0x01000504u;
    const int woff = lane * 2 + (lane & 1) * 126;
#define CK_ROWPAIR(base, pw, tprev) do { const unsigned nb_ = (unsigned)__builtin_amdgcn_update_dpp(0, (int)(pw), 0xB1, 0xF, 0xF, true); \
        *(LAS unsigned*)((base) + woff + (tprev) * 128) = __builtin_amdgcn_perm((pw), nb_, psel); } while (0)
#pragma unroll
    for (int t = 0; t < 16; ++t) {
        const float r = bf2f(g.rk[t].x), k = bf2f(g.rk[t].y), wl = bf2f(g.wa[t].x), al = bf2f(g.wa[t].y);
        const float dec = __builtin_amdgcn_exp2f(-0.8750387f * (sw0 + wl));
        const float a = al;
        const float kkv = k * kkw;
        const float kp = k * (1.f + (a - 1.f) * kaw);
        const float gcur = gprev * dec, rg = __builtin_amdgcn_rcpf(gcur);
        const float at = -kkv * gprev, bt = kkv * a * rg, kt = kp * rg, rt = r * gcur, vv = bf2f((t & 1) ? g.vv[t >> 1].y : g.vv[t >> 1].x);
        const float x1 = kkv * kkv, x2 = r * kp * rkw;
        if (t & 1) {
            const unsigned wa_ = pk2(pa, at), wb_ = pk2(pb, bt), wk_ = pk2(pk, kt), wr_ = pk2(pr, rt), w1_ = pk2(p1, x1), w2_ = pk2(p2, x2);
            att[t >> 1] = wa_; btt[t >> 1] = wb_; ktt[t >> 1] = wk_; vtb[t >> 1] = pk2(pv, vv);
            CK_ROWPAIR(scr + SC_AT, wa_, t - 1); CK_ROWPAIR(scr + SC_BT, wb_, t - 1); CK_ROWPAIR(scr + SC_KT, wk_, t - 1);
            CK_ROWPAIR(slot + SL_RT, wr_, t - 1); CK_ROWPAIR(scr + SC_X1, w1_, t - 1); CK_ROWPAIR(scr + SC_X2, w2_, t - 1);
        }
        pa = at; pb = bt; pk = kt; pv = vv; pr = rt; p1 = x1; p2 = x2;
        gprev = gcur;
    }
#undef CK_ROWPAIR
    ((LAS float*)(slot + SL_GC))[lane] = gprev;
    *(LAS u32x4*)(scr + SC_ATT + lane * 32) = (u32x4){att[0], att[1], att[2], att[3]}; *(LAS u32x4*)(scr + SC_ATT + lane * 32 + 16) = (u32x4){att[4], att[5], att[6], att[7]};
    *(LAS u32x4*)(slot + SL_BTT + lane * 32) = (u32x4){btt[0], btt[1], btt[2], btt[3]}; *(LAS u32x4*)(slot + SL_BTT + lane * 32 + 16) = (u32x4){btt[4], btt[5], btt[6], btt[7]};
    *(LAS u32x4*)(scr + SC_KTT + lane * 32) = (u32x4){ktt[0], ktt[1], ktt[2], ktt[3]}; *(LAS u32x4*)(scr + SC_KTT + lane * 32 + 16) = (u32x4){ktt[4], ktt[5], ktt[6], ktt[7]};
    if (lane < 16) {
        *(LAS u32x4*)(slot + SL_VTB + lane * 32) = (u32x4){vtb[0], vtb[1], vtb[2], vtb[3]}; *(LAS u32x4*)(slot + SL_VTB + lane * 32 + 16) = (u32x4){vtb[4], vtb[5], vtb[6], vtb[7]};
    }
    LDSW();
}
__device__ __forceinline__ void ck_prep_b(LAS unsigned char* slot, LAS unsigned char* scr, int lane) {
    const int m = lane & 15, kg = lane >> 4;
    const f32x4 z4 = (f32x4){0.f, 0.f, 0.f, 0.f};
    f32x4 P1, P2, P3, P4;
    {
        const bf16x8 KA0 = *(const LAS bf16x8*)(scr + SC_KT + m * 128 + kg * 16), KA1 = *(const LAS bf16x8*)(scr + SC_KT + m * 128 + kg * 16 + 64);
        const bf16x8 BA0 = *(const LAS bf16x8*)(scr + SC_BT + m * 128 + kg * 16), BA1 = *(const LAS bf16x8*)(scr + SC_BT + m * 128 + kg * 16 + 64);
        const bf16x8 AB0 = *(const LAS bf16x8*)(scr + SC_AT + m * 128 + kg * 16), AB1 = *(const LAS bf16x8*)(scr + SC_AT + m * 128 + kg * 16 + 64);
        const bf16x8 RB0 = *(const LAS bf16x8*)(slot + SL_RT + m * 128 + kg * 16), RB1 = *(const LAS bf16x8*)(slot + SL_RT + m * 128 + kg * 16 + 64);
        P1 = MFMA32(KA0, AB0, z4); P1 = MFMA32(KA1, AB1, P1);
        P2 = MFMA32(BA0, AB0, z4); P2 = MFMA32(BA1, AB1, P2);
        P3 = MFMA32(KA0, RB0, z4); P3 = MFMA32(KA1, RB1, P3);
        P4 = MFMA32(BA0, RB0, z4); P4 = MFMA32(BA1, RB1, P4);
    }
    f32x4 rn4;
    {
        const u32x4 one4 = (u32x4){0x3f803f80u, 0x3f803f80u, 0x3f803f80u, 0x3f803f80u}; const bf16x8 ones = __builtin_bit_cast(bf16x8, one4);
        const bf16x8 X10 = *(const LAS bf16x8*)(scr + SC_X1 + m * 128 + kg * 16), X11 = *(const LAS bf16x8*)(scr + SC_X1 + m * 128 + kg * 16 + 64);
        const bf16x8 X20 = *(const LAS bf16x8*)(scr + SC_X2 + m * 128 + kg * 16), X21 = *(const LAS bf16x8*)(scr + SC_X2 + m * 128 + kg * 16 + 64);
        f32x4 N2 = MFMA32(X10, ones, z4); N2 = MFMA32(X11, ones, N2);
        f32x4 BO = MFMA32(X20, ones, z4); BO = MFMA32(X21, ones, BO);
#pragma unroll
        for (int e = 0; e < 4; ++e) rn4[e] = __builtin_amdgcn_rsqf(fmaxf(N2[e], 1e-24f));
        if (m == 0) { *(LAS f32x4*)(slot + SL_RN + 4 * kg * 4) = rn4; *(LAS f32x4*)(slot + SL_BON + 4 * kg * 4) = BO; }
    }
    LDSW();
    const float rnm = ((const LAS float*)(slot + SL_RN))[m];
    f32x4 lak, lab, mrk, mrb;
#pragma unroll
    for (int e = 0; e < 4; ++e) { P1[e] *= rnm; P2[e] *= rnm * rn4[e]; P4[e] *= rn4[e]; }
#pragma unroll
    for (int e = 0; e < 4; ++e) { const int sI = 4 * kg + e; lak[e] = sI < m ? P1[e] : 0.f; lab[e] = sI < m ? P2[e] : 0.f; mrk[e] = sI <= m ? P3[e] : 0.f; mrb[e] = sI <= m ? P4[e] : 0.f; }
    *(LAS f32x4*)(scr + SC_LAB + (m * 16 + 4 * kg) * 4) = lab;
    *(LAS bf16x4*)(slot + SL_MRB + lane * 8) = pack4(mrb);
    const bf16x4 lakop = pack4(lak), mrkop = pack4(mrk);
    LDSW();
    float x[16];
#pragma unroll
    for (int t = 0; t < 16; ++t) {
        float acc = (t == m) ? 1.f : 0.f;
#pragma unroll
        for (int s4 = 0; s4 * 4 < t; ++s4) {
            const f32x4 L4 = *(const LAS f32x4*)(scr + SC_LAB + (t * 16 + 4 * s4) * 4);
#pragma unroll
            for (int e = 0; e < 4; ++e) if (4 * s4 + e < t) acc = fmaf(L4[e], x[4 * s4 + e], acc);
        }
        x[t] = acc;
    }
    if (lane < 16) {
#pragma unroll
        for (int t = 0; t < 16; ++t) { ((LAS bf16_t*)(scr + SC_TM))[t * 16 + m] = bf1(x[t]); ((LAS bf16_t*)(scr + SC_TM2))[t * 16 + m] = bf1(x[t] * rnm); }
    }
    LDSW();
    const bf16x4 vop = *(const LAS bf16x4*)(slot + SL_VTB + (m * 16 + 4 * kg) * 2);
    const bf16x4 top = *(const LAS bf16x4*)(scr + SC_TM + (m * 16 + 4 * kg) * 2);
    const bf16x4 top2 = *(const LAS bf16x4*)(scr + SC_TM2 + (m * 16 + 4 * kg) * 2);
    const f32x4 LV = MFMA16(lakop, vop, z4);
    const f32x4 Y0 = MFMA16(mrkop, vop, z4);
    *(LAS f32x4*)(slot + SL_Y0 + lane * 16) = Y0;
    const f32x4 UH = MFMA16(top, pack4(LV), z4);
    *(LAS f32x4*)(slot + SL_UH + lane * 16) = UH;
    u32x4 o1, o2;
    {
        f32x4 AH[4], ZV[4];
#pragma unroll
        for (int tau = 0; tau < 4; ++tau) {
            const bf16x4 aop = *(const LAS bf16x4*)(scr + SC_ATT + ((16 * tau + m) * 16 + 4 * kg) * 2);
            AH[tau] = MFMA16(aop, top2, z4);
            const bf16x4 kop = *(const LAS bf16x4*)(scr + SC_KTT + ((16 * tau + m) * 16 + 4 * kg) * 2);
            ZV[tau] = MFMA16(kop, vop, z4);
        }
        o1 = (u32x4){pk2(AH[0].x, AH[0].y), pk2(AH[0].z, AH[0].w), pk2(AH[1].x, AH[1].y), pk2(AH[1].z, AH[1].w)};
        o2 = (u32x4){pk2(AH[2].x, AH[2].y), pk2(AH[2].z, AH[2].w), pk2(AH[3].x, AH[3].y), pk2(AH[3].z, AH[3].w)};
        *(LAS u32x4*)(slot + SL_AOP + lane * 32) = o1; *(LAS u32x4*)(slot + SL_AOP + lane * 32 + 16) = o2;
        o1 = (u32x4){pk2(ZV[0].x, ZV[0].y), pk2(ZV[0].z, ZV[0].w), pk2(ZV[1].x, ZV[1].y), pk2(ZV[1].z, ZV[1].w)};
        o2 = (u32x4){pk2(ZV[2].x, ZV[2].y), pk2(ZV[2].z, ZV[2].w), pk2(ZV[3].x, ZV[3].y), pk2(ZV[3].z, ZV[3].w)};
        *(LAS u32x4*)(slot + SL_ZV + lane * 32) = o1; *(LAS u32x4*)(slot + SL_ZV + lane * 32 + 16) = o2;
    }
    LDSW();
}
__device__ __forceinline__ void ck_wait(volatile LAS unsigned* f, unsigned v) { while (*f != v) __builtin_amdgcn_s_sleep(1); asm volatile("" ::: "memory"); }
__device__ __forceinline__ void scan_chunked_item(KPtr P, LAS unsigned char* lds, int it, int tid, int mode) {
    const int lane = tid & 63, w = __builtin_amdgcn_readfirstlane(tid >> 6);
    const int b = it >> 6, h = (it >> 2) & 15, qi = it & 3, rowbase = b * TP;
    constexpr int NCH = TP / 16;
    volatile LAS unsigned* flags = (volatile LAS unsigned*)(lds + CK_FLAGS);
    if (tid < 16) flags[tid] = 0u;
    __syncthreads();
    if (w == 0) {
        const int m = lane & 15, kg = lane >> 4;
        f32x4 ST[4];
#pragma unroll
        for (int tau = 0; tau < 4; ++tau) ST[tau] = (f32x4){0.f, 0.f, 0.f, 0.f};
        bf16_t* Yg = (bf16_t*)(P->ws + O_Y) + (size_t)rowbase * D + h * 64 + qi * 16 + m;
        bf16_t* Bg = (bf16_t*)(P->ws + O_BON) + (size_t)rowbase * D + h * 64 + qi * 16 + m;
        int pslot = 0;
#pragma unroll 1
        for (int c = 0; c < NCH; ++c) {
            LAS unsigned char* slot = lds + pslot * (SLOT_B + SCR_B);
            ck_wait(flags + pslot, (unsigned)(c + 1));
            if (mode == 1 || mode == 3) { flags[8 + pslot] = (unsigned)(c + 1); pslot = (pslot == NPREP - 1) ? 0 : pslot + 1; continue; }
            const f32x4 z4 = (f32x4){0.f, 0.f, 0.f, 0.f};
            const u32x4 s1 = (u32x4){pk2(ST[0].x, ST[0].y), pk2(ST[0].z, ST[0].w), pk2(ST[1].x, ST[1].y), pk2(ST[1].z, ST[1].w)};
            const u32x4 s2 = (u32x4){pk2(ST[2].x, ST[2].y), pk2(ST[2].z, ST[2].w), pk2(ST[3].x, ST[3].y), pk2(ST[3].z, ST[3].w)};
            const bf16x8 sop1 = __builtin_bit_cast(bf16x8, s1), sop2 = __builtin_bit_cast(bf16x8, s2);
            const bf16x8 aop1 = *(const LAS bf16x8*)(slot + SL_AOP + lane * 32), aop2 = *(const LAS bf16x8*)(slot + SL_AOP + lane * 32 + 16);
            const LAS unsigned char* rrow = slot + SL_RT + m * 128 + kg * 8;
            const u32x2 r0 = *(const LAS u32x2*)(rrow), r1 = *(const LAS u32x2*)(rrow + 32), r2 = *(const LAS u32x2*)(rrow + 64), r3 = *(const LAS u32x2*)(rrow + 96);
            const bf16x8 rop1 = __builtin_bit_cast(bf16x8, (u32x4){r0.x, r0.y, r1.x, r1.y}), rop2 = __builtin_bit_cast(bf16x8, (u32x4){r2.x, r2.y, r3.x, r3.y});
            f32x4 U = MFMA32(aop1, sop1, z4); U = MFMA32(aop2, sop2, U);
            f32x4 Y = MFMA32(rop1, sop1, z4); Y = MFMA32(rop2, sop2, Y);
            U = U + *(const LAS f32x4*)(slot + SL_UH + lane * 16);
            const bf16x4 uop = pack4(U);
            const bf16x4 uop2 = pack4(U * *(const LAS f32x4*)(slot + SL_RN + 4 * kg * 4));
            const bf16x4 mop = *(const LAS bf16x4*)(slot + SL_MRB + lane * 8);
            Y = MFMA16(mop, uop, Y);
            Y = Y + *(const LAS f32x4*)(slot + SL_Y0 + lane * 16);
            const u32x4 zv1 = *(const LAS u32x4*)(slot + SL_ZV + lane * 32), zv2 = *(const LAS u32x4*)(slot + SL_ZV + lane * 32 + 16);
            const unsigned zvw[8] = {zv1.x, zv1.y, zv1.z, zv1.w, zv2.x, zv2.y, zv2.z, zv2.w};
#pragma unroll
            for (int tau = 0; tau < 4; ++tau) {
                const bf16x4 bop = *(const LAS bf16x4*)(slot + SL_BTT + ((16 * tau + m) * 16 + 4 * kg) * 2);
                const f32x4 dS = MFMA16(bop, uop2, z4);
                const f32x4 gc = *(const LAS f32x4*)(slot + SL_GC + (16 * tau + 4 * kg) * 4);
                const f32x4 zv = (f32x4){bflo(zvw[2 * tau]), bfhi(zvw[2 * tau]), bflo(zvw[2 * tau + 1]), bfhi(zvw[2 * tau + 1])};
                ST[tau] = (ST[tau] + dS + zv) * gc;
            }
            const f32x4 bn = *(const LAS f32x4*)(slot + SL_BON + 4 * kg * 4); const u32x2 vtw = *(const LAS u32x2*)(slot + SL_VTB + (m * 16 + 4 * kg) * 2);
            const f32x4 vt4 = (f32x4){bflo(vtw.x), bfhi(vtw.x), bflo(vtw.y), bfhi(vtw.y)};
            LDSW();
            flags[8 + pslot] = (unsigned)(c + 1);
            if (mode == 0) {
#pragma unroll
            for (int e = 0; e < 4; ++e) {
                const size_t off = (size_t)(c * 16 + 4 * kg + e) * D;
                Yg[off] = bf1(Y[e]); Bg[off] = bf1(bn[e] * vt4[e]);
            } } else { asm volatile("" :: "v"(Y), "v"(bn), "v"(vt4)); }
            pslot = (pslot == NPREP - 1) ? 0 : pslot + 1;
        }
        float* sout = P->out + O_WKVP + (size_t)(b * 16 + h) * 4096 + (size_t)(qi * 16 + m) * 64;
        if (mode == 0) {
#pragma unroll
        for (int tau = 0; tau < 4; ++tau) *(f32x4*)(sout + 16 * tau + 4 * kg) = ST[tau]; } else { asm volatile("" :: "v"(ST[0]), "v"(ST[1]), "v"(ST[2]), "v"(ST[3])); }
    } else if (w != 4 && ((w < 4 ? w - 1 : w - 2) < NPREP)) {
        const int p = w < 4 ? w - 1 : w - 2;
        LAS unsigned char* slot = lds + p * (SLOT_B + SCR_B); LAS unsigned char* scr = slot + SLOT_B;
        CkRegs g;
        CkPar cp; { const int ch = h * 64 + lane; cp.sw0 = ((const float*)(P->ws + O_PAR))[1024 + ch]; cp.kkw = P->in[25][ch]; cp.kaw = P->in[26][ch]; cp.rkw = P->in[27][ch]; }
        ck_load(P, g, rowbase + p * 16, h, qi, lane);
#pragma unroll 1
        for (int c = p; c < NCH; c += NPREP) {
            if (c >= NPREP) ck_wait(flags + 8 + p, (unsigned)(c - NPREP + 1));
            if (mode == 2) { flags[p] = (unsigned)(c + 1); continue; }
            ck_prep_a(cp, g, slot, scr, lane);
            if (mode != 3) { const int cn = (c + NPREP < NCH) ? c + NPREP : c; ck_load(P, g, rowbase + cn * 16, h, qi, lane); }
            ck_prep_b(slot, scr, lane);
            flags[p] = (unsigned)(c + 1);
        }
    }
}

__device__ __forceinline__ void scan_phase(KPtr P, LAS unsigned char* lds) {
    const int tid = tid_fresh(), lane = tid & 63, w = __builtin_amdgcn_readfirstlane(tid >> 6);
    const int bid = bid_fresh(), gdim = gdim_fresh();
#ifndef SCAN_REP_P
#define SCAN_REP_P 1
#endif
#ifndef SCAN_MODE2
#define SCAN_MODE2 0
#endif
#ifndef SCAN_REP_S
#define SCAN_REP_S 1
#endif
#ifdef SCAN_PRETOUCH
    {
        const int it = (gdim == 256) ? (((bid & 7) * 8 + (bid >> 5)) * 4 + ((bid >> 3) & 3)) : bid;
        const int b = it >> 6, h = (it >> 2) & 15, qi = it & 3;
        const bf16_t* RKV = (const bf16_t*)(P->ws + O_RKVB); const bf16_t* WL = (const bf16_t*)(P->ws + O_WL); const bf16_t* AL = (const bf16_t*)(P->ws + O_AL);
        unsigned acc = 0;
        for (int r = qi * 1024 + (tid >> 3); r < qi * 1024 + 1024; r += 64) {
            const size_t row = (size_t)b * TP + r; const int sub = tid & 7;
            for (int pc = sub; pc < 10; pc += 8) {
                const int seg = pc >> 1, half = pc & 1;
                const bf16_t* p = seg < 3 ? RKV + row * 3072 + seg * 1024 + h * 64 + half * 32 : (seg == 3 ? WL : AL) + row * 1024 + h * 64 + half * 32;
                acc += *(const unsigned*)p;
            }
        }
        if (acc == 0x12345678u) ((volatile LAS unsigned*)lds)[0] = acc;
        __syncthreads();
    }
#endif
    for (int rp_ = 0; rp_ < SCAN_REP_P; ++rp_)
    for (int it0 = bid; it0 < 256; it0 += gdim) {
        const int it = (gdim == 256) ? (((it0 & 7) * 8 + (it0 >> 5)) * 4 + ((it0 >> 3) & 3)) : it0;
        scan_chunked_item(P, lds, it, tid, rp_ == 0 ? 0 : SCAN_MODE2); __syncthreads(); }
    for (int rs_ = 0; rs_ < SCAN_REP_S; ++rs_)
    for (int it = 256 + bid; it < 256 + 2048; it += gdim) {
        int rowbase, T, h, qi; const float* sin; float* sout;
        if (it < 256) { const int b = it >> 6; h = (it >> 2) & 15; qi = it & 3; rowbase = b * TP; T = TP; sin = nullptr; sout = P->out + O_WKVP + (size_t)(b * 16 + h) * 4096; }
        else { const int j = it - 256; const int b = j >> 6; h = (j >> 2) & 15; qi = j & 3; rowbase = MP + b * TS; T = TS; sin = P->in[2] + (size_t)(b * 16 + h) * 4096; sout = P->out + O_WKVS + (size_t)(b * 16 + h) * 4096; }
        const int nch = (T + TC - 1) / TC;
        const int rr = lane >> 4, q = lane & 15; const int il = (w & 3) * 4 + rr; const int irow = qi * 16 + il;
        f32x4 s = (f32x4){0.f, 0.f, 0.f, 0.f};
        PrepRegs pg;
        if (w < 4) { if (sin) s = *(const f32x4*)(sin + (size_t)irow * 64 + q * 4); }
        else { scan_prep_load(P, pg, rowbase, 0, T, h, qi, w - 4, lane); scan_prep_compute(P, pg, lds, h, w - 4, lane); if (nch > 1) scan_prep_load(P, pg, rowbase, TC, T, h, qi, w - 4, lane); }
        __syncthreads();
        for (int c = 0; c < nch; ++c) {
            LAS unsigned char* buf = lds + (c & 1) * SC_BUF;
            LAS float* ob = (LAS float*)(lds + SC_OUT + (c & 1) * SC_OBUF);
            if (w >= 4) {
                if (c > 0) scan_flush(P, (const LAS float*)(lds + SC_OUT + ((c - 1) & 1) * SC_OBUF), rowbase, (c - 1) * TC, T, h, qi, tid - 256);
                if (c + 1 < nch) { scan_prep_compute(P, pg, lds + ((c + 1) & 1) * SC_BUF, h, w - 4, lane); if (c + 2 < nch) scan_prep_load(P, pg, rowbase, (c + 2) * TC, T, h, qi, w - 4, lane); }
            } else {
                const int ns = (T - c * TC) < TC ? (T - c * TC) : TC;
                const LAS float* fb = (const LAS float*)buf;
#pragma unroll 1
                for (int t8 = 0; t8 < ns; t8 += 8) {
                    f32x4 nkk = *(const LAS f32x4*)(fb + 0 * TC * 64 + t8 * 64 + q * 4), dw = *(const LAS f32x4*)(fb + 1 * TC * 64 + t8 * 64 + q * 4);
                    f32x4 bb = *(const LAS f32x4*)(fb + 2 * TC * 64 + t8 * 64 + q * 4), kp = *(const LAS f32x4*)(fb + 3 * TC * 64 + t8 * 64 + q * 4);
                    f32x4 r4 = *(const LAS f32x4*)(fb + 4 * TC * 64 + t8 * 64 + q * 4);
                    float vv = fb[5 * TC * 64 + t8 * 16 + il], bon = fb[5 * TC * 64 + TC * 16 + t8];
                    float keep = 0.f;
#pragma unroll
                    for (int u = 0; u < 8; ++u) {
                        const int tn = t8 + (u < 7 ? u + 1 : 7);
                        const f32x4 nkk_n = *(const LAS f32x4*)(fb + 0 * TC * 64 + tn * 64 + q * 4), dw_n = *(const LAS f32x4*)(fb + 1 * TC * 64 + tn * 64 + q * 4);
                        const f32x4 bb_n = *(const LAS f32x4*)(fb + 2 * TC * 64 + tn * 64 + q * 4), kp_n = *(const LAS f32x4*)(fb + 3 * TC * 64 + tn * 64 + q * 4);
                        const f32x4 r4_n = *(const LAS f32x4*)(fb + 4 * TC * 64 + tn * 64 + q * 4);
                        const float vv_n = fb[5 * TC * 64 + tn * 16 + il], bon_n = fb[5 * TC * 64 + TC * 16 + tn];
                        float sa0 = s.x * nkk.x, sa1 = s.z * nkk.z; sa0 = fmaf(s.y, nkk.y, sa0); sa1 = fmaf(s.w, nkk.w, sa1);
                        const float sa = row_sum16(sa0 + sa1);
                        s = s * dw + bb * sa + kp * vv;
                        float y0 = s.x * r4.x, y1 = s.z * r4.z; y0 = fmaf(s.y, r4.y, y0); y1 = fmaf(s.w, r4.w, y1);
                        const float y = row_sum16(y0 + y1);
                        const float val = (q < 8) ? y : bon * vv;
                        keep = ((q & 7) == u) ? val : keep;
                        nkk = nkk_n; dw = dw_n; bb = bb_n; kp = kp_n; r4 = r4_n; vv = vv_n; bon = bon_n;
                    }
                    ob[(q < 8 ? 0 : TC * 16) + (t8 + (q & 7)) * 16 + il] = keep;
                }
            }
            __syncthreads();
        }
        if (w < 4) *(f32x4*)(sout + (size_t)irow * 64 + q * 4) = s;
        else scan_flush(P, (const LAS float*)(lds + SC_OUT + ((nch - 1) & 1) * SC_OBUF), rowbase, (nch - 1) * TC, T, h, qi, tid - 256);
        __syncthreads();
    }
}

__device__ __forceinline__ int t5_bucket(int d) {
    if (d < 16) return d;
    int b = 16;
    b += (d >= 22) + (d >= 30) + (d >= 40) + (d >= 54) + (d >= 73) + (d >= 99) + (d >= 134) + (d >= 182) + (d >= 246) + (d >= 332) + (d >= 450) + (d >= 609) + (d >= 825) + (d >= 1117) + (d >= 1513);
    return b;
}
constexpr int BIAS_LD = 465, BIAS_OFF = 288;
constexpr int ATT_BIAS_BYTES = 3 * 16 * BIAS_LD * 4;
constexpr int ATT_WSCR = 12288;
__device__ __forceinline__ void vt_build(KPtr P, LAS unsigned char* lds) {
    const int tid = tid_fresh(); const int bid = bid_fresh(), gdim = gdim_fresh();
    const bf16_t* VB = (const bf16_t*)(P->ws + O_VB); bf16_t* VT = (bf16_t*)(P->ws + O_VT);
    const bf16_t* KB = (const bf16_t*)(P->ws + O_KB); bf16_t* KT = (bf16_t*)(P->ws + O_KT);
    constexpr int PITCH = 136;
    for (int it = bid; it < 384; it += gdim) {
        const int g = it % 3, un = it / 3, b = un >> 5, kvh = (un >> 3) & 3, tb = un & 7;
        const int sh = 2 * g;
        const int nblk_loc = 16 >> sh;
        const int nblk_tot = 128 >> sh;
#pragma unroll 1
        for (int kv = 0; kv < 2; ++kv) {
            const bf16_t* src = kv ? KB : VB;
            __syncthreads();
#pragma unroll
            for (int q = 0; q < 8; ++q) {
                const int idx = q * 512 + tid, t = idx >> 3, ch = idx & 7;
                const u32x4 v = *(const u32x4*)(src + ((size_t)(b * TP + tb * 512 + t)) * 256 + kvh * 64 + ch * 8);
                LAS u32x2* d = (LAS u32x2*)(lds + t * PITCH + ch * 16);
                d[0] = (u32x2){v.x, v.y}; d[1] = (u32x2){v.z, v.w};
            }
            __syncthreads();
            if (kv == 0) {
#pragma unroll 1
                for (int q = 0; q < 8; ++q) {
                    const int idx = q * 512 + tid;
                    const int oct = idx & 3, dim = (idx >> 2) & 63, cb = idx >> 8;
                    const int cls = cb / nblk_loc, lb = cb % nblk_loc;
                    unsigned short e[8];
#pragma unroll
                    for (int i = 0; i < 8; ++i) { const int pp = 16 * (oct >> 1) + 8 * (i >> 2) + 4 * (oct & 1) + (i & 3);
                        const int tl = ((lb * 32 + pp) << sh) + cls; e[i] = *(const LAS unsigned short*)(lds + tl * PITCH + dim * 2); }
                    u32x4 o; o.x = e[0] | ((unsigned)e[1] << 16); o.y = e[2] | ((unsigned)e[3] << 16); o.z = e[4] | ((unsigned)e[5] << 16); o.w = e[6] | ((unsigned)e[7] << 16);
                    const int blk = tb * nblk_loc + lb;
                    const int inner = ((((oct >> 1) * 2 + (dim >> 5)) * 2 + (oct & 1)) * 32 + (dim & 31)) * 8;
                    *(u32x4*)(VT + (size_t)g * VT_COPY + (size_t)((((b * 4 + kvh) << sh) + cls) * nblk_tot + blk) * 2048 + inner) = o;
                }
            } else {
#pragma unroll 1
                for (int q = 0; q < 8; ++q) {
                    const int idx = q * 512 + tid;
                    const int key = idx & 31, p = (idx >> 5) & 7, cb = idx >> 8;
                    const int cls = cb / nblk_loc, lb = cb % nblk_loc;
                    const int tl = ((lb * 32 + key) << sh) + cls;
                    const LAS u32x2* sp = (const LAS u32x2*)(lds + tl * PITCH + p * 16);
                    const u32x2 a0 = sp[0], a1 = sp[1];
                    const int blk = tb * nblk_loc + lb;
                    *(u32x4*)(KT + (size_t)g * VT_COPY + (size_t)((((b * 4 + kvh) << sh) + cls) * nblk_tot + blk) * 2048 + (p * 32 + key) * 8) = (u32x4){a0.x, a0.y, a1.x, a1.y};
                }
            }
        }
    }
    __syncthreads();
}
__device__ __forceinline__ void attn_phase(KPtr P, LAS unsigned char* lds) {
    const int tid = tid_fresh(), lane = tid & 63, w = __builtin_amdgcn_readfirstlane(tid >> 6);
    LAS float* bias = (LAS float*)lds;
    for (int e = tid; e < 3 * 16 * BIAS_LD; e += NTHREADS) {
        const int gh = e / BIAS_LD, x = e % BIAS_LD, g = gh >> 4, hd = gh & 15, j = BIAS_OFF - x;
        const int dil = g == 0 ? 1 : (g == 1 ? 4 : 16);
        float v = -1e30f;
        if (j >= 0 && j <= 128) v = P->in[34][t5_bucket(dil * j) * 48 + g * 16 + hd] * 1.4426950408889634f;
        bias[e] = v;
    }
    volatile LAS unsigned* ctr = (volatile LAS unsigned*)(lds + ATT_BIAS_BYTES + 4 * ATT_WSCR);
    if (tid == 0) ctr[0] = 0u;
    __syncthreads();
    const bf16_t* Q = (const bf16_t*)(P->ws + O_Q); const bf16_t* KT = (const bf16_t*)(P->ws + O_KT); const bf16_t* VT = (const bf16_t*)(P->ws + O_VT);
    bf16_t* ATT = (bf16_t*)(P->ws + O_ATT);
    const int bidx = bid_fresh(), gdimx = gdim_fresh();
    const int n = lane & 31, hh = lane >> 5, r = n >> 3, iq = n & 7;
    LAS float* qsc = (LAS float*)(lds + ATT_BIAS_BYTES + w * ATT_WSCR);
    LAS float* psc = qsc + 768;
    const float* cache = P->in[4]; const float* kvs = P->out + O_KVS;
#ifndef ATT_REP_S
#define ATT_REP_S 1
#endif
#ifndef ATT_MODE2
#define ATT_MODE2 0
#endif
#ifndef ATT_REP_P
#define ATT_REP_P 1
#endif
    if (w < 4)
    for (int reps_ = 0; reps_ < ATT_REP_S; ++reps_)
    for (int it = bidx * 4 + w; it < 1024; it += gdimx * 4) {
        const int b = it >> 5, t = (it >> 2) & 7, kvh = it & 3;
        const size_t qrow = (size_t)MP + b * TS + t;
        for (int e = lane; e < 768; e += 64) { const int g = e >> 8, rr2 = (e >> 6) & 3, d = e & 63; qsc[e] = bf2f(Q[qrow * 3072 + g * 1024 + kvh * 256 + rr2 * 64 + d]); }
        asm volatile("s_waitcnt lgkmcnt(0)" ::: "memory");
        float mx0 = -1e30f, mx1 = -1e30f, mx2 = -1e30f, mx3 = -1e30f;
#pragma unroll 1
        for (int gj = 0; gj < 9; ++gj) {
            const int g = gj / 3, jb = gj % 3, sh = 2 * g;
            const int j = jb * 64 + lane; const bool valid = j <= 128; const int jc = valid ? j : 128;
            const int pext = 2048 + t - (jc << sh);
            const float* kp = pext < 2048 ? cache + ((size_t)(b * 2048 + pext) * 2) * 256 + kvh * 64 : kvs + (size_t)(b * TS + (pext - 2048)) * 512 + kvh * 64;
            float d0 = 0.f, d1 = 0.f, d2 = 0.f, d3 = 0.f;
#pragma unroll 4
            for (int dd = 0; dd < 16; ++dd) {
                const f32x4 kv = *(const f32x4*)(kp + dd * 4);
                const f32x4 q0 = *(const LAS f32x4*)(qsc + g * 256 + 0 * 64 + dd * 4), q1 = *(const LAS f32x4*)(qsc + g * 256 + 1 * 64 + dd * 4);
                const f32x4 q2 = *(const LAS f32x4*)(qsc + g * 256 + 2 * 64 + dd * 4), q3 = *(const LAS f32x4*)(qsc + g * 256 + 3 * 64 + dd * 4);
                d0 += (kv.x * q0.x + kv.y * q0.y) + (kv.z * q0.z + kv.w * q0.w); d1 += (kv.x * q1.x + kv.y * q1.y) + (kv.z * q1.z + kv.w * q1.w);
                d2 += (kv.x * q2.x + kv.y * q2.y) + (kv.z * q2.z + kv.w * q2.w); d3 += (kv.x * q3.x + kv.y * q3.y) + (kv.z * q3.z + kv.w * q3.w);
            }
            const LAS float* bb = bias + (g * 16 + kvh * 4) * BIAS_LD + (BIAS_OFF - jc);
            const float v0 = valid ? d0 + bb[0] : -1e30f, v1 = valid ? d1 + bb[BIAS_LD] : -1e30f, v2 = valid ? d2 + bb[2 * BIAS_LD] : -1e30f, v3 = valid ? d3 + bb[3 * BIAS_LD] : -1e30f;
            psc[(g * 4 + 0) * 192 + j] = v0; psc[(g * 4 + 1) * 192 + j] = v1; psc[(g * 4 + 2) * 192 + j] = v2; psc[(g * 4 + 3) * 192 + j] = v3;
            mx0 = fmaxf(mx0, v0); mx1 = fmaxf(mx1, v1); mx2 = fmaxf(mx2, v2); mx3 = fmaxf(mx3, v3);
        }
#pragma unroll
        for (int o = 1; o < 64; o <<= 1) { mx0 = fmaxf(mx0, __shfl_xor(mx0, o)); mx1 = fmaxf(mx1, __shfl_xor(mx1, o)); mx2 = fmaxf(mx2, __shfl_xor(mx2, o)); mx3 = fmaxf(mx3, __shfl_xor(mx3, o)); }
        asm volatile("s_waitcnt lgkmcnt(0)" ::: "memory");
        float s0 = 0.f, s1 = 0.f, s2 = 0.f, s3 = 0.f;
#pragma unroll 1
        for (int gj = 0; gj < 9; ++gj) {
            const int g = gj / 3, j = (gj % 3) * 64 + lane;
            LAS float* pp = psc + (g * 4) * 192 + j;
            const float l0 = pp[0], l1 = pp[192], l2 = pp[384], l3 = pp[576];
            const float p0 = l0 > -1e29f ? __builtin_amdgcn_exp2f(l0 - mx0) : 0.f, p1 = l1 > -1e29f ? __builtin_amdgcn_exp2f(l1 - mx1) : 0.f, p2 = l2 > -1e29f ? __builtin_amdgcn_exp2f(l2 - mx2) : 0.f, p3 = l3 > -1e29f ? __builtin_amdgcn_exp2f(l3 - mx3) : 0.f;
            pp[0] = p0; pp[192] = p1; pp[384] = p2; pp[576] = p3;
            s0 += p0; s1 += p1; s2 += p2; s3 += p3;
        }
        s0 = wave_sum(s0); s1 = wave_sum(s1); s2 = wave_sum(s2); s3 = wave_sum(s3);
        asm volatile("s_waitcnt lgkmcnt(0)" ::: "memory");
        const int ksub = lane >> 4, dq = (lane & 15) * 4;
        f32x4 oa0 = (f32x4){0.f, 0.f, 0.f, 0.f}, oa1 = oa0, oa2 = oa0, oa3 = oa0;
#pragma unroll 1
        for (int g = 0; g < 3; ++g) {
            const int sh = 2 * g;
#pragma unroll 11
            for (int j0 = 0; j0 < 132; j0 += 4) {
                const int j = j0 + ksub; const int jc = j > 128 ? 128 : j;
                const int pext = 2048 + t - (jc << sh);
                const float* vp = pext < 2048 ? cache + ((size_t)(b * 2048 + pext) * 2 + 1) * 256 + kvh * 64 + dq : kvs + (size_t)(b * TS + (pext - 2048)) * 512 + 256 + kvh * 64 + dq;
                const f32x4 vv = *(const f32x4*)vp;
                const LAS float* pp = psc + (g * 4) * 192 + jc;
                const bool ok = j <= 128;
                const float p0 = ok ? pp[0] : 0.f, p1 = ok ? pp[192] : 0.f, p2 = ok ? pp[384] : 0.f, p3 = ok ? pp[576] : 0.f;
                oa0 = oa0 + vv * p0; oa1 = oa1 + vv * p1; oa2 = oa2 + vv * p2; oa3 = oa3 + vv * p3;
            }
        }
#pragma unroll
        for (int e = 0; e < 4; ++e) {
            oa0[e] += __shfl_xor(oa0[e], 16); oa0[e] += __shfl_xor(oa0[e], 32); oa1[e] += __shfl_xor(oa1[e], 16); oa1[e] += __shfl_xor(oa1[e], 32);
            oa2[e] += __shfl_xor(oa2[e], 16); oa2[e] += __shfl_xor(oa2[e], 32); oa3[e] += __shfl_xor(oa3[e], 16); oa3[e] += __shfl_xor(oa3[e], 32);
        }
        if (ksub == 0) {
            bf16_t* op = ATT + qrow * D + kvh * 256 + dq;
            const float i0 = 1.f / s0, i1 = 1.f / s1, i2 = 1.f / s2, i3 = 1.f / s3;
            u32x2 wv;
            wv.x = pk2(oa0.x * i0, oa0.y * i0); wv.y = pk2(oa0.z * i0, oa0.w * i0); *(u32x2*)(op) = wv;
            wv.x = pk2(oa1.x * i1, oa1.y * i1); wv.y = pk2(oa1.z * i1, oa1.w * i1); *(u32x2*)(op + 64) = wv;
            wv.x = pk2(oa2.x * i2, oa2.y * i2); wv.y = pk2(oa2.z * i2, oa2.w * i2); *(u32x2*)(op + 128) = wv;
            wv.x = pk2(oa3.x * i3, oa3.y * i3); wv.y = pk2(oa3.z * i3, oa3.w * i3); *(u32x2*)(op + 192) = wv;
        }
        asm volatile("s_waitcnt lgkmcnt(0)" ::: "memory");
    }
    const int per_cu = (4096 + gdimx - 1) / gdimx;
    for (;;) {
        int kx = 0;
        if (lane == 0) kx = (int)__hip_atomic_fetch_add((LAS unsigned*)ctr, 1u, __ATOMIC_RELAXED, __HIP_MEMORY_SCOPE_WORKGROUP);
        kx = __builtin_amdgcn_readfirstlane(kx);
        if (kx >= per_cu * ATT_REP_P) break;
        const int amode = (kx >= per_cu) ? ATT_MODE2 : 0;
        kx = kx % per_cu;
        const int it = bidx * per_cu + kx;
        if (it >= 4096) break;
        const int b = it >> 10, rem = it & 1023, kvh = rem >> 8, tg = rem & 255;
        const int tbase = (tg >> 4) * 256 + (tg & 15);
        const size_t qrowA = (size_t)b * TP + tbase + 16 * iq, qrowB = qrowA + 128;
        float mA = -1e4f, lA = 0.f, mB = -1e4f, lB = 0.f;
        f32x16 oA0, oA1, oB0, oB1;
#pragma unroll
        for (int e = 0; e < 16; ++e) { oA0[e] = 0.f; oA1[e] = 0.f; oB0[e] = 0.f; oB1[e] = 0.f; }
#pragma unroll 1
        for (int g = 0; g < 3; ++g) {
            const int sh = 2 * g, dmask = (1 << sh) - 1;
            const int c = tbase & dmask, u0 = tbase >> sh, qs = 16 >> sh;
            bf16x8 qfA[4], qfB[4];
            { const bf16_t* qp = Q + qrowA * 3072 + g * 1024 + kvh * 256 + r * 64 + hh * 8;
#pragma unroll
              for (int ks = 0; ks < 4; ++ks) { qfA[ks] = *(const bf16x8*)(qp + ks * 16); qfB[ks] = *(const bf16x8*)(qp + (size_t)128 * 3072 + ks * 16); } }
            const int ustart = (u0 - 128) & ~31;
            const int ntile = ((u0 + 15 * qs) >> 5) - (ustart >> 5) + 1;
            const int tau0 = ustart < 0 ? ((-ustart) >> 5) : 0;
            const int uqA = u0 + qs * iq, uqB = uqA + 8 * qs;
            const int tA1 = ((u0 + 7 * qs) - ustart) >> 5;
            const int tB0 = ((u0 + 8 * qs - 128) - ustart) >> 5;
            const size_t tile0 = (size_t)((((b * 4 + kvh) << sh) + c) * (128 >> sh) + (ustart >> 5)) * 2048;
            const bf16_t* Kg = KT + (size_t)g * VT_COPY + tile0 + hh * 256 + n * 8;
            const bf16_t* Vg = VT + (size_t)g * VT_COPY + tile0 + hh * 256 + n * 8;
            const LAS float* btA = bias + (g * 16 + kvh * 4 + r) * BIAS_LD + (BIAS_OFF - (uqA - ustart) + 4 * hh);
            const LAS float* btB = btA - 8 * qs;
            bf16x8 kfA[4], vfA[2][2], kfB[4], vfB[2][2];
#define ATT_LOAD(KF, VF, TAU) do { if (amode == 1 && (TAU) != tau0) break; \
                const bf16_t* kp_ = Kg + (size_t)(TAU) * 2048; \
                if (amode != 4) { _Pragma("unroll") for (int ks = 0; ks < 4; ++ks) KF[ks] = *(const bf16x8*)(kp_ + ks * 512); } \
                if (amode == 3) break; \
                const bf16_t* vb_ = Vg + (size_t)(TAU) * 2048; \
                _Pragma("unroll") for (int sI = 0; sI < 2; ++sI) { \
                    _Pragma("unroll") for (int dt = 0; dt < 2; ++dt) VF[sI][dt] = *(const bf16x8*)(vb_ + (sI * 2 + dt) * 512); } } while (0)
#define ATT_BLOCK(KF, VF, TAU, QF, BT0, MR, LR, O0, O1) do { \
                f32x16 S; _Pragma("unroll") for (int e = 0; e < 16; ++e) S[e] = 0.f; \
                _Pragma("unroll") for (int ks = 0; ks < 4; ++ks) S = __builtin_amdgcn_mfma_f32_32x32x16_bf16(KF[ks], QF[ks], S, 0, 0, 0); \
                const LAS float* bt = BT0 + 32 * (TAU); \
                float mx = -1e30f; \
                _Pragma("unroll") for (int e = 0; e < 16; ++e) { S[e] += bt[(e >> 2) * 8 + (e & 3)]; } \
                _Pragma("unroll") for (int e = 0; e < 16; ++e) mx = fmaxf(mx, S[e]); \
                mx = fmaxf(mx, __shfl_xor(mx, 32)); \
                if (__any(mx > MR + 8.0f)) { const float m_new = fmaxf(MR, mx); const float alpha = __builtin_amdgcn_exp2f(MR - m_new); MR = m_new; LR *= alpha; \
                    _Pragma("unroll") for (int e = 0; e < 16; ++e) { O0[e] *= alpha; O1[e] *= alpha; } } \
                float ps = 0.f; \
                _Pragma("unroll") for (int e = 0; e < 16; ++e) { const float p = __builtin_amdgcn_exp2f(S[e] - MR); S[e] = p; ps += p; } \
                LR += ps; \
                _Pragma("unroll") for (int sI = 0; sI < 2; ++sI) { \
                    u32x4 pw; pw.x = pk2(S[8 * sI + 0], S[8 * sI + 1]); pw.y = pk2(S[8 * sI + 2], S[8 * sI + 3]); pw.z = pk2(S[8 * sI + 4], S[8 * sI + 5]); pw.w = pk2(S[8 * sI + 6], S[8 * sI + 7]); \
                    const bf16x8 pb = __builtin_bit_cast(bf16x8, pw); \
                    O0 = __builtin_amdgcn_mfma_f32_32x32x16_bf16(VF[sI][0], pb, O0, 0, 0, 0); \
                    O1 = __builtin_amdgcn_mfma_f32_32x32x16_bf16(VF[sI][1], pb, O1, 0, 0, 0); } } while (0)
#define ATT_TILE(KF, VF, TAU) do { if (amode >= 2) { asm volatile("" :: "v"(KF[0]), "v"(KF[3]), "v"(VF[0][0]), "v"(VF[1][1])); break; } \
                if ((TAU) <= tA1) ATT_BLOCK(KF, VF, TAU, qfA, btA, mA, lA, oA0, oA1); \
                if ((TAU) >= tB0) ATT_BLOCK(KF, VF, TAU, qfB, btB, mB, lB, oB0, oB1); } while (0)
            ATT_LOAD(kfA, vfA, tau0);
            int tau = tau0;
#pragma unroll 1
            for (; tau + 1 < ntile; tau += 2) {
                ATT_LOAD(kfB, vfB, tau + 1);
                ATT_TILE(kfA, vfA, tau);
                { const int tn = (tau + 2 < ntile) ? tau + 2 : tau + 1; ATT_LOAD(kfA, vfA, tn); }
                ATT_TILE(kfB, vfB, tau + 1);
            }
            if (tau < ntile) ATT_TILE(kfA, vfA, tau);
#undef ATT_LOAD
#undef ATT_BLOCK
#undef ATT_TILE
        }
#define ATT_OUT(QROW, LR, O0, O1) do { \
            const float lt = LR + __shfl_xor(LR, 32); const float inv = 1.f / lt; \
            bf16_t* op = ATT + (QROW) * D + kvh * 256 + r * 64 + hh * 4; \
            _Pragma("unroll") for (int e4 = 0; e4 < 4; ++e4) { \
                u32x2 w0; w0.x = pk2(O0[e4 * 4 + 0] * inv, O0[e4 * 4 + 1] * inv); w0.y = pk2(O0[e4 * 4 + 2] * inv, O0[e4 * 4 + 3] * inv); \
                u32x2 w1; w1.x = pk2(O1[e4 * 4 + 0] * inv, O1[e4 * 4 + 1] * inv); w1.y = pk2(O1[e4 * 4 + 2] * inv, O1[e4 * 4 + 3] * inv); \
                if (amode == 0) { *(u32x2*)(op + e4 * 8) = w0; *(u32x2*)(op + 32 + e4 * 8) = w1; } else { asm volatile("" :: "v"(w0), "v"(w1)); } } } while (0)
        ATT_OUT(qrowA, lA, oA0, oA1);
        ATT_OUT(qrowB, lB, oB0, oB1);
#undef ATT_OUT
    }
}

#define XB_TMO      128
#define XB_XCNT(j)  (256  + 64 * (j))
#define XB_XSUB(j)  (1280 + 64 * (j))
#define XB_XGEN(j)  (2304 + 64 * (j))
#define XB_TOP      3328
#define XB_TOPGEN   3392
#define XCD_BAR_WORDS 3456
#define XB_SPIN_CAP (1u << 18)
__device__ __forceinline__ unsigned xb_ld(unsigned* p)              { return __hip_atomic_load(p, __ATOMIC_RELAXED, __HIP_MEMORY_SCOPE_AGENT); }
__device__ __forceinline__ unsigned xb_add(unsigned* p, unsigned v) { return __hip_atomic_fetch_add(p, v, __ATOMIC_RELAXED, __HIP_MEMORY_SCOPE_AGENT); }
__device__ __forceinline__ unsigned xb_xcc_id() { return (unsigned)__builtin_amdgcn_s_getreg((3 << 11) | 20) & 0xFu; }
#define XB_SPIN(cond, bar) do { unsigned _sp = 0; while (cond) { __builtin_amdgcn_s_sleep(1); \
    if ((++_sp & 255u) == 0u) { if (xb_ld(&(bar)[XB_TMO])) break; if (_sp > XB_SPIN_CAP) { atomicAdd(&(bar)[XB_TMO], 1u); break; } } } } while (0)
struct XcdBarrier { unsigned* bar; unsigned x; volatile LAS unsigned* st; };
__device__ __forceinline__ XcdBarrier xcd_barrier_post(unsigned* bar, volatile LAS unsigned* st) {
    XcdBarrier b; b.bar = bar; b.x = xb_xcc_id(); b.st = st;
    if (threadIdx.x == 0) (void)xb_add(&bar[XB_XCNT(b.x)], 1u);
    return b;
}
__device__ __forceinline__ void xcd_barrier_complete(unsigned* bar, unsigned x, unsigned& nloc, unsigned& nx) {
    const unsigned G = gridDim.x * gridDim.y * gridDim.z;
    unsigned sum, cnt, mine, sp = 0u;
    for (;;) {
        sum = 0u; cnt = 0u; mine = 0u;
#pragma unroll
        for (unsigned j = 0; j < 16; ++j) { const unsigned c = xb_ld(&bar[XB_XCNT(j)]); sum += c; cnt += (c > 0u) ? 1u : 0u; mine = (j == x) ? c : mine; }
        if (sum == G) break;
        __builtin_amdgcn_s_sleep(1);
        if ((++sp & 255u) == 0u) { if (xb_ld(&bar[XB_TMO])) break; if (sp > XB_SPIN_CAP) { atomicAdd(&bar[XB_TMO], 1u); break; } }
    }
    nloc = mine > 0u ? mine : 1u; nx = cnt > 0u ? cnt : 1u;
}
__device__ __forceinline__ void xcd_barrier(const XcdBarrier& b) {
    asm volatile("s_waitcnt vmcnt(0)" ::: "memory");
    __syncthreads();
    if (threadIdx.x == 0) {
        unsigned* bar = b.bar;
        __builtin_amdgcn_s_waitcnt(0);
        unsigned nloc = b.st[0], nx = b.st[1];
        if (nloc == 0u) { xcd_barrier_complete(bar, b.x, nloc, nx); b.st[0] = nloc; b.st[1] = nx; }
        const unsigned old = xb_add(&bar[XB_XSUB(b.x)], 1u);
        const unsigned gen = old / nloc;
        if (old + 1u == (gen + 1u) * nloc) {
            __builtin_amdgcn_fence(__ATOMIC_RELEASE, "agent");
            asm volatile("s_waitcnt vmcnt(0)" ::: "memory");
            const unsigned og = xb_add(&bar[XB_TOP], 1u);
            const unsigned tg = og / nx;
            if (og + 1u == (tg + 1u) * nx) xb_add(&bar[XB_TOPGEN], 1u);
            else XB_SPIN(xb_ld(&bar[XB_TOPGEN]) == tg, bar);
            __builtin_amdgcn_fence(__ATOMIC_ACQUIRE, "agent");
            xb_add(&bar[XB_XGEN(b.x)], 1u);
            asm volatile("s_waitcnt vmcnt(0)" ::: "memory");
        } else {
            XB_SPIN(xb_ld(&bar[XB_XGEN(b.x)]) == gen, bar);
            __builtin_amdgcn_fence(__ATOMIC_ACQUIRE, "agent");
            asm volatile("s_waitcnt vmcnt(0)" ::: "memory");
        }
    }
    __syncthreads();
}

constexpr int LDS_BYTES = LDS_BYTES_ALL; static_assert(ATT_BIAS_BYTES + 4 * ATT_WSCR + 64 <= LDS_CTL_OFF && STAGE_BYTES <= LDS_CTL_OFF, "LDS");
__global__ void __launch_bounds__(NTHREADS, 2) fwd_kernel(Params P) {
    extern __shared__ __attribute__((aligned(16))) unsigned char lds_raw[];
    LAS unsigned char* lds = (LAS unsigned char*)lds_raw;
    (void)P;
#ifdef CODE_PREFETCH
    {
        const char* pcb = (const char*)((unsigned long long)__builtin_amdgcn_s_getpc() & ~0xFFull);
        u32x4 acc = (u32x4){0u, 0u, 0u, 0u};
        for (int off = (int)threadIdx.x * 16; off < CODE_PREFETCH; off += NTHREADS * 16) { const u32x4 v = *(const u32x4*)(pcb + off); acc.x ^= v.x; acc.y ^= v.y; acc.z ^= v.z; acc.w ^= v.w; }
        if ((acc.x ^ acc.y ^ acc.z ^ acc.w) == 0x9e3779b9u && threadIdx.x == 12345u) ((volatile LAS unsigned*)lds)[0] = acc.x;
    }
#endif
    volatile LAS unsigned* bst = (volatile LAS unsigned*)(lds + LDS_CTL_OFF);
    if (threadIdx.x < 4) bst[threadIdx.x] = 0u;
    __syncthreads();
    { KPtr kp = kp_fresh(); (void)xcd_barrier_post((unsigned*)(kp->ws + O_CTL), bst); }
#ifndef REPEAT_MASK
#define REPEAT_MASK 0
#endif
#ifndef DRY_MASK
#define DRY_MASK 0
#endif
#ifndef ZS_MASK
#define ZS_MASK 0
#endif
#ifndef EXTRA_SYNCS
#define EXTRA_SYNCS 0
#endif
#pragma unroll 1
    for (int ph = 0; ph < NPH; ++ph) {
      const int reps = (((REPEAT_MASK | DRY_MASK | ZS_MASK) >> ph) & 1) ? 2 : 1;
#pragma unroll 1
      for (int rep = 0; rep < reps; ++rep) {
#ifdef REP_BARRIER
        if (rep > 0) { KPtr kp = kp_fresh(); XcdBarrier xb; xb.bar = (unsigned*)(kp->ws + O_CTL); xb.x = xb_xcc_id(); xb.st = (volatile LAS unsigned*)(lds + LDS_CTL_OFF); xcd_barrier(xb); }
#endif
        if (ph == PH_PRO) {
#ifndef NO_PRO
            prologue_phase(kp_fresh(), lds);
#endif
        }
        else if (ph == PH_MIX) {
#ifndef NO_ROW
            mix_pass(kp_fresh());
#endif
        }
        else if (ph == PH_SCAN) {
#ifndef NO_SCAN
            scan_phase(kp_fresh(), lds);
#endif
        }
        else if (ph == PH_POST) {
#ifndef NO_ROW
            post_pass(kp_fresh());
#endif
        }
        else if (ph == PH_ATTN) {
#ifndef NO_ATTN
            vt_build(kp_fresh(), lds);
            { KPtr kp = kp_fresh(); XcdBarrier xb; xb.bar = (unsigned*)(kp->ws + O_CTL); xb.x = xb_xcc_id(); xb.st = (volatile LAS unsigned*)(lds + LDS_CTL_OFF); xcd_barrier(xb); }
            attn_phase(kp_fresh(), lds);
#endif
        }
        else if (ph == PH_FINAL) {
#ifndef NO_ROW
            final_pass(kp_fresh());
#endif
        }
        else {
#ifndef NO_GEMM
#pragma unroll 1
            for (int pass2 = 0; pass2 < 2; ++pass2) {
                KPtr kp = kp_fresh();
                if (pass2) {
                    if (!(ph == PH_F2I1 && gdim_fresh() == 256 && bid_fresh() >= 252)) break;
                    if (threadIdx.x < 64) {
                        unsigned* dep = (unsigned*)(kp->ws + O_CTL) + CW_DEP + (20 + ph) * 64; unsigned sp = 0;
                        while ((unsigned)__builtin_amdgcn_readfirstlane(__hip_atomic_load(dep, __ATOMIC_RELAXED, __HIP_MEMORY_SCOPE_AGENT)) < 4u) { __builtin_amdgcn_s_sleep(2); if (++sp > (1u << 22)) break; }
                        __builtin_amdgcn_fence(__ATOMIC_ACQUIRE, "agent");
                    }
                    __syncthreads();
                }
                gemm_phase(kp->ws, kp->out, lds, ph, (rep == 0 && ((DRY_MASK >> ph) & 1)) ? 1 : ((rep == 0 && ((ZS_MASK >> ph) & 1)) ? 2 : 0), pass2);
            }
#endif
        }
      }
        if (ph + 1 < NPH) { KPtr kp = kp_fresh(); XcdBarrier xb; xb.bar = (unsigned*)(kp->ws + O_CTL); xb.x = xb_xcc_id(); xb.st = (volatile LAS unsigned*)(lds + LDS_CTL_OFF); xcd_barrier(xb); }
    }
}

extern "C" void kernel_launch(void* const* d_in, const int* in_sizes, int n_in, void* d_out, int out_size, void* d_ws, size_t ws_size, hipStream_t stream) {
    static int grid_blocks = 0;
    if (grid_blocks == 0) {
        if (n_in != 36 || ws_size < WS_END) { fprintf(stderr, "kernel_launch: unexpected n_in %d or ws_size %zu (< %zu)\n", n_in, ws_size, (size_t)WS_END); grid_blocks = -1; return; }
        int dev = 0, cus = 0, per_cu = 0;
        hipGetDevice(&dev);
        hipDeviceGetAttribute(&cus, hipDeviceAttributeMultiprocessorCount, dev);
        hipFuncSetAttribute((const void*)fwd_kernel, hipFuncAttributeMaxDynamicSharedMemorySize, LDS_BYTES);
        hipOccupancyMaxActiveBlocksPerMultiprocessor(&per_cu, (const void*)fwd_kernel, NTHREADS, LDS_BYTES);
        if (per_cu < 1) { fprintf(stderr, "kernel_launch: occupancy query says %d blocks per CU\n", per_cu); grid_blocks = -1; return; }
        grid_blocks = cus;
    }
    if (grid_blocks < 0) return;
    if (hipMemsetAsync((char*)d_ws + O_CTL, 0, CTL_BYTES, stream) != hipSuccess) { fprintf(stderr, "kernel_launch: memset failed\n"); return; }
    Params p{};
    for (int i = 0; i < 36; ++i) p.in[i] = (const float*)d_in[i];
    p.out = (float*)d_out; p.ws = (unsigned char*)d_ws;
    void* args[] = {&p};
    hipError_t e = hipLaunchCooperativeKernel((const void*)fwd_kernel, dim3(grid_blocks), dim3(NTHREADS), args, LDS_BYTES, stream);
    if (e != hipSuccess) fprintf(stderr, "cooperative launch failed: %s (grid %d)\n", hipGetErrorString(e), grid_blocks);
}
```

```cpp
#include <hip/hip_runtime.h>
#include <cstdio>
#include <cstdint>

#define LAS __attribute__((address_space(3)))
typedef unsigned short bf16_t;
typedef short bf16x8 __attribute__((ext_vector_type(8)));
typedef float f32x4 __attribute__((ext_vector_type(4)));
typedef float f32x2 __attribute__((ext_vector_type(2)));
typedef float f32x16 __attribute__((ext_vector_type(16)));
typedef unsigned u32x4 __attribute__((ext_vector_type(4)));
typedef unsigned u32x2 __attribute__((ext_vector_type(2)));
typedef __bf16 bf16x2_t __attribute__((ext_vector_type(2)));

constexpr int D = 1024, FF = 2816, MP = 16384, MS = 256, M = MP + MS, TP = 4096, TS = 8;
constexpr int NTHREADS = 512;
constexpr float RMS_EPS = 1e-6f;
constexpr size_t O_YP = 0, O_YS = 16777216, O_WKVP = 17039360, O_SHP = 17301504, O_KVP = 17305600, O_WKVS = 21499904, O_SHS = 23597056, O_KVS = 23629824;
constexpr size_t SL = (size_t)M * 1024 * 2;
constexpr size_t W_F1I = 0;
constexpr size_t W_F2I = W_F1I + 2 * (size_t)5632 * 1024 * 2;
constexpr size_t W_F1O = W_F2I + 2 * (size_t)5632 * 1024 * 2;
constexpr size_t W_F2O = W_F1O + 2 * (size_t)1024 * 2816 * 2;
constexpr size_t W_PEG = W_F2O + 2 * (size_t)1024 * 2816 * 2;
constexpr size_t W_PEP = W_PEG + 2 * (size_t)1024 * 1024 * 2;
constexpr size_t W_RKV = W_PEP + 2 * (size_t)1024 * 256 * 2;
constexpr size_t W_L1 = W_RKV + (size_t)3072 * 1024 * 2;
constexpr size_t W_L2W = W_L1 + (size_t)768 * 1024 * 2;
constexpr size_t W_L2A = W_L2W + (size_t)1024 * 128 * 2;
constexpr size_t W_L2G = W_L2A + (size_t)1024 * 128 * 2;
constexpr size_t W_RWO = W_L2G + (size_t)1024 * 256 * 2;
constexpr size_t W_Q = W_RWO + (size_t)1024 * 1024 * 2;
constexpr size_t W_KV = W_Q + (size_t)3072 * 1024 * 2;
constexpr size_t W_AO = W_KV + (size_t)512 * 1024 * 2;
constexpr size_t W_END = W_AO + (size_t)1024 * 1024 * 2;
constexpr size_t O_HB0 = (W_END + 4095) & ~(size_t)4095;
constexpr size_t O_HB1 = O_HB0 + SL;
constexpr size_t O_SSQ0 = O_HB1 + SL;
constexpr size_t O_SSQ1 = O_SSQ0 + (size_t)M * 16 * 4;
constexpr size_t O_PB = O_SSQ1 + (size_t)M * 16 * 4;
constexpr size_t O_R2 = O_PB + 2 * (size_t)M * 256 * 2;
constexpr size_t R2_BYTES = (size_t)128 << 20;
constexpr size_t O_R4 = O_R2 + R2_BYTES;
constexpr size_t O_CTL = O_R4 + 6 * SL;
constexpr size_t CTL_BYTES = 65536;
constexpr size_t O_PAR = O_CTL + 32768;
constexpr size_t WS_END = O_CTL + CTL_BYTES;
constexpr size_t O_ACT = O_R2;
constexpr size_t O_RKVB = O_R2;
constexpr size_t O_MW = O_R2 + (size_t)M * 3072 * 2;
constexpr size_t O_MA = O_MW + (size_t)M * 128 * 2;
constexpr size_t O_MG = O_MA + (size_t)M * 128 * 2;
constexpr size_t O_YG = O_R2;
static_assert(O_MG + (size_t)M * 256 * 2 <= O_R2 + R2_BYTES, "R2");
constexpr size_t O_WL = O_R4, O_AL = O_R4 + SL, O_GG = O_R4 + 2 * SL, O_Y = O_R4 + 3 * SL, O_BON = O_R4 + 4 * SL, O_PP = O_R4 + 5 * SL;
constexpr size_t O_Q = O_R4, O_ATT = O_R4 + 3 * SL, O_KB = O_R4 + 4 * SL, O_VT = O_KB + (size_t)MP * 256 * 2;
constexpr size_t O_VB = O_R2 + ((size_t)96 << 20);
static_assert(O_VB >= O_ACT + (size_t)M * FF * 2 && O_VB + (size_t)MP * 256 * 2 <= O_R2 + R2_BYTES, "VB");
constexpr size_t VT_COPY = (size_t)MP * 256;
constexpr size_t O_KT = O_R2 + ((size_t)104 << 20);
static_assert(O_KT >= O_VB + (size_t)MP * 256 * 2 && O_KT + 3 * VT_COPY * 2 <= O_R2 + R2_BYTES, "KT");
static_assert(O_VT + 3 * VT_COPY * 2 <= O_R4 + 5 * SL, "R4 slot 4");

struct Params { const float* in[36]; float* out; unsigned char* ws; };
typedef const Params __attribute__((address_space(4)))* KPtr;
__device__ __forceinline__ int tid_fresh() { int t = threadIdx.x; asm volatile("" : "+v"(t)); return t; }
__device__ __forceinline__ int bid_fresh() { int t = blockIdx.x; asm volatile("" : "+s"(t)); return t; }
__device__ __forceinline__ int gdim_fresh() { int t = gridDim.x; asm volatile("" : "+s"(t)); return t; }
__device__ __forceinline__ KPtr kp_fresh() { KPtr p = (KPtr)__builtin_amdgcn_kernarg_segment_ptr(); asm volatile("" : "+s"(p)); return p; }

__device__ __forceinline__ unsigned pk2(float lo, float hi) { f32x2 v = {lo, hi}; bf16x2_t b = __builtin_convertvector(v, bf16x2_t); return __builtin_bit_cast(unsigned, b); }
__device__ __forceinline__ float bf2f(unsigned short h) { return __builtin_bit_cast(float, (unsigned)h << 16); }
__device__ __forceinline__ float bflo(unsigned w) { return __builtin_bit_cast(float, w << 16); }
__device__ __forceinline__ float bfhi(unsigned w) { return __builtin_bit_cast(float, w & 0xffff0000u); }
template <int CTRL> __device__ __forceinline__ float dpp_mov(float x) { return __builtin_bit_cast(float, __builtin_amdgcn_update_dpp(0, __builtin_bit_cast(int, x), CTRL, 0xF, 0xF, true)); }
__device__ __forceinline__ float row_sum16(float x) {
    x += dpp_mov<0x128>(x); x += dpp_mov<0x124>(x); x += dpp_mov<0x122>(x); x += dpp_mov<0x121>(x); return x;
}
__device__ __forceinline__ float wave_sum(float v) {
#pragma unroll
    for (int o = 1; o < 64; o <<= 1) v += __shfl_xor(v, o);
    return v;
}
__device__ __forceinline__ float rstd_of(const float* ssq, int row) {
    const f32x4* p = (const f32x4*)(ssq + (size_t)row * 16);
    const f32x4 a = p[0], b = p[1], c = p[2], d = p[3];
    const float s = ((a.x + a.y) + (a.z + a.w)) + ((b.x + b.y) + (b.z + b.w)) + ((c.x + c.y) + (c.z + c.w)) + ((d.x + d.y) + (d.z + d.w));
    return __builtin_amdgcn_rsqf(s * (1.0f / 1024.0f) + RMS_EPS);
}
struct F8 { float v[8]; };
__device__ __forceinline__ F8 unpack8(u32x4 w) { F8 r; r.v[0] = bflo(w.x); r.v[1] = bfhi(w.x); r.v[2] = bflo(w.y); r.v[3] = bfhi(w.y); r.v[4] = bflo(w.z); r.v[5] = bfhi(w.z); r.v[6] = bflo(w.w); r.v[7] = bfhi(w.w); return r; }
__device__ __forceinline__ u32x4 pack8(const F8& f) { u32x4 w; w.x = pk2(f.v[0], f.v[1]); w.y = pk2(f.v[2], f.v[3]); w.z = pk2(f.v[4], f.v[5]); w.w = pk2(f.v[6], f.v[7]); return w; }
__device__ __forceinline__ F8 load8f(const float* p) { const f32x4 a = *(const f32x4*)p, b = *(const f32x4*)(p + 4); F8 r; r.v[0] = a.x; r.v[1] = a.y; r.v[2] = a.z; r.v[3] = a.w; r.v[4] = b.x; r.v[5] = b.y; r.v[6] = b.z; r.v[7] = b.w; return r; }
__device__ __forceinline__ float row_sum8(float x) {
    x += dpp_mov<0xB1>(x); x += dpp_mov<0x4E>(x); x += dpp_mov<0x141>(x); return x;
}
__device__ __forceinline__ float sigmoidf_(float x) { return __builtin_amdgcn_rcpf(1.0f + __expf(-x)); }

constexpr int LDS_BYTES_ALL = 147456, LDS_CTL_OFF = LDS_BYTES_ALL - 2048;
constexpr int BM = 256, BK = 64, HALF = 128, HTB = HALF * BK * 2, STAGE_BYTES = 8 * HTB, NXCD = 8, WGM = 8;
__host__ __device__ __forceinline__ int lds_byte(int r, int c) { const int st = (r >> 4) * 2 + (c >> 5), rr = r & 15, cc = c & 31, ob = rr * 64 + cc * 2; return st * 1024 + (ob ^ (((ob >> 9) & 1) << 5)); }
__host__ __device__ __forceinline__ void stage_rc(int b, int& R, int& C) { const int st = b / 1024, sb = b % 1024, swz = sb ^ (((sb >> 9) & 1) << 5); R = (st >> 1) * 16 + swz / 64; C = (st & 1) * 32 + (swz % 64) / 2; }

enum { EPI_SWIGLU = 0, EPI_RESID = 1, EPI_PE = 2, EPI_BF16 = 3, EPI_KV = 4 };
struct Unit { const char* A; const char* B; int pitchA, pitchB, nt, si, pm, pn, wait, eph; };
struct Epi { int epi; void* o0; const float* ssq_in; float* ssq_out; const bf16_t* pbuf; float scale; int opitch, ocol0, ncols, act; };

enum { PH_PRO = 0, PH_F1I0, PH_F1O0, PH_MIX, PH_RKV, PH_L2, PH_SCAN, PH_POST, PH_RWO, PH_F2I0, PH_F2O0, PH_PE0,
       PH_F1I1, PH_F1O1, PH_QKV, PH_ATTN, PH_AO, PH_F2I1, PH_F2O1, PH_PE1, PH_FINAL, NPH };

__device__ __forceinline__ bool get_gemm(unsigned char* ws, int ph, int si, Unit& u, int& nN) {
    size_t a = 0, b = 0; int pA = 2048, pB = 2048, nt = 16; nN = 4;
    switch (ph) {
    case PH_F1I0: case PH_F2I0: case PH_F1I1: case PH_F2I1: {
        if (si > 0) return false;
        const int l = (ph == PH_F1I1 || ph == PH_F2I1) ? 1 : 0; const bool f2 = (ph == PH_F2I0 || ph == PH_F2I1);
        a = O_HB0; b = (f2 ? W_F2I : W_F1I) + (size_t)l * 5632 * 1024 * 2; nN = 22; break; }
    case PH_F1O0: case PH_F1O1: {
        if (si > 0) return false;
        a = O_ACT; b = W_F1O + (size_t)(ph == PH_F1O1 ? 1 : 0) * 1024 * 2816 * 2; pA = 5632; pB = 5632; nt = 44; break; }
    case PH_F2O0: case PH_F2O1: {
        const int l = (ph == PH_F2O1) ? 1 : 0;
        if (si == 0) { a = O_ACT; b = W_F2O + (size_t)l * 1024 * 2816 * 2; pA = 5632; pB = 5632; nt = 44; }
        else if (si == 1) { a = O_PB + (size_t)l * M * 256 * 2; b = W_PEP + (size_t)l * 1024 * 256 * 2; pA = 512; pB = 512; nt = 4; }
        else return false;
        break; }
    case PH_RKV: {
        if (si < 3) { const int xi = (si == 0) ? 0 : (si == 1 ? 2 : 3); a = O_R4 + (size_t)xi * SL; b = W_RKV + (size_t)si * 1024 * 1024 * 2; }
        else if (si < 6) { const int j = si - 3; const int xi = (j == 0) ? 1 : (j == 1 ? 4 : 5); a = O_R4 + (size_t)xi * SL; b = W_L1 + (size_t)j * 256 * 1024 * 2; nN = 1; }
        else return false;
        break; }
    case PH_L2: {
        if (si == 0) { a = O_MG; b = W_L2G; pA = 512; pB = 512; nt = 4; }
        else if (si == 1) { a = O_MW; b = W_L2W; pA = 256; pB = 256; nt = 2; }
        else if (si == 2) { a = O_MA; b = W_L2A; pA = 256; pB = 256; nt = 2; }
        else return false;
        break; }
    case PH_RWO: if (si > 0) return false; a = O_YG; b = W_RWO; break;
    case PH_AO: if (si > 0) return false; a = O_ATT; b = W_AO; break;
    case PH_PE0: case PH_PE1: if (si > 0) return false; a = O_HB1; b = W_PEG + (size_t)(ph == PH_PE1 ? 1 : 0) * 1024 * 1024 * 2; break;
    case PH_QKV: {
        if (si == 0) { a = O_HB1; b = W_Q; nN = 12; }
        else if (si == 1) { a = O_HB0; b = W_KV; nN = 2; }
        else return false;
        break; }
    default: return false;
    }
    u.A = (const char*)(ws + a); u.B = (const char*)(ws + b); u.pitchA = pA; u.pitchB = pB; u.nt = nt; u.si = si; u.wait = 0; u.eph = ph; return true;
}
__device__ __forceinline__ void get_epi(unsigned char* ws, int ph, int si, Epi& s) {
    s.epi = EPI_BF16; s.o0 = nullptr; s.ssq_in = nullptr; s.ssq_out = nullptr; s.pbuf = nullptr; s.scale = 1.f; s.opitch = 1024; s.ocol0 = 0; s.ncols = 1024; s.act = 0;
    const float* ssq0 = (const float*)(ws + O_SSQ0); const float* ssq1 = (const float*)(ws + O_SSQ1);
    switch (ph) {
    case PH_F1I0: case PH_F2I0: case PH_F1I1: case PH_F2I1: s.epi = EPI_SWIGLU; s.o0 = ws + O_ACT; s.ssq_in = ssq0; break;
    case PH_F1O0: case PH_F1O1: s.epi = EPI_RESID; s.scale = 0.5f; s.o0 = ws + O_HB1; s.ssq_out = (float*)(ws + O_SSQ1); break;
    case PH_F2O0: case PH_F2O1:
        if (si == 0) { s.epi = EPI_RESID; s.scale = 0.5f; s.o0 = ws + O_HB1; s.ssq_out = (float*)(ws + O_SSQ1); }
        else { s.o0 = ws + O_PP; }
        break;
    case PH_RKV:
        if (si < 3) { s.o0 = ws + O_RKVB; s.opitch = 3072; s.ocol0 = si * 1024; }
        else { const int j = si - 3; s.o0 = ws + (j == 0 ? O_MW : (j == 1 ? O_MA : O_MG)); s.opitch = (j == 2) ? 256 : 128; s.ncols = s.opitch; s.act = (j == 0) ? 1 : (j == 1 ? 0 : 2); }
        break;
    case PH_L2: s.o0 = ws + (si == 0 ? O_GG : (si == 1 ? O_WL : O_AL)); s.act = (si == 0) ? 0 : (si == 1 ? 3 : 4); break;
    case PH_RWO: case PH_AO: s.epi = EPI_RESID; s.o0 = ws + O_HB0; s.ssq_out = (float*)(ws + O_SSQ0); break;
    case PH_PE0: case PH_PE1: s.epi = EPI_PE; s.o0 = ws + O_HB0; s.ssq_in = ssq1; s.ssq_out = (float*)(ws + O_SSQ0); s.pbuf = (const bf16_t*)(ws + O_PP); break;
    case PH_QKV:
        if (si == 0) { s.o0 = ws + O_Q; s.opitch = 3072; s.ncols = 3072; s.ssq_in = ssq1; }
        else { s.epi = EPI_KV; s.ssq_in = ssq0; }
        break;
    default: break;
    }
}

__device__ __forceinline__ void decode_tile(int L, int nM, int nN, int& pm, int& pn) {
    const int nwg = nM * nN;
    int wgid = L; { const int q = nwg / NXCD, r = nwg % NXCD, xcd = wgid % NXCD, off = wgid / NXCD; wgid = (xcd < r ? xcd * (q + 1) : r * (q + 1) + (xcd - r) * q) + off; }
    const int nig = WGM * nN, gid = wgid / nig, fm = gid * WGM, gsz = (nM - fm) < WGM ? (nM - fm) : WGM;
    pm = fm + ((wgid % nig) % gsz); pn = (wgid % nig) / gsz;
}
constexpr int CW_DEP = 4096;
__device__ __forceinline__ bool is_wi(int ph) { return ph == PH_F1I0 || ph == PH_F2I0 || ph == PH_F1I1 || ph == PH_F2I1; }
__device__ __forceinline__ bool is_wo(int ph) { return ph == PH_F1O0 || ph == PH_F2O0 || ph == PH_F1O1 || ph == PH_F2O1; }
__device__ __forceinline__ bool next_unit(unsigned char* ws, int ph, int i, int G, int c, Unit& u, int pass2) {
    int nN;
    if (pass2) {
        if (G == 256 && ph == PH_F2I1 && c >= 252 && i == 0) { get_gemm(ws, PH_PE1, 0, u, nN); u.pm = 64; u.pn = c - 252; u.wait = 8; u.eph = PH_PE1; return true; }
        return false;
    }
    if (G == 256 && is_wi(ph)) {
        const int pre = (ph == PH_F2I0) ? PH_RWO : (ph == PH_F1I1 ? PH_PE0 : (ph == PH_F2I1 ? PH_AO : -1));
        int L; int wt = 0;
        if (c >= 252) {
            if (i < 3) L = i * 256 + c;
            else if (i == 3) { get_gemm(ws, ph + 1, 0, u, nN); u.pm = 64; u.pn = c - 252; u.wait = 1; u.eph = ph + 1; return true; }
            else return false;
        } else if (pre >= 0 && c >= 248) {
            if (i == 0) { get_gemm(ws, pre, 0, u, nN); u.pm = 64; u.pn = c - 248; u.eph = pre; return true; }
            L = (i - 1) * 256 + c;
            if (L >= 1430) return false;
        } else {
            L = i * 256 + c;
            if (pre >= 0 && c < 22) L = (i + 1) * 256 + c;
            else if (pre >= 0 && c >= 160 && c < 182) { if (i == 2) { L = c - 160; wt = 2; } else if (i > 2) L = (i - 1) * 256 + c; }
            if (L >= 1430) {
                if (i == 5 && c >= 150 && c < 158) { const int k = c - 150; L = (3 + (k >> 2)) * 256 + 252 + (k & 3); }
                else if (pre >= 0 && (i == 5 || i == 6) && c >= 158 && c < 248 && !(c >= 160 && c < 182)) {
                    const int e = c < 160 ? c - 158 : c - 180, k = e * 2 + (i - 5);
                    if (k >= 130) return false;
                    const int fo = (ph == PH_F1I1) ? PH_F2O1 : (ph == PH_F2I1 ? PH_F2O1 : PH_F2O0);
                    const int idx = (ph == PH_F2I1) ? 126 + k : (ph == PH_F1I1 && k >= 126 ? k + 130 : k);
                    get_gemm(ws, fo, 1, u, nN); u.eph = fo; u.pm = idx >> 2; u.pn = idx & 3; return true;
                } else return false;
            }
        }
        get_gemm(ws, ph, 0, u, nN);
        if (L < 22) { u.pm = 64; u.pn = L; u.wait = wt; } else decode_tile(L - 22, 64, 22, u.pm, u.pn);
        return true;
    }
    int L = i * G + c;
    for (int si = 0; si < 6; ++si) {
        if (!get_gemm(ws, ph, si, u, nN)) return false;
        const int nM = (G == 256 && (is_wo(ph) || ph == PH_RWO || ph == PH_PE0 || ph == PH_PE1 || ph == PH_AO) && si == 0) ? 64 : M / BM;
        if (G == 256 && (ph == PH_F2O0 || ph == PH_F2O1) && si == 1) {
            const int first = (ph == PH_F2O0) ? 130 : 260, cnt = 260 - first;
            if (L < cnt) { const int idx = first + L; u.pm = idx >> 2; u.pn = idx & 3; return true; }
            L -= cnt; continue;
        }
        const int nwg = nM * nN;
        if (L < nwg) { decode_tile(L, nM, nN, u.pm, u.pn); return true; }
        L -= nwg;
    }
    return false;
}

template <int ACT>
__device__ __forceinline__ void epi_act(unsigned char* ws, f32x4 (&acc)[2][2][4][2], const Epi& s, const Unit& u, bf16_t* ob, int row0, int wc, int fq) {
#pragma unroll
    for (int bj = 0; bj < 2; ++bj) {
        const int lc = u.pn * BM + bj * HALF + wc * 32 + fq * 8;
        if (lc >= s.ncols) continue;
        float pa_[8], pb_[8];
#pragma unroll
        for (int q8 = 0; q8 < 8; ++q8) { pa_[q8] = 0.f; pb_[q8] = 0.f; }
        if (ACT >= 3) {
            const float* par = (const float*)(ws + O_PAR) + (ACT == 3 ? 0 : 2048) + lc;
            const f32x4 x0 = *(const f32x4*)par, x1 = *(const f32x4*)(par + 4);
            pa_[0] = x0.x; pa_[1] = x0.y; pa_[2] = x0.z; pa_[3] = x0.w; pa_[4] = x1.x; pa_[5] = x1.y; pa_[6] = x1.z; pa_[7] = x1.w;
            if (ACT == 3) { const f32x4 y0 = *(const f32x4*)(par + 1024), y1 = *(const f32x4*)(par + 1028);
                pb_[0] = y0.x; pb_[1] = y0.y; pb_[2] = y0.z; pb_[3] = y0.w; pb_[4] = y1.x; pb_[5] = y1.y; pb_[6] = y1.z; pb_[7] = y1.w; }
        }
#pragma unroll
        for (int ai = 0; ai < 2; ++ai)
#pragma unroll
            for (int m = 0; m < 4; ++m) {
                const int row = row0 + ai * HALF + m * 16;
                float o[8];
#pragma unroll
                for (int n = 0; n < 2; ++n)
#pragma unroll
                    for (int e = 0; e < 4; ++e) {
                        float v = acc[ai][bj][m][n][e];
                        if (ACT == 1) { const float t = __expf(2.f * v); v = 1.f - 2.f * __builtin_amdgcn_rcpf(t + 1.f); }
                        else if (ACT == 2) v = sigmoidf_(v);
                        else if (ACT == 3) v = sigmoidf_(v + pa_[n * 4 + e]) - pb_[n * 4 + e];
                        else v = sigmoidf_(v + pa_[n * 4 + e]);
                        o[n * 4 + e] = v;
                    }
                u32x4 w; w.x = pk2(o[0], o[1]); w.y = pk2(o[2], o[3]); w.z = pk2(o[4], o[5]); w.w = pk2(o[6], o[7]);
                *(u32x4*)(ob + (size_t)row * s.opitch + s.ocol0 + lc) = w;
            }
    }
}

template <bool PE>
__device__ __forceinline__ void epi_resid(unsigned char* ws, f32x4 (&acc)[2][2][4][2], const Epi& s, const Unit& u, const LAS float* rtab, int row0, int lrow0, int wc, int fq, float zs) {
    bf16_t* hb = (bf16_t*)s.o0; const bf16_t* hin = (const bf16_t*)(ws + (hb == (bf16_t*)(ws + O_HB1) ? O_HB0 : O_HB1));
    const int colb = u.pn * BM + wc * 32 + fq * 8;
    const float sc = s.scale * zs;
    u32x4 hn[2], pn_[2];
#pragma unroll
    for (int bj = 0; bj < 2; ++bj) {
        const size_t off = (size_t)row0 * D + colb + bj * HALF;
        hn[bj] = *(const u32x4*)(hin + off); pn_[bj] = (u32x4){0u, 0u, 0u, 0u};
        if (PE) pn_[bj] = *(const u32x4*)(s.pbuf + off);
    }
#pragma unroll
    for (int g = 0; g < 8; ++g) {
        const int ai = g >> 2, m = g & 3;
        const int row = row0 + ai * HALF + m * 16;
        u32x4 hc[2], pc[2];
#pragma unroll
        for (int bj = 0; bj < 2; ++bj) { hc[bj] = hn[bj]; pc[bj] = pn_[bj]; }
        if (g < 7) {
            const int rown = row0 + ((g + 1) >> 2) * HALF + ((g + 1) & 3) * 16;
#pragma unroll
            for (int bj = 0; bj < 2; ++bj) {
                const size_t off = (size_t)rown * D + colb + bj * HALF;
                hn[bj] = *(const u32x4*)(hin + off);
                if (PE) pn_[bj] = *(const u32x4*)(s.pbuf + off);
            }
        }
        float rs = 1.f; if (PE) rs = rtab[lrow0 + ai * HALF + m * 16];
        float sq = 0.f;
#pragma unroll
        for (int bj = 0; bj < 2; ++bj) {
            const size_t off = (size_t)row * D + colb + bj * HALF;
            const unsigned hw[4] = {hc[bj].x, hc[bj].y, hc[bj].z, hc[bj].w}, pw[4] = {pc[bj].x, pc[bj].y, pc[bj].z, pc[bj].w};
            unsigned ow[4];
#pragma unroll
            for (int n = 0; n < 2; ++n) {
                const f32x4 a = acc[ai][bj][m][n];
                f32x4 h = (f32x4){bflo(hw[2 * n]), bfhi(hw[2 * n]), bflo(hw[2 * n + 1]), bfhi(hw[2 * n + 1])};
                if (PE) {
                    h.x += zs * sigmoidf_(a.x * rs) * bflo(pw[2 * n]); h.y += zs * sigmoidf_(a.y * rs) * bfhi(pw[2 * n]);
                    h.z += zs * sigmoidf_(a.z * rs) * bflo(pw[2 * n + 1]); h.w += zs * sigmoidf_(a.w * rs) * bfhi(pw[2 * n + 1]);
                } else { h = h + a * sc; }
                ow[2 * n] = pk2(h.x, h.y); ow[2 * n + 1] = pk2(h.z, h.w);
                sq += (h.x * h.x + h.y * h.y) + (h.z * h.z + h.w * h.w);
            }
            *(u32x4*)(hb + off) = (u32x4){ow[0], ow[1], ow[2], ow[3]};
        }
        sq += __shfl_xor(sq, 16); sq += __shfl_xor(sq, 32);
        if (fq == 0) s.ssq_out[(size_t)row * 16 + u.pn * 4 + wc] = sq;
    }
}

__device__ __forceinline__ void epilogue(unsigned char* ws, float* outp, int ph, f32x4 (&acc)[2][2][4][2], const Unit& u, int wr, int wc, int fr, int fq, LAS unsigned char* lds, float zs) {
    Epi s; get_epi(ws, u.eph, u.si, s);
    const LAS float* rtab = (const LAS float*)(lds + LDS_CTL_OFF + 1024);
    if (s.ssq_in) {
        const int t = threadIdx.x;
        if (t < 256) ((LAS float*)(lds + LDS_CTL_OFF + 1024))[t] = rstd_of(s.ssq_in, u.pm * BM + t);
        __syncthreads();
    }
    const int lrow0 = wr * 64 + fr;
    const int row0 = u.pm * BM + wr * 64 + fr;
    if (s.epi == EPI_SWIGLU) {
        bf16_t* act = (bf16_t*)s.o0;
        const int col = u.pn * 128 + wc * 32 + fq * 8;
#pragma unroll
        for (int ai = 0; ai < 2; ++ai)
#pragma unroll
            for (int m = 0; m < 4; ++m) {
                const int row = row0 + ai * HALF + m * 16;
                const float rs = rtab[lrow0 + ai * HALF + m * 16];
                float o[8];
#pragma unroll
                for (int n = 0; n < 2; ++n)
#pragma unroll
                    for (int e = 0; e < 4; ++e) { const float g = acc[ai][0][m][n][e] * rs, up = acc[ai][1][m][n][e] * rs; o[n * 4 + e] = g * sigmoidf_(g) * up; }
                u32x4 w; w.x = pk2(o[0], o[1]); w.y = pk2(o[2], o[3]); w.z = pk2(o[4], o[5]); w.w = pk2(o[6], o[7]);
                if (u.pm == 64) {
                    unsigned long long* p8 = (unsigned long long*)(act + (size_t)row * FF + col);
                    __hip_atomic_store(p8, ((unsigned long long)w.y << 32) | w.x, __ATOMIC_RELAXED, __HIP_MEMORY_SCOPE_AGENT);
                    __hip_atomic_store(p8 + 1, ((unsigned long long)w.w << 32) | w.z, __ATOMIC_RELAXED, __HIP_MEMORY_SCOPE_AGENT);
                } else *(u32x4*)(act + (size_t)row * FF + col) = w;
            }
        if (u.pm == 64) {
            asm volatile("s_waitcnt vmcnt(0)" ::: "memory");
            __syncthreads();
            if (threadIdx.x == 0) __hip_atomic_fetch_add((unsigned*)(ws + O_CTL) + CW_DEP + ph * 64, 1u, __ATOMIC_RELAXED, __HIP_MEMORY_SCOPE_AGENT);
        }
    } else if (s.epi == EPI_RESID || s.epi == EPI_PE) {
        if (s.epi == EPI_PE) epi_resid<true>(ws, acc, s, u, rtab, row0, lrow0, wc, fq, zs);
        else epi_resid<false>(ws, acc, s, u, rtab, row0, lrow0, wc, fq, zs);
        if (u.eph != ph && (u.wait == 0 || (u.wait == 1 && ph == PH_F2I1))) {
            asm volatile("s_waitcnt vmcnt(0)" ::: "memory");
            __syncthreads();
            if (threadIdx.x == 0) {
                __builtin_amdgcn_fence(__ATOMIC_RELEASE, "agent");
                asm volatile("s_waitcnt vmcnt(0)" ::: "memory");
                __hip_atomic_fetch_add((unsigned*)(ws + O_CTL) + CW_DEP + ((u.wait == 1 ? 20 : 32) + ph) * 64, 1u, __ATOMIC_RELAXED, __HIP_MEMORY_SCOPE_AGENT);
            }
        }
    } else if (s.epi == EPI_BF16) {
        bf16_t* ob = (bf16_t*)s.o0;
        if (s.act == 0) {
#pragma unroll
            for (int ai = 0; ai < 2; ++ai)
#pragma unroll
                for (int m = 0; m < 4; ++m) {
                    const int row = row0 + ai * HALF + m * 16;
                    float rs = 1.f; if (s.ssq_in) rs = rtab[lrow0 + ai * HALF + m * 16];
#pragma unroll
                    for (int bj = 0; bj < 2; ++bj) {
                        const int lc = u.pn * BM + bj * HALF + wc * 32 + fq * 8;
                        const f32x4 v0 = acc[ai][bj][m][0] * rs, v1 = acc[ai][bj][m][1] * rs;
                        if (lc < s.ncols) {
                            u32x4 w; w.x = pk2(v0.x, v0.y); w.y = pk2(v0.z, v0.w); w.z = pk2(v1.x, v1.y); w.w = pk2(v1.z, v1.w);
                            *(u32x4*)(ob + (size_t)row * s.opitch + s.ocol0 + lc) = w;
                        }
                    }
                }
        } else if (s.act == 1) epi_act<1>(ws, acc, s, u, ob, row0, wc, fq);
        else if (s.act == 2) epi_act<2>(ws, acc, s, u, ob, row0, wc, fq);
        else if (s.act == 3) epi_act<3>(ws, acc, s, u, ob, row0, wc, fq);
        else epi_act<4>(ws, acc, s, u, ob, row0, wc, fq);
    } else {
        bf16_t* kb = (bf16_t*)(ws + O_KB); bf16_t* vt = (bf16_t*)(ws + O_VT);
#pragma unroll
        for (int ai = 0; ai < 2; ++ai)
#pragma unroll
            for (int m = 0; m < 4; ++m) {
                const int row = row0 + ai * HALF + m * 16;
                const float rs = rtab[lrow0 + ai * HALF + m * 16];
                const bool isP = row < MP; const int b = row >> 12, t = row & 4095;
                float* fo = nullptr;
                if (isP) { if (t >= 2048) fo = outp + O_KVP + ((size_t)(b * 2048 + (t - 2048)) * 512) + u.pn * 256; }
                else fo = outp + O_KVS + (size_t)(row - MP) * 512 + u.pn * 256;
#pragma unroll
                for (int bj = 0; bj < 2; ++bj) {
                    const int c = bj * HALF + wc * 32 + fq * 8;
                    const f32x4 v0 = acc[ai][bj][m][0] * rs, v1 = acc[ai][bj][m][1] * rs;
                    if (fo) { *(f32x4*)(fo + c) = v0; *(f32x4*)(fo + c + 4) = v1; }
                    if (isP) {
                        u32x4 w; w.x = pk2(v0.x, v0.y); w.y = pk2(v0.z, v0.w); w.z = pk2(v1.x, v1.y); w.w = pk2(v1.z, v1.w);
                        *(u32x4*)((u.pn == 0 ? kb : (bf16_t*)(ws + O_VB)) + (size_t)row * 256 + c) = w;
                    }
                }
            }
    }
}

__device__ __forceinline__ void gemm_phase(unsigned char* ws, float* outp, LAS unsigned char* lds, int ph, int dry, int pass2) {
    const int tid = tid_fresh(), wid = __builtin_amdgcn_readfirstlane(tid >> 6), lane = tid & 63, wr = wid >> 2, wc = wid & 3, fr = lane & 15, fq = lane >> 4;
    const int G = gdim_fresh(), cidx = bid_fresh();
    int R0, C0; stage_rc(tid * 16, R0, C0);
    const unsigned ldsw = (unsigned)wid * 1024u;
    const int aoff = lds_byte(wr * 64 + fr, fq * 8), boff = lds_byte(wc * 32 + fr, fq * 8);
    const size_t kstep = (size_t)(BK * 2);
#define PG8_SA(b, h) (((b) * 2 + (h)) * HTB)
#define PG8_SB(b, h) ((4 + (b) * 2 + (h)) * HTB)
#define PG8_STAGE(bufoff, gbase, voff, p64) do { \
        __builtin_amdgcn_global_load_lds((const unsigned*)((const char*)(gbase) + (voff)), (LAS unsigned*)(lds + (bufoff) + ldsw), 16, 0, 0); \
        __builtin_amdgcn_global_load_lds((const unsigned*)((const char*)(gbase) + (voff) + (p64)), (LAS unsigned*)(lds + (bufoff) + ldsw + 8192), 16, 0, 0); } while (0)
#define PG8_LDA(dst, b, h) do { _Pragma("unroll") for (int m = 0; m < 4; ++m) _Pragma("unroll") for (int k = 0; k < 2; ++k) dst[m][k] = *(const LAS bf16x8*)(lds + PG8_SA(b, h) + aoff + m * 2048 + k * 1024); } while (0)
#define PG8_LDB(dst, b, h) do { _Pragma("unroll") for (int n = 0; n < 2; ++n) _Pragma("unroll") for (int k = 0; k < 2; ++k) dst[n][k] = *(const LAS bf16x8*)(lds + PG8_SB(b, h) + boff + n * 2048 + k * 1024); } while (0)
#define PG8_MMA(ai, bj, At, Bt) do { __builtin_amdgcn_s_setprio(1); _Pragma("unroll") for (int m = 0; m < 4; ++m) _Pragma("unroll") for (int n = 0; n < 2; ++n) _Pragma("unroll") for (int k = 0; k < 2; ++k) \
        acc[ai][bj][m][n] = __builtin_amdgcn_mfma_f32_16x16x32_bf16(Bt[n][k], At[m][k], acc[ai][bj][m][n], 0, 0, 0); __builtin_amdgcn_s_setprio(0); } while (0)
#define PG8_WAIT_V(n) asm volatile("s_waitcnt vmcnt(" #n ")" ::: "memory")
#define PG8_WAIT_L(n) asm volatile("s_waitcnt lgkmcnt(" #n ")" ::: "memory")
#define PG8_BAR __builtin_amdgcn_s_barrier()
#define PG8_SCHED __builtin_amdgcn_sched_barrier(0)
    Unit cur, nxt; int ui = 0;
    if (!next_unit(ws, ph, 0, G, cidx, cur, pass2)) return;
    f32x4 acc[2][2][4][2];
#pragma unroll
    for (int a = 0; a < 2; ++a)
#pragma unroll
        for (int b = 0; b < 2; ++b)
#pragma unroll
            for (int m = 0; m < 4; ++m)
#pragma unroll
                for (int n = 0; n < 2; ++n) acc[a][b][m][n] = (f32x4){0.f, 0.f, 0.f, 0.f};
    bf16x8 At[4][2], B0[2][2], B1[2][2];
    const char* cA = cur.A + (size_t)cur.pm * 256 * cur.pitchA; const char* cB = cur.B + (size_t)cur.pn * 256 * cur.pitchB;
    unsigned vA = (unsigned)(R0 * cur.pitchA + C0 * 2), vB = (unsigned)(R0 * cur.pitchB + C0 * 2);
    unsigned hA = (unsigned)HALF * cur.pitchA, hB = (unsigned)HALF * cur.pitchB; unsigned pA = 64u * cur.pitchA, pB = 64u * cur.pitchB;
    PG8_STAGE(PG8_SB(0, 0), cB, vB, pB); PG8_STAGE(PG8_SB(0, 1), cB + hB, vB, pB); PG8_STAGE(PG8_SA(0, 0), cA, vA, pA); PG8_STAGE(PG8_SA(0, 1), cA + hA, vA, pA);
    if (wr == 1) PG8_BAR;
    PG8_WAIT_V(2); PG8_BAR;
    PG8_STAGE(PG8_SB(1, 0), cB + kstep, vB, pB); PG8_STAGE(PG8_SA(1, 0), cA + kstep, vA, pA); PG8_STAGE(PG8_SB(1, 1), cB + hB + kstep, vB, pB);
    PG8_WAIT_V(6); PG8_BAR;
    for (;;) {
        const bool has_next = next_unit(ws, ph, ui + 1, G, cidx, nxt, pass2);
        const char* nA = has_next ? nxt.A + (size_t)nxt.pm * 256 * nxt.pitchA : cA; const char* nB = has_next ? nxt.B + (size_t)nxt.pn * 256 * nxt.pitchB : cB;
        const int npA = has_next ? nxt.pitchA : cur.pitchA, npB = has_next ? nxt.pitchB : cur.pitchB;
        const unsigned nvA = (unsigned)(R0 * npA + C0 * 2), nvB = (unsigned)(R0 * npB + C0 * 2);
        const unsigned nhA = (unsigned)HALF * npA, nhB = (unsigned)HALF * npB; const unsigned nppA = 64u * npA, nppB = 64u * npB;
        const int nt = cur.nt;
        for (int t = 0; t < nt; t += 2) {
            const bool last = (t == nt - 2);
            if (last && has_next && nxt.wait) {
                if (wid == 0) {
                    unsigned* dep = (unsigned*)(ws + O_CTL) + CW_DEP + (nxt.wait == 2 ? 32 + ph : (nxt.wait == 4 ? 20 + ph : ph)) * 64; unsigned sp = 0; const unsigned need = (nxt.wait == 1) ? 22u : 4u;
                    while ((unsigned)__builtin_amdgcn_readfirstlane(__hip_atomic_load(dep, __ATOMIC_RELAXED, __HIP_MEMORY_SCOPE_AGENT)) < need) { __builtin_amdgcn_s_sleep(2); if (++sp > (1u << 22)) break; }
                    __builtin_amdgcn_fence(__ATOMIC_ACQUIRE, "agent");
                    asm volatile("s_waitcnt vmcnt(0)" ::: "memory");
                }
                asm volatile("" ::: "memory"); PG8_BAR; asm volatile("" ::: "memory");
            }
            const char* a1 = cA + (size_t)(t + 1) * kstep;
            const char* a2 = last ? nA : cA + (size_t)(t + 2) * kstep; const char* b2 = last ? nB : cB + (size_t)(t + 2) * kstep;
            const char* a3 = a2 + kstep; const char* b3 = b2 + kstep;
            const unsigned vA2 = last ? nvA : vA, vB2 = last ? nvB : vB, pA2 = last ? nppA : pA, pB2 = last ? nppB : pB;
            const unsigned hA2 = last ? nhA : hA, hB2 = last ? nhB : hB;
            PG8_LDB(B0, 0, 0); PG8_LDB(B1, 0, 1); PG8_SCHED; PG8_LDA(At, 0, 0); PG8_STAGE(PG8_SA(1, 1), a1 + hA, vA, pA);
            PG8_WAIT_V(8); PG8_WAIT_L(0); PG8_BAR; PG8_MMA(0, 0, At, B0); PG8_MMA(0, 1, At, B1); PG8_BAR; PG8_SCHED;
            PG8_LDA(At, 0, 1); PG8_STAGE(PG8_SB(0, 0), b2, vB2, pB2); PG8_STAGE(PG8_SB(0, 1), b2 + hB2, vB2, pB2); PG8_STAGE(PG8_SA(0, 0), a2, vA2, pA2);
            PG8_WAIT_V(8); PG8_WAIT_L(0); PG8_BAR; PG8_MMA(1, 0, At, B0); PG8_MMA(1, 1, At, B1); PG8_BAR; PG8_SCHED;
            PG8_LDB(B0, 1, 0); PG8_LDB(B1, 1, 1); PG8_SCHED; PG8_LDA(At, 1, 0); PG8_STAGE(PG8_SA(0, 1), a2 + hA2, vA2, pA2);
            PG8_WAIT_V(8); PG8_WAIT_L(0); PG8_BAR; PG8_MMA(0, 0, At, B0); PG8_MMA(0, 1, At, B1); PG8_BAR; PG8_SCHED;
            PG8_LDA(At, 1, 1); PG8_STAGE(PG8_SB(1, 0), b3, vB2, pB2); PG8_STAGE(PG8_SB(1, 1), b3 + hB2, vB2, pB2); PG8_STAGE(PG8_SA(1, 0), a3, vA2, pA2);
            PG8_WAIT_V(8); PG8_WAIT_L(0); PG8_BAR; PG8_MMA(1, 0, At, B0); PG8_MMA(1, 1, At, B1); PG8_BAR; PG8_SCHED;
        }
        if (wr == 0) PG8_BAR;
        if (dry != 1) epilogue(ws, outp, ph, acc, cur, wr, wc, fr, fq, lds, dry == 2 ? 0.f : 1.f);
        if (!has_next) break;
#pragma unroll
        for (int a = 0; a < 2; ++a)
#pragma unroll
            for (int b = 0; b < 2; ++b)
#pragma unroll
                for (int m = 0; m < 4; ++m)
#pragma unroll
                    for (int n = 0; n < 2; ++n) acc[a][b][m][n] = (f32x4){0.f, 0.f, 0.f, 0.f};
        cur = nxt; cA = nA; cB = nB; vA = nvA; vB = nvB; hA = nhA; hB = nhB; pA = nppA; pB = nppB; ++ui;
        if (wr == 1) PG8_BAR;
    }
    PG8_WAIT_V(0);
    PG8_BAR;
#undef PG8_SA
#undef PG8_SB
#undef PG8_STAGE
#undef PG8_LDA
#undef PG8_LDB
#undef PG8_MMA
#undef PG8_WAIT_V
#undef PG8_WAIT_L
#undef PG8_BAR
#undef PG8_SCHED
}

struct Job { int src, soff, Ksrc, Nsrc, Kdst, Ndst, gidx, goff, map; size_t dst; float scal; };
__device__ __forceinline__ int pinv32(int l) { return 16 * ((l >> 2) & 1) + 4 * (l >> 3) + (l & 3); }
__device__ __forceinline__ Job get_job(int j) {
    Job b; b.gidx = -1; b.goff = 0; b.scal = 1.f; b.map = 0; b.soff = 0;
    if (j < 4) { const int l = j & 1, f2 = j >> 1; b.src = f2 ? 10 : 8; b.soff = l * 1024 * 5632; b.Ksrc = 1024; b.Nsrc = 5632; b.Kdst = 1024; b.Ndst = 5632; b.gidx = 7; b.goff = l * 4096 + (f2 ? 2048 : 0); b.map = 2;
                 b.dst = (f2 ? W_F2I : W_F1I) + (size_t)l * 5632 * 1024 * 2; return b; }
    if (j < 8) { const int l = j & 1, f2 = (j - 4) >> 1; b.src = f2 ? 11 : 9; b.soff = l * 2816 * 1024; b.Ksrc = 2816; b.Nsrc = 1024; b.Kdst = 2816; b.Ndst = 1024; b.map = 1;
                 b.dst = (f2 ? W_F2O : W_F1O) + (size_t)l * 1024 * 2816 * 2; return b; }
    if (j < 10) { const int l = j - 8; b.src = 13; b.soff = l * 1024 * 1024; b.Ksrc = 1024; b.Nsrc = 1024; b.Kdst = 1024; b.Ndst = 1024; b.gidx = 7; b.goff = l * 4096 + 3072; b.map = 1; b.dst = W_PEG + (size_t)l * 1024 * 1024 * 2; return b; }
    if (j < 12) { const int l = j - 10; b.src = 12; b.soff = l * 256 * 1024; b.Ksrc = 256; b.Nsrc = 1024; b.Kdst = 256; b.Ndst = 1024; b.map = 1; b.dst = W_PEP + (size_t)l * 1024 * 256 * 2; return b; }
    if (j < 15) { const int q = j - 12; b.src = 15; b.soff = q * 1024 * 1024; b.Ksrc = 1024; b.Nsrc = 1024; b.Kdst = 1024; b.Ndst = 1024; b.map = 1; b.dst = W_RKV + (size_t)q * 1024 * 1024 * 2; return b; }
    if (j == 15) { b.src = 16; b.Ksrc = 1024; b.Nsrc = 1024; b.Kdst = 1024; b.Ndst = 1024; b.map = 1; b.dst = W_RWO; return b; }
    if (j == 16) { b.src = 18; b.Ksrc = 1024; b.Nsrc = 64; b.Kdst = 1024; b.Ndst = 256; b.map = 1; b.dst = W_L1; return b; }
    if (j == 17) { b.src = 21; b.Ksrc = 1024; b.Nsrc = 64; b.Kdst = 1024; b.Ndst = 256; b.map = 1; b.dst = W_L1 + (size_t)256 * 1024 * 2; return b; }
    if (j == 18) { b.src = 23; b.Ksrc = 1024; b.Nsrc = 160; b.Kdst = 1024; b.Ndst = 256; b.map = 1; b.dst = W_L1 + (size_t)512 * 1024 * 2; return b; }
    if (j == 19) { b.src = 19; b.Ksrc = 64; b.Nsrc = 1024; b.Kdst = 128; b.Ndst = 1024; b.map = 1; b.dst = W_L2W; return b; }
    if (j == 20) { b.src = 22; b.Ksrc = 64; b.Nsrc = 1024; b.Kdst = 128; b.Ndst = 1024; b.map = 1; b.dst = W_L2A; return b; }
    if (j == 21) { b.src = 24; b.Ksrc = 160; b.Nsrc = 1024; b.Kdst = 256; b.Ndst = 1024; b.map = 1; b.dst = W_L2G; return b; }
    if (j == 22) { b.src = 30; b.Ksrc = 1024; b.Nsrc = 3072; b.Kdst = 1024; b.Ndst = 3072; b.map = 1; b.gidx = 7; b.goff = 4096 + 1024; b.scal = 0.125f * 1.4426950408889634f; b.dst = W_Q; return b; }
    if (j == 23) { b.src = 31; b.Ksrc = 1024; b.Nsrc = 1024; b.Kdst = 1024; b.Ndst = 1024; b.map = 1; b.dst = W_AO; return b; }
    b.src = 33; b.Ksrc = 1024; b.Nsrc = 512; b.Kdst = 1024; b.Ndst = 512; b.gidx = 32; b.map = 1; b.dst = W_KV; return b;
}
constexpr int NJOBS = 25;
__device__ __forceinline__ const float* sel_in(KPtr P, int i) { return P->in[i]; }
__device__ __forceinline__ void prologue_phase(KPtr P, LAS unsigned char* lds) {
    const int tid = tid_fresh(), lane = tid & 63, wave = __builtin_amdgcn_readfirstlane(tid >> 6);
    const int bid = bid_fresh(), gdim = gdim_fresh();
    const int gw = bid * 8 + wave, NGW = gdim * 8;
    LAS unsigned char* scr = lds + wave * 9216;
    int base = 0;
    for (int j = 0; j < NJOBS; ++j) {
        const Job jb = get_job(j);
        const int nkb = jb.Kdst / 64, nnb = jb.Ndst / 64, nit = nkb * nnb;
        const float* W = sel_in(P, jb.src) + jb.soff; const float* gv = jb.gidx >= 0 ? sel_in(P, jb.gidx) + jb.goff : nullptr;
        bf16_t* dst = (bf16_t*)(P->ws + jb.dst);
        int first = (gw - (base % NGW) + NGW) % NGW;
        for (int it = first; it < nit; it += NGW) {
            const int kb = it / nnb, nb = it % nnb, k0 = kb * 64, n0 = nb * 64;
            const int nn4 = (lane & 15) * 4, n = n0 + nn4;
            f32x4 v[16];
#pragma unroll
            for (int i = 0; i < 16; ++i) {
                const int k = k0 + 4 * i + (lane >> 4);
                v[i] = (f32x4){0.f, 0.f, 0.f, 0.f};
                if (k < jb.Ksrc && n < jb.Nsrc) v[i] = *(const f32x4*)(W + (size_t)k * jb.Nsrc + n);
            }
#pragma unroll
            for (int i = 0; i < 16; ++i) {
                const int kk = 4 * i + (lane >> 4), k = k0 + kk;
                float sc = jb.scal; if (gv && k < jb.Ksrc) sc *= gv[k];
                const f32x4 x = v[i] * sc;
                LAS bf16_t* sp = (LAS bf16_t*)(scr + nn4 * 144 + kk * 2);
                sp[0] = (bf16_t)(pk2(x.x, 0.f) & 0xffffu); sp[72] = (bf16_t)(pk2(x.y, 0.f) & 0xffffu); sp[144] = (bf16_t)(pk2(x.z, 0.f) & 0xffffu); sp[216] = (bf16_t)(pk2(x.w, 0.f) & 0xffffu);
            }
            asm volatile("s_waitcnt lgkmcnt(0)" ::: "memory");
            int rbase;
            if (jb.map == 2) { const int isUp = n0 >= 2816 ? 1 : 0, j0 = n0 - isUp * 2816; rbase = 256 * (j0 >> 7) + 128 * isUp + (j0 & 127); }
            else rbase = n0;
            const int c = lane & 7;
#pragma unroll
            for (int q = 0; q < 8; ++q) {
                const int nn = (lane >> 3) + 8 * q;
                const u32x4 o = *(const LAS u32x4*)(scr + nn * 144 + c * 16);
                const int drow = rbase + (jb.map ? ((nn & 32) + pinv32(nn & 31)) : nn);
                *(u32x4*)(dst + (size_t)drow * jb.Kdst + k0 + 8 * c) = o;
            }
            asm volatile("s_waitcnt lgkmcnt(0)" ::: "memory");
        }
        base += nit;
    }
    if (bid == 0) { float* par = (float*)(P->ws + O_PAR); for (int e = tid; e < 1024; e += NTHREADS) { const float w0v = P->in[17][e]; par[e] = w0v; par[1024 + e] = sigmoidf_(w0v); par[2048 + e] = P->in[20][e]; } }
    bf16_t* hb0 = (bf16_t*)(P->ws + O_HB0); float* ssq0 = (float*)(P->ws + O_SSQ0);
    for (int row = gw; row < M; row += NGW) {
        const float* src = row < MP ? P->in[0] + (size_t)row * D : P->in[1] + (size_t)(row - MP) * D;
        float sq = 0.f;
#pragma unroll
        for (int j = 0; j < 2; ++j) {
            const int c = 8 * lane + 512 * j;
            const F8 v = load8f(src + c);
            *(u32x4*)(hb0 + (size_t)row * D + c) = pack8(v);
#pragma unroll
            for (int q = 0; q < 8; ++q) sq += v.v[q] * v.v[q];
        }
        sq = wave_sum(sq);
        if (lane < 16) ssq0[(size_t)row * 16 + lane] = (lane == 0) ? sq : 0.f;
    }
    bf16_t* pb = (bf16_t*)(P->ws + O_PB);
    const size_t nchunk = (size_t)2 * M * 32;
    for (size_t ch = (size_t)bid * NTHREADS + tid; ch < nchunk; ch += (size_t)gdim * NTHREADS) {
        const size_t e = ch * 8; const int l = (int)(e / ((size_t)M * 256)); const size_t r = e - (size_t)l * M * 256; const int row = (int)(r >> 8), col = (int)(r & 255);
        const float* src = row < MP ? P->in[5] + ((size_t)l * MP + row) * 256 + col : P->in[6] + ((size_t)l * MS + (row - MP)) * 256 + col;
        *(u32x4*)(pb + e) = pack8(load8f(src));
    }
}

__device__ __forceinline__ void mix_pass(KPtr P) {
    const int tid = tid_fresh(), lane = tid & 63, wave = tid >> 6; const int gw = bid_fresh() * 8 + wave, NGW = gdim_fresh() * 8;
    const float* ssq = (const float*)(P->ws + O_SSQ1); const bf16_t* H = (const bf16_t*)(P->ws + O_HB1); const float* g1 = P->in[7] + 1024; const float* mix = P->in[14];
#pragma unroll 1
    for (int j = 0; j < 2; ++j) {
        const int c = 8 * lane + 512 * j;
        const F8 g = load8f(g1 + c);
        F8 mq[6];
#pragma unroll
        for (int a6 = 0; a6 < 6; ++a6) mq[a6] = load8f(mix + a6 * 1024 + c);
        for (int row = gw; row < M; row += NGW) {
            int b, t, T; const bool isS = row >= MP;
            if (!isS) { b = row >> 12; t = row & 4095; T = TP; } else { const int jj = row - MP; b = jj >> 3; t = jj & 7; T = TS; }
            const float rs = rstd_of(ssq, row); const float rsp = t > 0 ? rstd_of(ssq, row - 1) : 0.f;
            const F8 hc = unpack8(*(const u32x4*)(H + (size_t)row * D + c));
            F8 xn, xx;
#pragma unroll
            for (int q = 0; q < 8; ++q) xn.v[q] = hc.v[q] * rs * g.v[q];
            if (t > 0) { const F8 hp = unpack8(*(const u32x4*)(H + (size_t)(row - 1) * D + c));
#pragma unroll
                for (int q = 0; q < 8; ++q) xx.v[q] = hp.v[q] * rsp * g.v[q] - xn.v[q]; }
            else if (isS) { const F8 sp = load8f(P->in[3] + (size_t)b * D + c);
#pragma unroll
                for (int q = 0; q < 8; ++q) xx.v[q] = sp.v[q] - xn.v[q]; }
            else {
#pragma unroll
                for (int q = 0; q < 8; ++q) xx.v[q] = -xn.v[q]; }
#pragma unroll
            for (int a6 = 0; a6 < 6; ++a6) {
                F8 v;
#pragma unroll
                for (int q = 0; q < 8; ++q) v.v[q] = xn.v[q] + xx.v[q] * mq[a6].v[q];
                *(u32x4*)((bf16_t*)(P->ws + O_R4 + (size_t)a6 * SL) + (size_t)row * D + c) = pack8(v);
            }
            if (t == T - 1) { float* so = P->out + (isS ? O_SHS : O_SHP) + (size_t)b * D + c;
                *(f32x4*)so = (f32x4){xn.v[0], xn.v[1], xn.v[2], xn.v[3]}; *(f32x4*)(so + 4) = (f32x4){xn.v[4], xn.v[5], xn.v[6], xn.v[7]}; }
        }
    }
}
__device__ __forceinline__ void post_pass(KPtr P) {
    const int tid = tid_fresh(), lane = tid & 63, wave = tid >> 6; const int gw = bid_fresh() * 8 + wave, NGW = gdim_fresh() * 8;
    const bf16_t* Y = (const bf16_t*)(P->ws + O_Y); const bf16_t* BON = (const bf16_t*)(P->ws + O_BON); const bf16_t* GG = (const bf16_t*)(P->ws + O_GG);
    bf16_t* YG = (bf16_t*)(P->ws + O_YG); const float* lw = P->in[28]; const float* lb = P->in[29];
    for (int row = gw; row < M; row += NGW) {
#pragma unroll
        for (int j = 0; j < 2; ++j) {
            const int c = 8 * lane + 512 * j; const size_t off = (size_t)row * D + c;
            const F8 y = unpack8(*(const u32x4*)(Y + off)), bo = unpack8(*(const u32x4*)(BON + off)), gg = unpack8(*(const u32x4*)(GG + off));
            const F8 w8 = load8f(lw + c), b8 = load8f(lb + c);
            float sm = 0.f;
#pragma unroll
            for (int q = 0; q < 8; ++q) sm += y.v[q];
            const float mu = row_sum8(sm) * (1.f / 64.f);
            float sv = 0.f; F8 d;
#pragma unroll
            for (int q = 0; q < 8; ++q) { d.v[q] = y.v[q] - mu; sv += d.v[q] * d.v[q]; }
            const float rs = __builtin_amdgcn_rsqf(row_sum8(sv) * (1.f / 64.f) + 64e-5f);
            F8 o;
#pragma unroll
            for (int q = 0; q < 8; ++q) o.v[q] = (d.v[q] * rs * w8.v[q] + b8.v[q] + bo.v[q]) * gg.v[q];
            *(u32x4*)(YG + off) = pack8(o);
        }
    }
}
__device__ __forceinline__ void final_pass(KPtr P) {
    const int tid = tid_fresh(), lane = tid & 63, wave = tid >> 6; const int gw = bid_fresh() * 8 + wave, NGW = gdim_fresh() * 8;
    const float* ssq = (const float*)(P->ws + O_SSQ0); const float* fn = P->in[35];
    for (int row = gw; row < M; row += NGW) {
        const float rs = rstd_of(ssq, row);
#pragma unroll
        for (int j = 0; j < 2; ++j) {
            const int c = 8 * lane + 512 * j; float* p = P->out + (size_t)row * D + c;
            const F8 h = unpack8(*(const u32x4*)((const bf16_t*)(P->ws + O_HB0) + (size_t)row * D + c)), f = load8f(fn + c);
            *(f32x4*)p = (f32x4){h.v[0] * rs * f.v[0], h.v[1] * rs * f.v[1], h.v[2] * rs * f.v[2], h.v[3] * rs * f.v[3]};
            *(f32x4*)(p + 4) = (f32x4){h.v[4] * rs * f.v[4], h.v[5] * rs * f.v[5], h.v[6] * rs * f.v[6], h.v[7] * rs * f.v[7]};
        }
    }
}

constexpr int TC = 32;
constexpr int SC_BUF = 5 * TC * 256 + TC * 64 + TC * 4;
constexpr int SC_OUT = 2 * SC_BUF;
constexpr int SC_OBUF = 2 * TC * 16 * 4;
__device__ __forceinline__ float wave_sum_fast(float x) {
    x = row_sum16(x);
    const float a = __builtin_bit_cast(float, __builtin_amdgcn_readlane(__builtin_bit_cast(int, x), 0)), b = __builtin_bit_cast(float, __builtin_amdgcn_readlane(__builtin_bit_cast(int, x), 16));
    const float c = __builtin_bit_cast(float, __builtin_amdgcn_readlane(__builtin_bit_cast(int, x), 32)), d = __builtin_bit_cast(float, __builtin_amdgcn_readlane(__builtin_bit_cast(int, x), 48));
    return (a + b) + (c + d);
}
struct PrepRegs { unsigned short lr[TC / 4], lk[TC / 4], lw[TC / 4], la[TC / 4], lv[TC / 4]; };
__device__ __forceinline__ void scan_prep_load(KPtr P, PrepRegs& g, int rowbase, int t0, int T, int h, int qi, int pw, int lane) {
    const bf16_t* RKV = (const bf16_t*)(P->ws + O_RKVB); const bf16_t* WL = (const bf16_t*)(P->ws + O_WL); const bf16_t* AL = (const bf16_t*)(P->ws + O_AL);
    const int ch = h * 64 + lane;
    constexpr int NS = TC / 4;
#pragma unroll
    for (int q = 0; q < NS; ++q) {
        int t = t0 + pw * NS + q; t = t < T ? t : T - 1;
        const size_t row = (size_t)(rowbase + t);
        g.lr[q] = RKV[row * 3072 + ch]; g.lk[q] = RKV[row * 3072 + 1024 + ch]; g.lw[q] = WL[row * 1024 + ch]; g.la[q] = AL[row * 1024 + ch];
        g.lv[q] = RKV[row * 3072 + 2048 + h * 64 + qi * 16 + (lane & 15)];
    }
}
__device__ __forceinline__ void scan_prep_compute(KPtr P, const PrepRegs& g, LAS unsigned char* buf, int h, int pw, int lane) {
    const int ch = h * 64 + lane;
    const float sw0 = ((const float*)(P->ws + O_PAR))[1024 + ch], kkw = P->in[25][ch], kaw = P->in[26][ch], rkw = P->in[27][ch];
    LAS float* fb = (LAS float*)buf;
    constexpr int NS = TC / 4;
#pragma unroll
    for (int q = 0; q < NS; ++q) {
        const int tau = pw * NS + q;
        const float r = bf2f(g.lr[q]), k = bf2f(g.lk[q]), wl = bf2f(g.lw[q]), al = bf2f(g.la[q]);
        const float dec = __builtin_amdgcn_exp2f(-0.8750387f * (sw0 + wl));
        const float a = al;
        const float kkv = k * kkw;
        const float n2 = wave_sum_fast(kkv * kkv);
        const float kkn = kkv * __builtin_amdgcn_rsqf(fmaxf(n2, 1e-24f));
        const float kp = k * (1.f + (a - 1.f) * kaw);
        const float bon = wave_sum_fast(r * kp * rkw);
        fb[0 * TC * 64 + tau * 64 + lane] = -kkn;
        fb[1 * TC * 64 + tau * 64 + lane] = dec;
        fb[2 * TC * 64 + tau * 64 + lane] = kkn * a;
        fb[3 * TC * 64 + tau * 64 + lane] = kp;
        fb[4 * TC * 64 + tau * 64 + lane] = r;
        if (lane < 16) fb[5 * TC * 64 + tau * 16 + lane] = bf2f(g.lv[q]);
        if (lane == 0) fb[5 * TC * 64 + TC * 16 + tau] = bon;
    }
}
__device__ __forceinline__ void scan_flush(KPtr P, const LAS float* ob, int rowbase, int t0, int T, int h, int qi, int p) {
    const int tau = p >> 3, pr = (p & 7) * 2; const int t = t0 + tau;
    if (t < T) {
        const size_t off = (size_t)(rowbase + t) * D + h * 64 + qi * 16 + pr;
        *(unsigned*)((bf16_t*)(P->ws + O_Y) + off) = pk2(ob[tau * 16 + pr], ob[tau * 16 + pr + 1]);
        *(unsigned*)((bf16_t*)(P->ws + O_BON) + off) = pk2(ob[TC * 16 + tau * 16 + pr], ob[TC * 16 + tau * 16 + pr + 1]);
    }
}
typedef short bf16x4 __attribute__((ext_vector_type(4)));
#ifndef NPREP_
#define NPREP_ 6
#endif
constexpr int NPREP = NPREP_;
constexpr int SL_AOP = 0, SL_RT = 2048, SL_UH = 4096, SL_Y0 = 5120, SL_MRB = 6144, SL_BTT = 6656, SL_ZV = 8704, SL_GC = 10752, SL_VTB = 11008, SL_BON = 11520, SL_RN = 11584, SLOT_B = 11776;
constexpr int SC_AT = 0, SC_BT = 2048, SC_KT = 4096, SC_ATT = 6144, SC_KTT = 8192, SC_LAB = 10240, SC_TM = 11264, SC_TM2 = SC_LAB  , SCR_B = 11776;
constexpr int SC_X1 = -SLOT_B + SL_AOP, SC_X2 = -SLOT_B + SL_ZV;
constexpr int CK_FLAGS = NPREP * (SLOT_B + SCR_B);
static_assert(CK_FLAGS + 64 <= LDS_CTL_OFF, "chunked scan LDS");
typedef unsigned short us2 __attribute__((ext_vector_type(2)));
struct CkRegs { us2 rk[16], wa[16], vv[8]; };
__device__ __forceinline__ void ck_load(KPtr P, CkRegs& g, int row0, int h, int qi, int lane) {
    const bf16_t* rk = (const bf16_t*)(P->ws + O_RKVB) + (size_t)row0 * 3072 + h * 64;
    const bf16_t* wl = (const bf16_t*)(P->ws + O_WL) + (size_t)row0 * 1024 + h * 64;
    const bf16_t* al = (const bf16_t*)(P->ws + O_AL) + (size_t)row0 * 1024 + h * 64;
    const bf16_t* vq = rk + 2048 + qi * 16;
    const int l15 = lane & 15;
#pragma unroll
    for (int t = 0; t < 16; ++t) {
        g.rk[t].x = rk[t * 3072 + lane]; g.rk[t].y = rk[t * 3072 + 1024 + lane]; g.wa[t].x = wl[t * 1024 + lane]; g.wa[t].y = al[t * 1024 + lane];
        const unsigned short vv_ = vq[t * 3072 + l15];
        if (t & 1) g.vv[t >> 1].y = vv_; else g.vv[t >> 1].x = vv_;
    }
}
__device__ __forceinline__ unsigned short bf1(float x) { return (unsigned short)(pk2(x, 0.f) & 0xffffu); }
__device__ __forceinline__ bf16x4 pack4(f32x4 v) { u32x2 w; w.x = pk2(v.x, v.y); w.y = pk2(v.z, v.w); return __builtin_bit_cast(bf16x4, w); }
#define MFMA16(a, b, c) __builtin_amdgcn_mfma_f32_16x16x16bf16_1k(a, b, c, 0, 0, 0)
#define MFMA32(a, b, c) __builtin_amdgcn_mfma_f32_16x16x32_bf16(a, b, c, 0, 0, 0)
#define LDSW() asm volatile("s_waitcnt lgkmcnt(0)" ::: "memory")
__device__ __forceinline__ bf16x4 ck_tr(const LAS unsigned char* a) { return __builtin_amdgcn_ds_read_tr16_b64_v4i16((LAS bf16x4*)a); }
__device__ __forceinline__ bf16x8 ck_tr8(const LAS unsigned char* a, int second) { const bf16x4 lo = ck_tr(a), hi = ck_tr(a + second); return (bf16x8){lo.x, lo.y, lo.z, lo.w, hi.x, hi.y, hi.z, hi.w}; }
struct CkPar { float sw0, kkw, kaw, rkw; };
__device__ __forceinline__ void ck_prep_a(const CkPar& cp, const CkRegs& g, LAS unsigned char* slot, LAS unsigned char* scr, int lane) {
    const float sw0 = cp.sw0, kkw = cp.kkw, kaw = cp.kaw, rkw = cp.rkw;
    float gprev = 1.f, pa = 0.f, pb = 0.f, pk = 0.f, pv = 0.f, pr = 0.f, p1 = 0.f, p2 = 0.f;
    unsigned att[8], btt[8], ktt[8], vtb[8], rtt[8], x1t[8], x2t[8];
#pragma unroll
    for (int t = 0; t < 16; ++t) {
        const float r = bf2f(g.rk[t].x), k = bf2f(g.rk[t].y), wl = bf2f(g.wa[t].x), al = bf2f(g.wa[t].y);
        const float dec = __builtin_amdgcn_exp2f(-0.8750387f * (sw0 + wl));
        const float a = al;
        const float kkv = k * kkw;
        const float kp = k * (1.f + (a - 1.f) * kaw);
        const float gcur = gprev * dec, rg = __builtin_amdgcn_rcpf(gcur);
        const float at = -kkv * gprev, bt = kkv * a * rg, kt = kp * rg, rt = r * gcur, vv = bf2f((t & 1) ? g.vv[t >> 1].y : g.vv[t >> 1].x);
        const float x1 = kkv * kkv, x2 = r * kp * rkw;
        if (t & 1) {
            att[t >> 1] = pk2(pa, at); btt[t >> 1] = pk2(pb, bt); ktt[t >> 1] = pk2(pk, kt); vtb[t >> 1] = pk2(pv, vv);
            rtt[t >> 1] = pk2(pr, rt); x1t[t >> 1] = pk2(p1, x1); x2t[t >> 1] = pk2(p2, x2);
        }
        pa = at; pb = bt; pk = kt; pv = vv; pr = rt; p1 = x1; p2 = x2;
        gprev = gcur;
    }
    *(LAS u32x4*)(slot + SL_RT + lane * 32) = (u32x4){rtt[0], rtt[1], rtt[2], rtt[3]}; *(LAS u32x4*)(slot + SL_RT + lane * 32 + 16) = (u32x4){rtt[4], rtt[5], rtt[6], rtt[7]};
    *(LAS u32x4*)(scr + SC_X1 + lane * 32) = (u32x4){x1t[0], x1t[1], x1t[2], x1t[3]}; *(LAS u32x4*)(scr + SC_X1 + lane * 32 + 16) = (u32x4){x1t[4], x1t[5], x1t[6], x1t[7]};
    *(LAS u32x4*)(scr + SC_X2 + lane * 32) = (u32x4){x2t[0], x2t[1], x2t[2], x2t[3]}; *(LAS u32x4*)(scr + SC_X2 + lane * 32 + 16) = (u32x4){x2t[4], x2t[5], x2t[6], x2t[7]};
    ((LAS float*)(slot + SL_GC))[lane] = gprev;
    *(LAS u32x4*)(scr + SC_ATT + lane * 32) = (u32x4){att[0], att[1], att[2], att[3]}; *(LAS u32x4*)(scr + SC_ATT + lane * 32 + 16) = (u32x4){att[4], att[5], att[6], att[7]};
    *(LAS u32x4*)(slot + SL_BTT + lane * 32) = (u32x4){btt[0], btt[1], btt[2], btt[3]}; *(LAS u32x4*)(slot + SL_BTT + lane * 32 + 16) = (u32x4){btt[4], btt[5], btt[6], btt[7]};
    *(LAS u32x4*)(scr + SC_KTT + lane * 32) = (u32x4){ktt[0], ktt[1], ktt[2], ktt[3]}; *(LAS u32x4*)(scr + SC_KTT + lane * 32 + 16) = (u32x4){ktt[4], ktt[5], ktt[6], ktt[7]};
    if (lane < 16) {
        *(LAS u32x4*)(slot + SL_VTB + lane * 32) = (u32x4){vtb[0], vtb[1], vtb[2], vtb[3]}; *(LAS u32x4*)(slot + SL_VTB + lane * 32 + 16) = (u32x4){vtb[4], vtb[5], vtb[6], vtb[7]};
    }
    LDSW();
}
__device__ __forceinline__ void ck_prep_b(LAS unsigned char* slot, LAS unsigned char* scr, int lane) {
    const int m = lane & 15, kg = lane >> 4;
    const f32x4 z4 = (f32x4){0.f, 0.f, 0.f, 0.f};
    f32x4 P1, P2, P3, P4;
    {
        const int tro = (8 * kg + ((lane >> 2) & 3)) * 32 + (lane & 3) * 8;
        const bf16x8 KA0 = ck_tr8(scr + SC_KTT + tro, 128), KA1 = ck_tr8(scr + SC_KTT + tro + 1024, 128);
        const bf16x8 BA0 = ck_tr8(slot + SL_BTT + tro, 128), BA1 = ck_tr8(slot + SL_BTT + tro + 1024, 128);
        const bf16x8 AB0 = ck_tr8(scr + SC_ATT + tro, 128), AB1 = ck_tr8(scr + SC_ATT + tro + 1024, 128);
        const bf16x8 RB0 = ck_tr8(slot + SL_RT + tro, 128), RB1 = ck_tr8(slot + SL_RT + tro + 1024, 128);
        P1 = MFMA32(KA0, AB0, z4); P1 = MFMA32(KA1, AB1, P1);
        P2 = MFMA32(BA0, AB0, z4); P2 = MFMA32(BA1, AB1, P2);
        P3 = MFMA32(KA0, RB0, z4); P3 = MFMA32(KA1, RB1, P3);
        P4 = MFMA32(BA0, RB0, z4); P4 = MFMA32(BA1, RB1, P4);
    }
    f32x4 rn4;
    {
        const u32x4 one4 = (u32x4){0x3f803f80u, 0x3f803f80u, 0x3f803f80u, 0x3f803f80u}; const bf16x8 ones = __builtin_bit_cast(bf16x8, one4);
        const int tro = (8 * kg + ((lane >> 2) & 3)) * 32 + (lane & 3) * 8;
        const bf16x8 X10 = ck_tr8(scr + SC_X1 + tro, 128), X11 = ck_tr8(scr + SC_X1 + tro + 1024, 128);
        const bf16x8 X20 = ck_tr8(scr + SC_X2 + tro, 128), X21 = ck_tr8(scr + SC_X2 + tro + 1024, 128);
        f32x4 N2 = MFMA32(X10, ones, z4); N2 = MFMA32(X11, ones, N2);
        f32x4 BO = MFMA32(X20, ones, z4); BO = MFMA32(X21, ones, BO);
#pragma unroll
        for (int e = 0; e < 4; ++e) rn4[e] = __builtin_amdgcn_rsqf(fmaxf(N2[e], 1e-24f));
        if (m == 0) { *(LAS f32x4*)(slot + SL_RN + 4 * kg * 4) = rn4; *(LAS f32x4*)(slot + SL_BON + 4 * kg * 4) = BO; }
    }
    LDSW();
    const float rnm = ((const LAS float*)(slot + SL_RN))[m];
    f32x4 lak, lab, mrk, mrb;
#pragma unroll
    for (int e = 0; e < 4; ++e) { P1[e] *= rnm; P2[e] *= rnm * rn4[e]; P4[e] *= rn4[e]; }
#pragma unroll
    for (int e = 0; e < 4; ++e) { const int sI = 4 * kg + e; lak[e] = sI < m ? P1[e] : 0.f; lab[e] = sI < m ? P2[e] : 0.f; mrk[e] = sI <= m ? P3[e] : 0.f; mrb[e] = sI <= m ? P4[e] : 0.f; }
    *(LAS f32x4*)(scr + SC_LAB + (m * 16 + 4 * kg) * 4) = lab;
    *(LAS bf16x4*)(slot + SL_MRB + lane * 8) = pack4(mrb);
    const bf16x4 lakop = pack4(lak), mrkop = pack4(mrk);
    LDSW();
    float x[16];
#pragma unroll
    for (int t = 0; t < 16; ++t) {
        float acc = (t == m) ? 1.f : 0.f;
#pragma unroll
        for (int s4 = 0; s4 * 4 < t; ++s4) {
            const f32x4 L4 = *(const LAS f32x4*)(scr + SC_LAB + (t * 16 + 4 * s4) * 4);
#pragma unroll
            for (int e = 0; e < 4; ++e) if (4 * s4 + e < t) acc = fmaf(L4[e], x[4 * s4 + e], acc);
        }
        x[t] = acc;
    }
    if (lane < 16) {
#pragma unroll
        for (int t = 0; t < 16; ++t) { ((LAS bf16_t*)(scr + SC_TM))[t * 16 + m] = bf1(x[t]); ((LAS bf16_t*)(scr + SC_TM2))[t * 16 + m] = bf1(x[t] * rnm); }
    }
    LDSW();
    const bf16x4 vop = *(const LAS bf16x4*)(slot + SL_VTB + (m * 16 + 4 * kg) * 2);
    const bf16x4 top = *(const LAS bf16x4*)(scr + SC_TM + (m * 16 + 4 * kg) * 2);
    const bf16x4 top2 = *(const LAS bf16x4*)(scr + SC_TM2 + (m * 16 + 4 * kg) * 2);
    const f32x4 LV = MFMA16(lakop, vop, z4);
    const f32x4 Y0 = MFMA16(mrkop, vop, z4);
    *(LAS f32x4*)(slot + SL_Y0 + lane * 16) = Y0;
    const f32x4 UH = MFMA16(top, pack4(LV), z4);
    *(LAS f32x4*)(slot + SL_UH + lane * 16) = UH;
    u32x4 o1, o2;
    {
        f32x4 AH[4], ZV[4];
#pragma unroll
        for (int tau = 0; tau < 4; ++tau) {
            const bf16x4 aop = *(const LAS bf16x4*)(scr + SC_ATT + ((16 * tau + m) * 16 + 4 * kg) * 2);
            AH[tau] = MFMA16(aop, top2, z4);
            const bf16x4 kop = *(const LAS bf16x4*)(scr + SC_KTT + ((16 * tau + m) * 16 + 4 * kg) * 2);
            ZV[tau] = MFMA16(kop, vop, z4);
        }
        o1 = (u32x4){pk2(AH[0].x, AH[0].y), pk2(AH[0].z, AH[0].w), pk2(AH[1].x, AH[1].y), pk2(AH[1].z, AH[1].w)};
        o2 = (u32x4){pk2(AH[2].x, AH[2].y), pk2(AH[2].z, AH[2].w), pk2(AH[3].x, AH[3].y), pk2(AH[3].z, AH[3].w)};
        *(LAS u32x4*)(slot + SL_AOP + lane * 32) = o1; *(LAS u32x4*)(slot + SL_AOP + lane * 32 + 16) = o2;
        o1 = (u32x4){pk2(ZV[0].x, ZV[0].y), pk2(ZV[0].z, ZV[0].w), pk2(ZV[1].x, ZV[1].y), pk2(ZV[1].z, ZV[1].w)};
        o2 = (u32x4){pk2(ZV[2].x, ZV[2].y), pk2(ZV[2].z, ZV[2].w), pk2(ZV[3].x, ZV[3].y), pk2(ZV[3].z, ZV[3].w)};
        *(LAS u32x4*)(slot + SL_ZV + lane * 32) = o1; *(LAS u32x4*)(slot + SL_ZV + lane * 32 + 16) = o2;
    }
    LDSW();
}
__device__ __forceinline__ void ck_wait(volatile LAS unsigned* f, unsigned v) { while (*f != v) __builtin_amdgcn_s_sleep(1); asm volatile("" ::: "memory"); }
__device__ __forceinline__ void scan_chunked_item(KPtr P, LAS unsigned char* lds, int it, int tid, int mode) {
    const int lane = tid & 63, w = __builtin_amdgcn_readfirstlane(tid >> 6);
    const int b = it >> 6, h = (it >> 2) & 15, qi = it & 3, rowbase = b * TP;
    constexpr int NCH = TP / 16;
    volatile LAS unsigned* flags = (volatile LAS unsigned*)(lds + CK_FLAGS);
    if (tid < 16) flags[tid] = 0u;
    __syncthreads();
    if (w == 0) {
        const int m = lane & 15, kg = lane >> 4;
        f32x4 ST[4];
#pragma unroll
        for (int tau = 0; tau < 4; ++tau) ST[tau] = (f32x4){0.f, 0.f, 0.f, 0.f};
        bf16_t* Yg = (bf16_t*)(P->ws + O_Y) + (size_t)rowbase * D + h * 64 + qi * 16 + m;
        bf16_t* Bg = (bf16_t*)(P->ws + O_BON) + (size_t)rowbase * D + h * 64 + qi * 16 + m;
        int pslot = 0;
#pragma unroll 1
        for (int c = 0; c < NCH; ++c) {
            LAS unsigned char* slot = lds + pslot * (SLOT_B + SCR_B);
            ck_wait(flags + pslot, (unsigned)(c + 1));
            if (mode == 1 || mode == 3) { flags[8 + pslot] = (unsigned)(c + 1); pslot = (pslot == NPREP - 1) ? 0 : pslot + 1; continue; }
            const f32x4 z4 = (f32x4){0.f, 0.f, 0.f, 0.f};
            const u32x4 s1 = (u32x4){pk2(ST[0].x, ST[0].y), pk2(ST[0].z, ST[0].w), pk2(ST[1].x, ST[1].y), pk2(ST[1].z, ST[1].w)};
            const u32x4 s2 = (u32x4){pk2(ST[2].x, ST[2].y), pk2(ST[2].z, ST[2].w), pk2(ST[3].x, ST[3].y), pk2(ST[3].z, ST[3].w)};
            const bf16x8 sop1 = __builtin_bit_cast(bf16x8, s1), sop2 = __builtin_bit_cast(bf16x8, s2);
            const bf16x8 aop1 = *(const LAS bf16x8*)(slot + SL_AOP + lane * 32), aop2 = *(const LAS bf16x8*)(slot + SL_AOP + lane * 32 + 16);
            const LAS unsigned char* rrow = slot + SL_RT + (4 * kg + ((lane >> 2) & 3)) * 32 + (lane & 3) * 8;
            const bf16x8 rop1 = ck_tr8(rrow, 512), rop2 = ck_tr8(rrow + 1024, 512);
            f32x4 U = MFMA32(aop1, sop1, z4); U = MFMA32(aop2, sop2, U);
            f32x4 Y = MFMA32(rop1, sop1, z4); Y = MFMA32(rop2, sop2, Y);
            U = U + *(const LAS f32x4*)(slot + SL_UH + lane * 16);
            const bf16x4 uop = pack4(U);
            const bf16x4 uop2 = pack4(U * *(const LAS f32x4*)(slot + SL_RN + 4 * kg * 4));
            const bf16x4 mop = *(const LAS bf16x4*)(slot + SL_MRB + lane * 8);
            Y = MFMA16(mop, uop, Y);
            Y = Y + *(const LAS f32x4*)(slot + SL_Y0 + lane * 16);
            const u32x4 zv1 = *(const LAS u32x4*)(slot + SL_ZV + lane * 32), zv2 = *(const LAS u32x4*)(slot + SL_ZV + lane * 32 + 16);
            const unsigned zvw[8] = {zv1.x, zv1.y, zv1.z, zv1.w, zv2.x, zv2.y, zv2.z, zv2.w};
#pragma unroll
            for (int tau = 0; tau < 4; ++tau) {
                const bf16x4 bop = *(const LAS bf16x4*)(slot + SL_BTT + ((16 * tau + m) * 16 + 4 * kg) * 2);
                const f32x4 dS = MFMA16(bop, uop2, z4);
                const f32x4 gc = *(const LAS f32x4*)(slot + SL_GC + (16 * tau + 4 * kg) * 4);
                const f32x4 zv = (f32x4){bflo(zvw[2 * tau]), bfhi(zvw[2 * tau]), bflo(zvw[2 * tau + 1]), bfhi(zvw[2 * tau + 1])};
                ST[tau] = (ST[tau] + dS + zv) * gc;
            }
            const f32x4 bn = *(const LAS f32x4*)(slot + SL_BON + 4 * kg * 4); const u32x2 vtw = *(const LAS u32x2*)(slot + SL_VTB + (m * 16 + 4 * kg) * 2);
            const f32x4 vt4 = (f32x4){bflo(vtw.x), bfhi(vtw.x), bflo(vtw.y), bfhi(vtw.y)};
            LDSW();
            flags[8 + pslot] = (unsigned)(c + 1);
            if (mode == 0) {
#pragma unroll
            for (int e = 0; e < 4; ++e) {
                const size_t off = (size_t)(c * 16 + 4 * kg + e) * D;
                Yg[off] = bf1(Y[e]); Bg[off] = bf1(bn[e] * vt4[e]);
            } } else { asm volatile("" :: "v"(Y), "v"(bn), "v"(vt4)); }
            pslot = (pslot == NPREP - 1) ? 0 : pslot + 1;
        }
        float* sout = P->out + O_WKVP + (size_t)(b * 16 + h) * 4096 + (size_t)(qi * 16 + m) * 64;
        if (mode == 0) {
#pragma unroll
        for (int tau = 0; tau < 4; ++tau) *(f32x4*)(sout + 16 * tau + 4 * kg) = ST[tau]; } else { asm volatile("" :: "v"(ST[0]), "v"(ST[1]), "v"(ST[2]), "v"(ST[3])); }
    } else if (w != 4 && ((w < 4 ? w - 1 : w - 2) < NPREP)) {
        const int p = w < 4 ? w - 1 : w - 2;
        LAS unsigned char* slot = lds + p * (SLOT_B + SCR_B); LAS unsigned char* scr = slot + SLOT_B;
        CkRegs g;
        CkPar cp; { const int ch = h * 64 + lane; cp.sw0 = ((const float*)(P->ws + O_PAR))[1024 + ch]; cp.kkw = P->in[25][ch]; cp.kaw = P->in[26][ch]; cp.rkw = P->in[27][ch]; }
        ck_load(P, g, rowbase + p * 16, h, qi, lane);
#pragma unroll 1
        for (int c = p; c < NCH; c += NPREP) {
            if (c >= NPREP) ck_wait(flags + 8 + p, (unsigned)(c - NPREP + 1));
            if (mode == 2) { flags[p] = (unsigned)(c + 1); continue; }
            ck_prep_a(cp, g, slot, scr, lane);
            if (mode != 3) { const int cn = (c + NPREP < NCH) ? c + NPREP : c; ck_load(P, g, rowbase + cn * 16, h, qi, lane); }
            ck_prep_b(slot, scr, lane);
            flags[p] = (unsigned)(c + 1);
        }
    }
}

__device__ __forceinline__ void scan_phase(KPtr P, LAS unsigned char* lds) {
    const int tid = tid_fresh(), lane = tid & 63, w = __builtin_amdgcn_readfirstlane(tid >> 6);
    const int bid = bid_fresh(), gdim = gdim_fresh();
#ifndef SCAN_REP_P
#define SCAN_REP_P 1
#endif
#ifndef SCAN_MODE2
#define SCAN_MODE2 0
#endif
#ifndef SCAN_REP_S
#define SCAN_REP_S 1
#endif
#ifdef SCAN_PRETOUCH
    {
        const int it = (gdim == 256) ? (((bid & 7) * 8 + (bid >> 5)) * 4 + ((bid >> 3) & 3)) : bid;
        const int b = it >> 6, h = (it >> 2) & 15, qi = it & 3;
        const bf16_t* RKV = (const bf16_t*)(P->ws + O_RKVB); const bf16_t* WL = (const bf16_t*)(P->ws + O_WL); const bf16_t* AL = (const bf16_t*)(P->ws + O_AL);
        unsigned acc = 0;
        for (int r = qi * 1024 + (tid >> 3); r < qi * 1024 + 1024; r += 64) {
            const size_t row = (size_t)b * TP + r; const int sub = tid & 7;
            for (int pc = sub; pc < 10; pc += 8) {
                const int seg = pc >> 1, half = pc & 1;
                const bf16_t* p = seg < 3 ? RKV + row * 3072 + seg * 1024 + h * 64 + half * 32 : (seg == 3 ? WL : AL) + row * 1024 + h * 64 + half * 32;
                acc += *(const unsigned*)p;
            }
        }
        if (acc == 0x12345678u) ((volatile LAS unsigned*)lds)[0] = acc;
        __syncthreads();
    }
#endif
    for (int rp_ = 0; rp_ < SCAN_REP_P; ++rp_)
    for (int it0 = bid; it0 < 256; it0 += gdim) {
        const int it = (gdim == 256) ? (((it0 & 7) * 8 + (it0 >> 5)) * 4 + ((it0 >> 3) & 3)) : it0;
        scan_chunked_item(P, lds, it, tid, rp_ == 0 ? 0 : SCAN_MODE2); __syncthreads(); }
    for (int rs_ = 0; rs_ < SCAN_REP_S; ++rs_)
    for (int it = 256 + bid; it < 256 + 2048; it += gdim) {
        int rowbase, T, h, qi; const float* sin; float* sout;
        if (it < 256) { const int b = it >> 6; h = (it >> 2) & 15; qi = it & 3; rowbase = b * TP; T = TP; sin = nullptr; sout = P->out + O_WKVP + (size_t)(b * 16 + h) * 4096; }
        else { const int j = it - 256; const int b = j >> 6; h = (j >> 2) & 15; qi = j & 3; rowbase = MP + b * TS; T = TS; sin = P->in[2] + (size_t)(b * 16 + h) * 4096; sout = P->out + O_WKVS + (size_t)(b * 16 + h) * 4096; }
        const int nch = (T + TC - 1) / TC;
        const int rr = lane >> 4, q = lane & 15; const int il = (w & 3) * 4 + rr; const int irow = qi * 16 + il;
        f32x4 s = (f32x4){0.f, 0.f, 0.f, 0.f};
        PrepRegs pg;
        if (w < 4) { if (sin) s = *(const f32x4*)(sin + (size_t)irow * 64 + q * 4); }
        else { scan_prep_load(P, pg, rowbase, 0, T, h, qi, w - 4, lane); scan_prep_compute(P, pg, lds, h, w - 4, lane); if (nch > 1) scan_prep_load(P, pg, rowbase, TC, T, h, qi, w - 4, lane); }
        __syncthreads();
        for (int c = 0; c < nch; ++c) {
            LAS unsigned char* buf = lds + (c & 1) * SC_BUF;
            LAS float* ob = (LAS float*)(lds + SC_OUT + (c & 1) * SC_OBUF);
            if (w >= 4) {
                if (c > 0) scan_flush(P, (const LAS float*)(lds + SC_OUT + ((c - 1) & 1) * SC_OBUF), rowbase, (c - 1) * TC, T, h, qi, tid - 256);
                if (c + 1 < nch) { scan_prep_compute(P, pg, lds + ((c + 1) & 1) * SC_BUF, h, w - 4, lane); if (c + 2 < nch) scan_prep_load(P, pg, rowbase, (c + 2) * TC, T, h, qi, w - 4, lane); }
            } else {
                const int ns = (T - c * TC) < TC ? (T - c * TC) : TC;
                const LAS float* fb = (const LAS float*)buf;
#pragma unroll 1
                for (int t8 = 0; t8 < ns; t8 += 8) {
                    f32x4 nkk = *(const LAS f32x4*)(fb + 0 * TC * 64 + t8 * 64 + q * 4), dw = *(const LAS f32x4*)(fb + 1 * TC * 64 + t8 * 64 + q * 4);
                    f32x4 bb = *(const LAS f32x4*)(fb + 2 * TC * 64 + t8 * 64 + q * 4), kp = *(const LAS f32x4*)(fb + 3 * TC * 64 + t8 * 64 + q * 4);
                    f32x4 r4 = *(const LAS f32x4*)(fb + 4 * TC * 64 + t8 * 64 + q * 4);
                    float vv = fb[5 * TC * 64 + t8 * 16 + il], bon = fb[5 * TC * 64 + TC * 16 + t8];
                    float keep = 0.f;
#pragma unroll
                    for (int u = 0; u < 8; ++u) {
                        const int tn = t8 + (u < 7 ? u + 1 : 7);
                        const f32x4 nkk_n = *(const LAS f32x4*)(fb + 0 * TC * 64 + tn * 64 + q * 4), dw_n = *(const LAS f32x4*)(fb + 1 * TC * 64 + tn * 64 + q * 4);
                        const f32x4 bb_n = *(const LAS f32x4*)(fb + 2 * TC * 64 + tn * 64 + q * 4), kp_n = *(const LAS f32x4*)(fb + 3 * TC * 64 + tn * 64 + q * 4);
                        const f32x4 r4_n = *(const LAS f32x4*)(fb + 4 * TC * 64 + tn * 64 + q * 4);
                        const float vv_n = fb[5 * TC * 64 + tn * 16 + il], bon_n = fb[5 * TC * 64 + TC * 16 + tn];
                        float sa0 = s.x * nkk.x, sa1 = s.z * nkk.z; sa0 = fmaf(s.y, nkk.y, sa0); sa1 = fmaf(s.w, nkk.w, sa1);
                        const float sa = row_sum16(sa0 + sa1);
                        s = s * dw + bb * sa + kp * vv;
                        float y0 = s.x * r4.x, y1 = s.z * r4.z; y0 = fmaf(s.y, r4.y, y0); y1 = fmaf(s.w, r4.w, y1);
                        const float y = row_sum16(y0 + y1);
                        const float val = (q < 8) ? y : bon * vv;
                        keep = ((q & 7) == u) ? val : keep;
                        nkk = nkk_n; dw = dw_n; bb = bb_n; kp = kp_n; r4 = r4_n; vv = vv_n; bon = bon_n;
                    }
                    ob[(q < 8 ? 0 : TC * 16) + (t8 + (q & 7)) * 16 + il] = keep;
                }
            }
            __syncthreads();
        }
        if (w < 4) *(f32x4*)(sout + (size_t)irow * 64 + q * 4) = s;
        else scan_flush(P, (const LAS float*)(lds + SC_OUT + ((nch - 1) & 1) * SC_OBUF), rowbase, (nch - 1) * TC, T, h, qi, tid - 256);
        __syncthreads();
    }
}

__device__ __forceinline__ int t5_bucket(int d) {
    if (d < 16) return d;
    int b = 16;
    b += (d >= 22) + (d >= 30) + (d >= 40) + (d >= 54) + (d >= 73) + (d >= 99) + (d >= 134) + (d >= 182) + (d >= 246) + (d >= 332) + (d >= 450) + (d >= 609) + (d >= 825) + (d >= 1117) + (d >= 1513);
    return b;
}
constexpr int BIAS_LD = 465, BIAS_OFF = 288;
constexpr int ATT_BIAS_BYTES = 3 * 16 * BIAS_LD * 4;
constexpr int ATT_WSCR = 12288;
__device__ __forceinline__ void vt_build(KPtr P, LAS unsigned char* lds) {
    const int tid = tid_fresh(); const int bid = bid_fresh(), gdim = gdim_fresh();
    const bf16_t* VB = (const bf16_t*)(P->ws + O_VB); bf16_t* VT = (bf16_t*)(P->ws + O_VT);
    const bf16_t* KB = (const bf16_t*)(P->ws + O_KB); bf16_t* KT = (bf16_t*)(P->ws + O_KT);
    constexpr int PITCH = 136;
    for (int it = bid; it < 384; it += gdim) {
        const int g = it % 3, un = it / 3, b = un >> 5, kvh = (un >> 3) & 3, tb = un & 7;
        const int sh = 2 * g;
        const int nblk_loc = 16 >> sh;
        const int nblk_tot = 128 >> sh;
#pragma unroll 1
        for (int kv = 0; kv < 2; ++kv) {
            const bf16_t* src = kv ? KB : VB;
            __syncthreads();
#pragma unroll
            for (int q = 0; q < 8; ++q) {
                const int idx = q * 512 + tid, t = idx >> 3, ch = idx & 7;
                const u32x4 v = *(const u32x4*)(src + ((size_t)(b * TP + tb * 512 + t)) * 256 + kvh * 64 + ch * 8);
                LAS u32x2* d = (LAS u32x2*)(lds + t * PITCH + ch * 16);
                d[0] = (u32x2){v.x, v.y}; d[1] = (u32x2){v.z, v.w};
            }
            __syncthreads();
            if (kv == 0) {
#pragma unroll 1
                for (int q = 0; q < 8; ++q) {
                    const int idx = q * 512 + tid;
                    const int oct = idx & 3, dim = (idx >> 2) & 63, cb = idx >> 8;
                    const int cls = cb / nblk_loc, lb = cb % nblk_loc;
                    unsigned short e[8];
#pragma unroll
                    for (int i = 0; i < 8; ++i) { const int pp = 16 * (oct >> 1) + 8 * (i >> 2) + 4 * (oct & 1) + (i & 3);
                        const int tl = ((lb * 32 + pp) << sh) + cls; e[i] = *(const LAS unsigned short*)(lds + tl * PITCH + dim * 2); }
                    u32x4 o; o.x = e[0] | ((unsigned)e[1] << 16); o.y = e[2] | ((unsigned)e[3] << 16); o.z = e[4] | ((unsigned)e[5] << 16); o.w = e[6] | ((unsigned)e[7] << 16);
                    const int blk = tb * nblk_loc + lb;
                    const int inner = ((((oct >> 1) * 2 + (dim >> 5)) * 2 + (oct & 1)) * 32 + (dim & 31)) * 8;
                    *(u32x4*)(VT + (size_t)g * VT_COPY + (size_t)((((b * 4 + kvh) << sh) + cls) * nblk_tot + blk) * 2048 + inner) = o;
                }
            } else {
#pragma unroll 1
                for (int q = 0; q < 8; ++q) {
                    const int idx = q * 512 + tid;
                    const int key = idx & 31, p = (idx >> 5) & 7, cb = idx >> 8;
                    const int cls = cb / nblk_loc, lb = cb % nblk_loc;
                    const int tl = ((lb * 32 + key) << sh) + cls;
                    const LAS u32x2* sp = (const LAS u32x2*)(lds + tl * PITCH + p * 16);
                    const u32x2 a0 = sp[0], a1 = sp[1];
                    const int blk = tb * nblk_loc + lb;
                    *(u32x4*)(KT + (size_t)g * VT_COPY + (size_t)((((b * 4 + kvh) << sh) + cls) * nblk_tot + blk) * 2048 + (p * 32 + key) * 8) = (u32x4){a0.x, a0.y, a1.x, a1.y};
                }
            }
        }
    }
    __syncthreads();
}
__device__ __forceinline__ void attn_phase(KPtr P, LAS unsigned char* lds) {
    const int tid = tid_fresh(), lane = tid & 63, w = __builtin_amdgcn_readfirstlane(tid >> 6);
    LAS float* bias = (LAS float*)lds;
    for (int e = tid; e < 3 * 16 * BIAS_LD; e += NTHREADS) {
        const int gh = e / BIAS_LD, x = e % BIAS_LD, g = gh >> 4, hd = gh & 15, j = BIAS_OFF - x;
        const int dil = g == 0 ? 1 : (g == 1 ? 4 : 16);
        float v = -1e30f;
        if (j >= 0 && j <= 128) v = P->in[34][t5_bucket(dil * j) * 48 + g * 16 + hd] * 1.4426950408889634f;
        bias[e] = v;
    }
    volatile LAS unsigned* ctr = (volatile LAS unsigned*)(lds + ATT_BIAS_BYTES + 4 * ATT_WSCR);
    if (tid == 0) ctr[0] = 0u;
    __syncthreads();
    const bf16_t* Q = (const bf16_t*)(P->ws + O_Q); const bf16_t* KT = (const bf16_t*)(P->ws + O_KT); const bf16_t* VT = (const bf16_t*)(P->ws + O_VT);
    bf16_t* ATT = (bf16_t*)(P->ws + O_ATT);
    const int bidx = bid_fresh(), gdimx = gdim_fresh();
    const int n = lane & 31, hh = lane >> 5, r = n >> 3, iq = n & 7;
    LAS float* qsc = (LAS float*)(lds + ATT_BIAS_BYTES + w * ATT_WSCR);
    LAS float* psc = qsc + 768;
    const float* cache = P->in[4]; const float* kvs = P->out + O_KVS;
#ifndef ATT_REP_S
#define ATT_REP_S 1
#endif
#ifndef ATT_MODE2
#define ATT_MODE2 0
#endif
#ifndef ATT_REP_P
#define ATT_REP_P 1
#endif
    if (w < 4)
    for (int reps_ = 0; reps_ < ATT_REP_S; ++reps_)
    for (int it = bidx * 4 + w; it < 1024; it += gdimx * 4) {
        const int b = it >> 5, t = (it >> 2) & 7, kvh = it & 3;
        const size_t qrow = (size_t)MP + b * TS + t;
        for (int e = lane; e < 768; e += 64) { const int g = e >> 8, rr2 = (e >> 6) & 3, d = e & 63; qsc[e] = bf2f(Q[qrow * 3072 + g * 1024 + kvh * 256 + rr2 * 64 + d]); }
        asm volatile("s_waitcnt lgkmcnt(0)" ::: "memory");
        float mx0 = -1e30f, mx1 = -1e30f, mx2 = -1e30f, mx3 = -1e30f;
#pragma unroll 1
        for (int gj = 0; gj < 9; ++gj) {
            const int g = gj / 3, jb = gj % 3, sh = 2 * g;
            const int j = jb * 64 + lane; const bool valid = j <= 128; const int jc = valid ? j : 128;
            const int pext = 2048 + t - (jc << sh);
            const float* kp = pext < 2048 ? cache + ((size_t)(b * 2048 + pext) * 2) * 256 + kvh * 64 : kvs + (size_t)(b * TS + (pext - 2048)) * 512 + kvh * 64;
            float d0 = 0.f, d1 = 0.f, d2 = 0.f, d3 = 0.f;
#pragma unroll 4
            for (int dd = 0; dd < 16; ++dd) {
                const f32x4 kv = *(const f32x4*)(kp + dd * 4);
                const f32x4 q0 = *(const LAS f32x4*)(qsc + g * 256 + 0 * 64 + dd * 4), q1 = *(const LAS f32x4*)(qsc + g * 256 + 1 * 64 + dd * 4);
                const f32x4 q2 = *(const LAS f32x4*)(qsc + g * 256 + 2 * 64 + dd * 4), q3 = *(const LAS f32x4*)(qsc + g * 256 + 3 * 64 + dd * 4);
                d0 += (kv.x * q0.x + kv.y * q0.y) + (kv.z * q0.z + kv.w * q0.w); d1 += (kv.x * q1.x + kv.y * q1.y) + (kv.z * q1.z + kv.w * q1.w);
                d2 += (kv.x * q2.x + kv.y * q2.y) + (kv.z * q2.z + kv.w * q2.w); d3 += (kv.x * q3.x + kv.y * q3.y) + (kv.z * q3.z + kv.w * q3.w);
            }
            const LAS float* bb = bias + (g * 16 + kvh * 4) * BIAS_LD + (BIAS_OFF - jc);
            const float v0 = valid ? d0 + bb[0] : -1e30f, v1 = valid ? d1 + bb[BIAS_LD] : -1e30f, v2 = valid ? d2 + bb[2 * BIAS_LD] : -1e30f, v3 = valid ? d3 + bb[3 * BIAS_LD] : -1e30f;
            psc[(g * 4 + 0) * 192 + j] = v0; psc[(g * 4 + 1) * 192 + j] = v1; psc[(g * 4 + 2) * 192 + j] = v2; psc[(g * 4 + 3) * 192 + j] = v3;
            mx0 = fmaxf(mx0, v0); mx1 = fmaxf(mx1, v1); mx2 = fmaxf(mx2, v2); mx3 = fmaxf(mx3, v3);
        }
#pragma unroll
        for (int o = 1; o < 64; o <<= 1) { mx0 = fmaxf(mx0, __shfl_xor(mx0, o)); mx1 = fmaxf(mx1, __shfl_xor(mx1, o)); mx2 = fmaxf(mx2, __shfl_xor(mx2, o)); mx3 = fmaxf(mx3, __shfl_xor(mx3, o)); }
        asm volatile("s_waitcnt lgkmcnt(0)" ::: "memory");
        float s0 = 0.f, s1 = 0.f, s2 = 0.f, s3 = 0.f;
#pragma unroll 1
        for (int gj = 0; gj < 9; ++gj) {
            const int g = gj / 3, j = (gj % 3) * 64 + lane;
            LAS float* pp = psc + (g * 4) * 192 + j;
            const float l0 = pp[0], l1 = pp[192], l2 = pp[384], l3 = pp[576];
            const float p0 = l0 > -1e29f ? __builtin_amdgcn_exp2f(l0 - mx0) : 0.f, p1 = l1 > -1e29f ? __builtin_amdgcn_exp2f(l1 - mx1) : 0.f, p2 = l2 > -1e29f ? __builtin_amdgcn_exp2f(l2 - mx2) : 0.f, p3 = l3 > -1e29f ? __builtin_amdgcn_exp2f(l3 - mx3) : 0.f;
            pp[0] = p0; pp[192] = p1; pp[384] = p2; pp[576] = p3;
            s0 += p0; s1 += p1; s2 += p2; s3 += p3;
        }
        s0 = wave_sum(s0); s1 = wave_sum(s1); s2 = wave_sum(s2); s3 = wave_sum(s3);
        asm volatile("s_waitcnt lgkmcnt(0)" ::: "memory");
        const int ksub = lane >> 4, dq = (lane & 15) * 4;
        f32x4 oa0 = (f32x4){0.f, 0.f, 0.f, 0.f}, oa1 = oa0, oa2 = oa0, oa3 = oa0;
#pragma unroll 1
        for (int g = 0; g < 3; ++g) {
            const int sh = 2 * g;
#pragma unroll 11
            for (int j0 = 0; j0 < 132; j0 += 4) {
                const int j = j0 + ksub; const int jc = j > 128 ? 128 : j;
                const int pext = 2048 + t - (jc << sh);
                const float* vp = pext < 2048 ? cache + ((size_t)(b * 2048 + pext) * 2 + 1) * 256 + kvh * 64 + dq : kvs + (size_t)(b * TS + (pext - 2048)) * 512 + 256 + kvh * 64 + dq;
                const f32x4 vv = *(const f32x4*)vp;
                const LAS float* pp = psc + (g * 4) * 192 + jc;
                const bool ok = j <= 128;
                const float p0 = ok ? pp[0] : 0.f, p1 = ok ? pp[192] : 0.f, p2 = ok ? pp[384] : 0.f, p3 = ok ? pp[576] : 0.f;
                oa0 = oa0 + vv * p0; oa1 = oa1 + vv * p1; oa2 = oa2 + vv * p2; oa3 = oa3 + vv * p3;
            }
        }
#pragma unroll
        for (int e = 0; e < 4; ++e) {
            oa0[e] += __shfl_xor(oa0[e], 16); oa0[e] += __shfl_xor(oa0[e], 32); oa1[e] += __shfl_xor(oa1[e], 16); oa1[e] += __shfl_xor(oa1[e], 32);
            oa2[e] += __shfl_xor(oa2[e], 16); oa2[e] += __shfl_xor(oa2[e], 32); oa3[e] += __shfl_xor(oa3[e], 16); oa3[e] += __shfl_xor(oa3[e], 32);
        }
        if (ksub == 0) {
            bf16_t* op = ATT + qrow * D + kvh * 256 + dq;
            const float i0 = 1.f / s0, i1 = 1.f / s1, i2 = 1.f / s2, i3 = 1.f / s3;
            u32x2 wv;
            wv.x = pk2(oa0.x * i0, oa0.y * i0); wv.y = pk2(oa0.z * i0, oa0.w * i0); *(u32x2*)(op) = wv;
            wv.x = pk2(oa1.x * i1, oa1.y * i1); wv.y = pk2(oa1.z * i1, oa1.w * i1); *(u32x2*)(op + 64) = wv;
            wv.x = pk2(oa2.x * i2, oa2.y * i2); wv.y = pk2(oa2.z * i2, oa2.w * i2); *(u32x2*)(op + 128) = wv;
            wv.x = pk2(oa3.x * i3, oa3.y * i3); wv.y = pk2(oa3.z * i3, oa3.w * i3); *(u32x2*)(op + 192) = wv;
        }
        asm volatile("s_waitcnt lgkmcnt(0)" ::: "memory");
    }
    const int per_cu = (4096 + gdimx - 1) / gdimx;
    for (;;) {
        int kx = 0;
        if (lane == 0) kx = (int)__hip_atomic_fetch_add((LAS unsigned*)ctr, 1u, __ATOMIC_RELAXED, __HIP_MEMORY_SCOPE_WORKGROUP);
        kx = __builtin_amdgcn_readfirstlane(kx);
        if (kx >= per_cu * ATT_REP_P) break;
        const int amode = (kx >= per_cu) ? ATT_MODE2 : 0;
        kx = kx % per_cu;
        const int it = bidx * per_cu + kx;
        if (it >= 4096) break;
        const int b = it >> 10, rem = it & 1023, kvh = rem >> 8, tg = rem & 255;
        const int tbase = (tg >> 4) * 256 + (tg & 15);
        const size_t qrowA = (size_t)b * TP + tbase + 16 * iq, qrowB = qrowA + 128;
        float mA = -1e4f, lA = 0.f, mB = -1e4f, lB = 0.f;
        f32x16 oA0, oA1, oB0, oB1;
#pragma unroll
        for (int e = 0; e < 16; ++e) { oA0[e] = 0.f; oA1[e] = 0.f; oB0[e] = 0.f; oB1[e] = 0.f; }
#pragma unroll 1
        for (int g = 0; g < 3; ++g) {
            const int sh = 2 * g, dmask = (1 << sh) - 1;
            const int c = tbase & dmask, u0 = tbase >> sh, qs = 16 >> sh;
            bf16x8 qfA[4], qfB[4];
            { const bf16_t* qp = Q + qrowA * 3072 + g * 1024 + kvh * 256 + r * 64 + hh * 8;
#pragma unroll
              for (int ks = 0; ks < 4; ++ks) { qfA[ks] = *(const bf16x8*)(qp + ks * 16); qfB[ks] = *(const bf16x8*)(qp + (size_t)128 * 3072 + ks * 16); } }
            const int ustart = (u0 - 128) & ~31;
            const int ntile = ((u0 + 15 * qs) >> 5) - (ustart >> 5) + 1;
            const int tau0 = ustart < 0 ? ((-ustart) >> 5) : 0;
            const int uqA = u0 + qs * iq, uqB = uqA + 8 * qs;
            const int tA1 = ((u0 + 7 * qs) - ustart) >> 5;
            const int tB0 = ((u0 + 8 * qs - 128) - ustart) >> 5;
            const size_t tile0 = (size_t)((((b * 4 + kvh) << sh) + c) * (128 >> sh) + (ustart >> 5)) * 2048;
            const bf16_t* Kg = KT + (size_t)g * VT_COPY + tile0 + hh * 256 + n * 8;
            const bf16_t* Vg = VT + (size_t)g * VT_COPY + tile0 + hh * 256 + n * 8;
            const LAS float* btA = bias + (g * 16 + kvh * 4 + r) * BIAS_LD + (BIAS_OFF - (uqA - ustart) + 4 * hh);
            const LAS float* btB = btA - 8 * qs;
            bf16x8 kfA[4], vfA[2][2], kfB[4], vfB[2][2];
#define ATT_LOAD(KF, VF, TAU) do { if (amode == 1 && (TAU) != tau0) break; \
                const bf16_t* kp_ = Kg + (size_t)(TAU) * 2048; \
                if (amode != 4) { _Pragma("unroll") for (int ks = 0; ks < 4; ++ks) KF[ks] = *(const bf16x8*)(kp_ + ks * 512); } \
                if (amode == 3) break; \
                const bf16_t* vb_ = Vg + (size_t)(TAU) * 2048; \
                _Pragma("unroll") for (int sI = 0; sI < 2; ++sI) { \
                    _Pragma("unroll") for (int dt = 0; dt < 2; ++dt) VF[sI][dt] = *(const bf16x8*)(vb_ + (sI * 2 + dt) * 512); } } while (0)
#define ATT_BLOCK(KF, VF, TAU, QF, BT0, MR, LR, O0, O1) do { \
                f32x16 S; _Pragma("unroll") for (int e = 0; e < 16; ++e) S[e] = 0.f; \
                _Pragma("unroll") for (int ks = 0; ks < 4; ++ks) S = __builtin_amdgcn_mfma_f32_32x32x16_bf16(KF[ks], QF[ks], S, 0, 0, 0); \
                const LAS float* bt = BT0 + 32 * (TAU); \
                float mx = -1e30f; \
                _Pragma("unroll") for (int e = 0; e < 16; ++e) { S[e] += bt[(e >> 2) * 8 + (e & 3)]; } \
                _Pragma("unroll") for (int e = 0; e < 16; ++e) mx = fmaxf(mx, S[e]); \
                mx = fmaxf(mx, __shfl_xor(mx, 32)); \
                if (__any(mx > MR + 8.0f)) { const float m_new = fmaxf(MR, mx); const float alpha = __builtin_amdgcn_exp2f(MR - m_new); MR = m_new; LR *= alpha; \
                    _Pragma("unroll") for (int e = 0; e < 16; ++e) { O0[e] *= alpha; O1[e] *= alpha; } } \
                float ps = 0.f; \
                _Pragma("unroll") for (int e = 0; e < 16; ++e) { const float p = __builtin_amdgcn_exp2f(S[e] - MR); S[e] = p; ps += p; } \
                LR += ps; \
                _Pragma("unroll") for (int sI = 0; sI < 2; ++sI) { \
                    u32x4 pw; pw.x = pk2(S[8 * sI + 0], S[8 * sI + 1]); pw.y = pk2(S[8 * sI + 2], S[8 * sI + 3]); pw.z = pk2(S[8 * sI + 4], S[8 * sI + 5]); pw.w = pk2(S[8 * sI + 6], S[8 * sI + 7]); \
                    const bf16x8 pb = __builtin_bit_cast(bf16x8, pw); \
                    O0 = __builtin_amdgcn_mfma_f32_32x32x16_bf16(VF[sI][0], pb, O0, 0, 0, 0); \
                    O1 = __builtin_amdgcn_mfma_f32_32x32x16_bf16(VF[sI][1], pb, O1, 0, 0, 0); } } while (0)
#define ATT_TILE(KF, VF, TAU) do { if (amode >= 2) { asm volatile("" :: "v"(KF[0]), "v"(KF[3]), "v"(VF[0][0]), "v"(VF[1][1])); break; } \
                if ((TAU) <= tA1) ATT_BLOCK(KF, VF, TAU, qfA, btA, mA, lA, oA0, oA1); \
                if ((TAU) >= tB0) ATT_BLOCK(KF, VF, TAU, qfB, btB, mB, lB, oB0, oB1); } while (0)
            ATT_LOAD(kfA, vfA, tau0);
            int tau = tau0;
#pragma unroll 1
            for (; tau + 1 < ntile; tau += 2) {
                ATT_LOAD(kfB, vfB, tau + 1);
                ATT_TILE(kfA, vfA, tau);
                { const int tn = (tau + 2 < ntile) ? tau + 2 : tau + 1; ATT_LOAD(kfA, vfA, tn); }
                ATT_TILE(kfB, vfB, tau + 1);
            }
            if (tau < ntile) ATT_TILE(kfA, vfA, tau);
#undef ATT_LOAD
#undef ATT_BLOCK
#undef ATT_TILE
        }
#define ATT_OUT(QROW, LR, O0, O1) do { \
            const float lt = LR + __shfl_xor(LR, 32); const float inv = 1.f / lt; \
            bf16_t* op = ATT + (QROW) * D + kvh * 256 + r * 64 + hh * 4; \
            _Pragma("unroll") for (int e4 = 0; e4 < 4; ++e4) { \
                u32x2 w0; w0.x = pk2(O0[e4 * 4 + 0] * inv, O0[e4 * 4 + 1] * inv); w0.y = pk2(O0[e4 * 4 + 2] * inv, O0[e4 * 4 + 3] * inv); \
                u32x2 w1; w1.x = pk2(O1[e4 * 4 + 0] * inv, O1[e4 * 4 + 1] * inv); w1.y = pk2(O1[e4 * 4 + 2] * inv, O1[e4 * 4 + 3] * inv); \
                if (amode == 0) { *(u32x2*)(op + e4 * 8) = w0; *(u32x2*)(op + 32 + e4 * 8) = w1; } else { asm volatile("" :: "v"(w0), "v"(w1)); } } } while (0)
        ATT_OUT(qrowA, lA, oA0, oA1);
        ATT_OUT(qrowB, lB, oB0, oB1);
#undef ATT_OUT
    }
}

#define XB_TMO      128
#define XB_XCNT(j)  (256  + 64 * (j))
#define XB_XSUB(j)  (1280 + 64 * (j))
#define XB_XGEN(j)  (2304 + 64 * (j))
#define XB_TOP      3328
#define XB_TOPGEN   3392
#define XCD_BAR_WORDS 3456
#define XB_SPIN_CAP (1u << 18)
__device__ __forceinline__ unsigned xb_ld(unsigned* p)              { return __hip_atomic_load(p, __ATOMIC_RELAXED, __HIP_MEMORY_SCOPE_AGENT); }
__device__ __forceinline__ unsigned xb_add(unsigned* p, unsigned v) { return __hip_atomic_fetch_add(p, v, __ATOMIC_RELAXED, __HIP_MEMORY_SCOPE_AGENT); }
__device__ __forceinline__ unsigned xb_xcc_id() { return (unsigned)__builtin_amdgcn_s_getreg((3 << 11) | 20) & 0xFu; }
#define XB_SPIN(cond, bar) do { unsigned _sp = 0; while (cond) { __builtin_amdgcn_s_sleep(1); \
    if ((++_sp & 255u) == 0u) { if (xb_ld(&(bar)[XB_TMO])) break; if (_sp > XB_SPIN_CAP) { atomicAdd(&(bar)[XB_TMO], 1u); break; } } } } while (0)
struct XcdBarrier { unsigned* bar; unsigned x; volatile LAS unsigned* st; };
__device__ __forceinline__ XcdBarrier xcd_barrier_post(unsigned* bar, volatile LAS unsigned* st) {
    XcdBarrier b; b.bar = bar; b.x = xb_xcc_id(); b.st = st;
    if (threadIdx.x == 0) (void)xb_add(&bar[XB_XCNT(b.x)], 1u);
    return b;
}
__device__ __forceinline__ void xcd_barrier_complete(unsigned* bar, unsigned x, unsigned& nloc, unsigned& nx) {
    const unsigned G = gridDim.x * gridDim.y * gridDim.z;
    unsigned sum, cnt, mine, sp = 0u;
    for (;;) {
        sum = 0u; cnt = 0u; mine = 0u;
#pragma unroll
        for (unsigned j = 0; j < 16; ++j) { const unsigned c = xb_ld(&bar[XB_XCNT(j)]); sum += c; cnt += (c > 0u) ? 1u : 0u; mine = (j == x) ? c : mine; }
        if (sum == G) break;
        __builtin_amdgcn_s_sleep(1);
        if ((++sp & 255u) == 0u) { if (xb_ld(&bar[XB_TMO])) break; if (sp > XB_SPIN_CAP) { atomicAdd(&bar[XB_TMO], 1u); break; } }
    }
    nloc = mine > 0u ? mine : 1u; nx = cnt > 0u ? cnt : 1u;
}
__device__ __forceinline__ void xcd_barrier(const XcdBarrier& b) {
    asm volatile("s_waitcnt vmcnt(0)" ::: "memory");
    __syncthreads();
    if (threadIdx.x == 0) {
        unsigned* bar = b.bar;
        __builtin_amdgcn_s_waitcnt(0);
        unsigned nloc = b.st[0], nx = b.st[1];
        if (nloc == 0u) { xcd_barrier_complete(bar, b.x, nloc, nx); b.st[0] = nloc; b.st[1] = nx; }
        const unsigned old = xb_add(&bar[XB_XSUB(b.x)], 1u);
        const unsigned gen = old / nloc;
        if (old + 1u == (gen + 1u) * nloc) {
            __builtin_amdgcn_fence(__ATOMIC_RELEASE, "agent");
            asm volatile("s_waitcnt vmcnt(0)" ::: "memory");
            const unsigned og = xb_add(&bar[XB_TOP], 1u);
            const unsigned tg = og / nx;
            if (og + 1u == (tg + 1u) * nx) xb_add(&bar[XB_TOPGEN], 1u);
            else XB_SPIN(xb_ld(&bar[XB_TOPGEN]) == tg, bar);
            __builtin_amdgcn_fence(__ATOMIC_ACQUIRE, "agent");
            xb_add(&bar[XB_XGEN(b.x)], 1u);
            asm volatile("s_waitcnt vmcnt(0)" ::: "memory");
        } else {
            XB_SPIN(xb_ld(&bar[XB_XGEN(b.x)]) == gen, bar);
            __builtin_amdgcn_fence(__ATOMIC_ACQUIRE, "agent");
            asm volatile("s_waitcnt vmcnt(0)" ::: "memory");
        }
    }
    __syncthreads();
}

constexpr int LDS_BYTES = LDS_BYTES_ALL; static_assert(ATT_BIAS_BYTES + 4 * ATT_WSCR + 64 <= LDS_CTL_OFF && STAGE_BYTES <= LDS_CTL_OFF, "LDS");
__global__ void __launch_bounds__(NTHREADS, 2) fwd_kernel(Params P) {
    extern __shared__ __attribute__((aligned(16))) unsigned char lds_raw[];
    LAS unsigned char* lds = (LAS unsigned char*)lds_raw;
    (void)P;
#ifdef CODE_PREFETCH
    {
        const char* pcb = (const char*)((unsigned long long)__builtin_amdgcn_s_getpc() & ~0xFFull);
        u32x4 acc = (u32x4){0u, 0u, 0u, 0u};
        for (int off = (int)threadIdx.x * 16; off < CODE_PREFETCH; off += NTHREADS * 16) { const u32x4 v = *(const u32x4*)(pcb + off); acc.x ^= v.x; acc.y ^= v.y; acc.z ^= v.z; acc.w ^= v.w; }
        if ((acc.x ^ acc.y ^ acc.z ^ acc.w) == 0x9e3779b9u && threadIdx.x == 12345u) ((volatile LAS unsigned*)lds)[0] = acc.x;
    }
#endif
    volatile LAS unsigned* bst = (volatile LAS unsigned*)(lds + LDS_CTL_OFF);
    if (threadIdx.x < 4) bst[threadIdx.x] = 0u;
    __syncthreads();
    { KPtr kp = kp_fresh(); (void)xcd_barrier_post((unsigned*)(kp->ws + O_CTL), bst); }
#ifndef REPEAT_MASK
#define REPEAT_MASK 0
#endif
#ifndef DRY_MASK
#define DRY_MASK 0
#endif
#ifndef ZS_MASK
#define ZS_MASK 0
#endif
#ifndef EXTRA_SYNCS
#define EXTRA_SYNCS 0
#endif
#ifdef AMP_MASK
    long long t0amp = wall_clock64();
#endif
#pragma unroll 1
    for (int ph = 0; ph < NPH; ++ph) {
      const int reps = (((REPEAT_MASK | DRY_MASK | ZS_MASK) >> ph) & 1) ? 2 : 1;
#pragma unroll 1
      for (int rep = 0; rep < reps; ++rep) {
#ifdef REP_BARRIER
        if (rep > 0) { KPtr kp = kp_fresh(); XcdBarrier xb; xb.bar = (unsigned*)(kp->ws + O_CTL); xb.x = xb_xcc_id(); xb.st = (volatile LAS unsigned*)(lds + LDS_CTL_OFF); xcd_barrier(xb); }
#endif
        if (ph == PH_PRO) {
#ifndef NO_PRO
            prologue_phase(kp_fresh(), lds);
#endif
        }
        else if (ph == PH_MIX) {
#ifndef NO_ROW
            mix_pass(kp_fresh());
#endif
        }
        else if (ph == PH_SCAN) {
#ifndef NO_SCAN
            scan_phase(kp_fresh(), lds);
#endif
        }
        else if (ph == PH_POST) {
#ifndef NO_ROW
            post_pass(kp_fresh());
#endif
        }
        else if (ph == PH_ATTN) {
#ifndef NO_ATTN
            vt_build(kp_fresh(), lds);
            { KPtr kp = kp_fresh(); XcdBarrier xb; xb.bar = (unsigned*)(kp->ws + O_CTL); xb.x = xb_xcc_id(); xb.st = (volatile LAS unsigned*)(lds + LDS_CTL_OFF); xcd_barrier(xb); }
            attn_phase(kp_fresh(), lds);
#endif
        }
        else if (ph == PH_FINAL) {
#ifndef NO_ROW
            final_pass(kp_fresh());
#endif
        }
        else {
#ifndef NO_GEMM
#pragma unroll 1
            for (int pass2 = 0; pass2 < 2; ++pass2) {
                KPtr kp = kp_fresh();
                if (pass2) {
                    if (!(ph == PH_F2I1 && gdim_fresh() == 256 && bid_fresh() >= 252)) break;
                    if (threadIdx.x < 64) {
                        unsigned* dep = (unsigned*)(kp->ws + O_CTL) + CW_DEP + (20 + ph) * 64; unsigned sp = 0;
                        while ((unsigned)__builtin_amdgcn_readfirstlane(__hip_atomic_load(dep, __ATOMIC_RELAXED, __HIP_MEMORY_SCOPE_AGENT)) < 4u) { __builtin_amdgcn_s_sleep(2); if (++sp > (1u << 22)) break; }
                        __builtin_amdgcn_fence(__ATOMIC_ACQUIRE, "agent");
                    }
                    __syncthreads();
                }
                gemm_phase(kp->ws, kp->out, lds, ph, (rep == 0 && ((DRY_MASK >> ph) & 1)) ? 1 : ((rep == 0 && ((ZS_MASK >> ph) & 1)) ? 2 : 0), pass2);
            }
#endif
        }
      }
        if (ph + 1 < NPH) { KPtr kp = kp_fresh(); XcdBarrier xb; xb.bar = (unsigned*)(kp->ws + O_CTL); xb.x = xb_xcc_id(); xb.st = (volatile LAS unsigned*)(lds + LDS_CTL_OFF); xcd_barrier(xb); }
#ifdef AMP_MASK
        if (((AMP_MASK >> ph) & 1) && bid_fresh() == 0) { const long long t1 = wall_clock64(); const long long tend = t1 + (long long)AMP_K * (t1 - t0amp); while (wall_clock64() < tend) __builtin_amdgcn_s_sleep(32); }
        t0amp = wall_clock64();
#endif
    }
}

extern "C" void kernel_launch(void* const* d_in, const int* in_sizes, int n_in, void* d_out, int out_size, void* d_ws, size_t ws_size, hipStream_t stream) {
    static int grid_blocks = 0;
    if (grid_blocks == 0) {
        if (n_in != 36 || ws_size < WS_END) { fprintf(stderr, "kernel_launch: unexpected n_in %d or ws_size %zu (< %zu)\n", n_in, ws_size, (size_t)WS_END); grid_blocks = -1; return; }
        int dev = 0, cus = 0, per_cu = 0;
        hipGetDevice(&dev);
        hipDeviceGetAttribute(&cus, hipDeviceAttributeMultiprocessorCount, dev);
        hipFuncSetAttribute((const void*)fwd_kernel, hipFuncAttributeMaxDynamicSharedMemorySize, LDS_BYTES);
        hipOccupancyMaxActiveBlocksPerMultiprocessor(&per_cu, (const void*)fwd_kernel, NTHREADS, LDS_BYTES);
        if (per_cu < 1) { fprintf(stderr, "kernel_launch: occupancy query says %d blocks per CU\n", per_cu); grid_blocks = -1; return; }
        grid_blocks = cus;
    }
    if (grid_blocks < 0) return;
    if (hipMemsetAsync((char*)d_ws + O_CTL, 0, CTL_BYTES, stream) != hipSuccess) { fprintf(stderr, "kernel_launch: memset failed\n"); return; }
    Params p{};
    for (int i = 0; i < 36; ++i) p.in[i] = (const float*)d_in[i];
    p.out = (float*)d_out; p.ws = (unsigned char*)d_ws;
    void* args[] = {&p};
    hipError_t e = hipLaunchCooperativeKernel((const void*)fwd_kernel, dim3(grid_blocks), dim3(NTHREADS), args, LDS_BYTES, stream);
    if (e != hipSuccess) fprintf(stderr, "cooperative launch failed: %s (grid %d)\n", hipGetErrorString(e), grid_blocks);
}
```

```cpp
#include <hip/hip_runtime.h>
#include <cstdio>
#include <cstdint>

#define LAS __attribute__((address_space(3)))
typedef unsigned short bf16_t;
typedef short bf16x8 __attribute__((ext_vector_type(8)));
typedef float f32x4 __attribute__((ext_vector_type(4)));
typedef float f32x2 __attribute__((ext_vector_type(2)));
typedef float f32x16 __attribute__((ext_vector_type(16)));
typedef unsigned u32x4 __attribute__((ext_vector_type(4)));
typedef unsigned u32x2 __attribute__((ext_vector_type(2)));
typedef __bf16 bf16x2_t __attribute__((ext_vector_type(2)));

constexpr int D = 1024, FF = 2816, MP = 16384, MS = 256, M = MP + MS, TP = 4096, TS = 8;
constexpr int NTHREADS = 512;
constexpr float RMS_EPS = 1e-6f;
constexpr size_t O_YP = 0, O_YS = 16777216, O_WKVP = 17039360, O_SHP = 17301504, O_KVP = 17305600, O_WKVS = 21499904, O_SHS = 23597056, O_KVS = 23629824;
constexpr size_t SL = (size_t)M * 1024 * 2;
constexpr size_t W_F1I = 0;
constexpr size_t W_F2I = W_F1I + 2 * (size_t)5632 * 1024 * 2;
constexpr size_t W_F1O = W_F2I + 2 * (size_t)5632 * 1024 * 2;
constexpr size_t W_F2O = W_F1O + 2 * (size_t)1024 * 2816 * 2;
constexpr size_t W_PEG = W_F2O + 2 * (size_t)1024 * 2816 * 2;
constexpr size_t W_PEP = W_PEG + 2 * (size_t)1024 * 1024 * 2;
constexpr size_t W_RKV = W_PEP + 2 * (size_t)1024 * 256 * 2;
constexpr size_t W_L1 = W_RKV + (size_t)3072 * 1024 * 2;
constexpr size_t W_L2W = W_L1 + (size_t)768 * 1024 * 2;
constexpr size_t W_L2A = W_L2W + (size_t)1024 * 128 * 2;
constexpr size_t W_L2G = W_L2A + (size_t)1024 * 128 * 2;
constexpr size_t W_RWO = W_L2G + (size_t)1024 * 256 * 2;
constexpr size_t W_Q = W_RWO + (size_t)1024 * 1024 * 2;
constexpr size_t W_KV = W_Q + (size_t)3072 * 1024 * 2;
constexpr size_t W_AO = W_KV + (size_t)512 * 1024 * 2;
constexpr size_t W_END = W_AO + (size_t)1024 * 1024 * 2;
constexpr size_t O_HB0 = (W_END + 4095) & ~(size_t)4095;
constexpr size_t O_HB1 = O_HB0 + SL;
constexpr size_t O_SSQ0 = O_HB1 + SL;
constexpr size_t O_SSQ1 = O_SSQ0 + (size_t)M * 16 * 4;
constexpr size_t O_PB = O_SSQ1 + (size_t)M * 16 * 4;
constexpr size_t O_R2 = O_PB + 2 * (size_t)M * 256 * 2;
constexpr size_t R2_BYTES = (size_t)128 << 20;
constexpr size_t O_R4 = O_R2 + R2_BYTES;
constexpr size_t O_CTL = O_R4 + 6 * SL;
constexpr size_t CTL_BYTES = 65536;
constexpr size_t O_PAR = O_CTL + 32768;
constexpr size_t WS_END = O_CTL + CTL_BYTES;
constexpr size_t O_ACT = O_R2;
constexpr size_t O_RKVB = O_R2;
constexpr size_t O_MW = O_R2 + (size_t)M * 3072 * 2;
constexpr size_t O_MA = O_MW + (size_t)M * 128 * 2;
constexpr size_t O_MG = O_MA + (size_t)M * 128 * 2;
constexpr size_t O_YG = O_R2;
static_assert(O_MG + (size_t)M * 256 * 2 <= O_R2 + R2_BYTES, "R2");
constexpr size_t O_WL = O_R4, O_AL = O_R4 + SL, O_GG = O_R4 + 2 * SL, O_Y = O_R4 + 3 * SL, O_BON = O_R4 + 4 * SL, O_PP = O_R4 + 5 * SL;
constexpr size_t O_Q = O_R4, O_ATT = O_R4 + 3 * SL, O_KB = O_R4 + 4 * SL, O_VT = O_KB + (size_t)MP * 256 * 2;
constexpr size_t O_VB = O_R2 + ((size_t)96 << 20);
static_assert(O_VB >= O_ACT + (size_t)M * FF * 2 && O_VB + (size_t)MP * 256 * 2 <= O_R2 + R2_BYTES, "VB");
constexpr size_t VT_COPY = (size_t)MP * 256;
constexpr size_t O_KT = O_R2 + ((size_t)104 << 20);
static_assert(O_KT >= O_VB + (size_t)MP * 256 * 2 && O_KT + 3 * VT_COPY * 2 <= O_R2 + R2_BYTES, "KT");
static_assert(O_VT + 3 * VT_COPY * 2 <= O_R4 + 5 * SL, "R4 slot 4");

struct Params { const float* in[36]; float* out; unsigned char* ws; };
typedef const Params __attribute__((address_space(4)))* KPtr;
__device__ __forceinline__ int tid_fresh() { int t = threadIdx.x; asm volatile("" : "+v"(t)); return t; }
__device__ __forceinline__ int bid_fresh() { int t = blockIdx.x; asm volatile("" : "+s"(t)); return t; }
__device__ __forceinline__ int gdim_fresh() { int t = gridDim.x; asm volatile("" : "+s"(t)); return t; }
__device__ __forceinline__ KPtr kp_fresh() { KPtr p = (KPtr)__builtin_amdgcn_kernarg_segment_ptr(); asm volatile("" : "+s"(p)); return p; }

__device__ __forceinline__ unsigned pk2(float lo, float hi) { f32x2 v = {lo, hi}; bf16x2_t b = __builtin_convertvector(v, bf16x2_t); return __builtin_bit_cast(unsigned, b); }
__device__ __forceinline__ float bf2f(unsigned short h) { return __builtin_bit_cast(float, (unsigned)h << 16); }
__device__ __forceinline__ float bflo(unsigned w) { return __builtin_bit_cast(float, w << 16); }
__device__ __forceinline__ float bfhi(unsigned w) { return __builtin_bit_cast(float, w & 0xffff0000u); }
template <int CTRL> __device__ __forceinline__ float dpp_mov(float x) { return __builtin_bit_cast(float, __builtin_amdgcn_update_dpp(0, __builtin_bit_cast(int, x), CTRL, 0xF, 0xF, true)); }
__device__ __forceinline__ float row_sum16(float x) {
    x += dpp_mov<0x128>(x); x += dpp_mov<0x124>(x); x += dpp_mov<0x122>(x); x += dpp_mov<0x121>(x); return x;
}
__device__ __forceinline__ float wave_sum(float v) {
#pragma unroll
    for (int o = 1; o < 64; o <<= 1) v += __shfl_xor(v, o);
    return v;
}
__device__ __forceinline__ float rstd_of(const float* ssq, int row) {
    const f32x4* p = (const f32x4*)(ssq + (size_t)row * 16);
    const f32x4 a = p[0], b = p[1], c = p[2], d = p[3];
    const float s = ((a.x + a.y) + (a.z + a.w)) + ((b.x + b.y) + (b.z + b.w)) + ((c.x + c.y) + (c.z + c.w)) + ((d.x + d.y) + (d.z + d.w));
    return __builtin_amdgcn_rsqf(s * (1.0f / 1024.0f) + RMS_EPS);
}
struct F8 { float v[8]; };
__device__ __forceinline__ F8 unpack8(u32x4 w) { F8 r; r.v[0] = bflo(w.x); r.v[1] = bfhi(w.x); r.v[2] = bflo(w.y); r.v[3] = bfhi(w.y); r.v[4] = bflo(w.z); r.v[5] = bfhi(w.z); r.v[6] = bflo(w.w); r.v[7] = bfhi(w.w); return r; }
__device__ __forceinline__ u32x4 pack8(const F8& f) { u32x4 w; w.x = pk2(f.v[0], f.v[1]); w.y = pk2(f.v[2], f.v[3]); w.z = pk2(f.v[4], f.v[5]); w.w = pk2(f.v[6], f.v[7]); return w; }
__device__ __forceinline__ F8 load8f(const float* p) { const f32x4 a = *(const f32x4*)p, b = *(const f32x4*)(p + 4); F8 r; r.v[0] = a.x; r.v[1] = a.y; r.v[2] = a.z; r.v[3] = a.w; r.v[4] = b.x; r.v[5] = b.y; r.v[6] = b.z; r.v[7] = b.w; return r; }
__device__ __forceinline__ float row_sum8(float x) {
    x += dpp_mov<0xB1>(x); x += dpp_mov<0x4E>(x); x += dpp_mov<0x141>(x); return x;
}
__device__ __forceinline__ float sigmoidf_(float x) { return __builtin_amdgcn_rcpf(1.0f + __expf(-x)); }

constexpr int LDS_BYTES_ALL = 147456, LDS_CTL_OFF = LDS_BYTES_ALL - 2048;
constexpr int BM = 256, BK = 64, HALF = 128, HTB = HALF * BK * 2, STAGE_BYTES = 8 * HTB, NXCD = 8, WGM = 8;
__host__ __device__ __forceinline__ int lds_byte(int r, int c) { const int st = (r >> 4) * 2 + (c >> 5), rr = r & 15, cc = c & 31, ob = rr * 64 + cc * 2; return st * 1024 + (ob ^ (((ob >> 9) & 1) << 5)); }
__host__ __device__ __forceinline__ void stage_rc(int b, int& R, int& C) { const int st = b / 1024, sb = b % 1024, swz = sb ^ (((sb >> 9) & 1) << 5); R = (st >> 1) * 16 + swz / 64; C = (st & 1) * 32 + (swz % 64) / 2; }

enum { EPI_SWIGLU = 0, EPI_RESID = 1, EPI_PE = 2, EPI_BF16 = 3, EPI_KV = 4 };
struct Unit { const char* A; const char* B; int pitchA, pitchB, nt, si, pm, pn, wait, eph; };
struct Epi { int epi; void* o0; const float* ssq_in; float* ssq_out; const bf16_t* pbuf; float scale; int opitch, ocol0, ncols, act; };

enum { PH_PRO = 0, PH_F1I0, PH_F1O0, PH_MIX, PH_RKV, PH_L2, PH_SCAN, PH_POST, PH_RWO, PH_F2I0, PH_F2O0, PH_PE0,
       PH_F1I1, PH_F1O1, PH_QKV, PH_ATTN, PH_AO, PH_F2I1, PH_F2O1, PH_PE1, PH_FINAL, NPH };

__device__ __forceinline__ bool get_gemm(unsigned char* ws, int ph, int si, Unit& u, int& nN) {
    size_t a = 0, b = 0; int pA = 2048, pB = 2048, nt = 16; nN = 4;
    switch (ph) {
    case PH_F1I0: case PH_F2I0: case PH_F1I1: case PH_F2I1: {
        if (si > 0) return false;
        const int l = (ph == PH_F1I1 || ph == PH_F2I1) ? 1 : 0; const bool f2 = (ph == PH_F2I0 || ph == PH_F2I1);
        a = O_HB0; b = (f2 ? W_F2I : W_F1I) + (size_t)l * 5632 * 1024 * 2; nN = 22; break; }
    case PH_F1O0: case PH_F1O1: {
        if (si > 0) return false;
        a = O_ACT; b = W_F1O + (size_t)(ph == PH_F1O1 ? 1 : 0) * 1024 * 2816 * 2; pA = 5632; pB = 5632; nt = 44; break; }
    case PH_F2O0: case PH_F2O1: {
        const int l = (ph == PH_F2O1) ? 1 : 0;
        if (si == 0) { a = O_ACT; b = W_F2O + (size_t)l * 1024 * 2816 * 2; pA = 5632; pB = 5632; nt = 44; }
        else if (si == 1) { a = O_PB + (size_t)l * M * 256 * 2; b = W_PEP + (size_t)l * 1024 * 256 * 2; pA = 512; pB = 512; nt = 4; }
        else return false;
        break; }
    case PH_RKV: {
        if (si < 3) { const int xi = (si == 0) ? 0 : (si == 1 ? 2 : 3); a = O_R4 + (size_t)xi * SL; b = W_RKV + (size_t)si * 1024 * 1024 * 2; }
        else if (si < 6) { const int j = si - 3; const int xi = (j == 0) ? 1 : (j == 1 ? 4 : 5); a = O_R4 + (size_t)xi * SL; b = W_L1 + (size_t)j * 256 * 1024 * 2; nN = 1; }
        else return false;
        break; }
    case PH_L2: {
        if (si == 0) { a = O_MG; b = W_L2G; pA = 512; pB = 512; nt = 4; }
        else if (si == 1) { a = O_MW; b = W_L2W; pA = 256; pB = 256; nt = 2; }
        else if (si == 2) { a = O_MA; b = W_L2A; pA = 256; pB = 256; nt = 2; }
        else return false;
        break; }
    case PH_RWO: if (si > 0) return false; a = O_YG; b = W_RWO; break;
    case PH_AO: if (si > 0) return false; a = O_ATT; b = W_AO; break;
    case PH_PE0: case PH_PE1: if (si > 0) return false; a = O_HB1; b = W_PEG + (size_t)(ph == PH_PE1 ? 1 : 0) * 1024 * 1024 * 2; break;
    case PH_QKV: {
        if (si == 0) { a = O_HB1; b = W_Q; nN = 12; }
        else if (si == 1) { a = O_HB0; b = W_KV; nN = 2; }
        else return false;
        break; }
    default: return false;
    }
    u.A = (const char*)(ws + a); u.B = (const char*)(ws + b); u.pitchA = pA; u.pitchB = pB; u.nt = nt; u.si = si; u.wait = 0; u.eph = ph; return true;
}
__device__ __forceinline__ void get_epi(unsigned char* ws, int ph, int si, Epi& s) {
    s.epi = EPI_BF16; s.o0 = nullptr; s.ssq_in = nullptr; s.ssq_out = nullptr; s.pbuf = nullptr; s.scale = 1.f; s.opitch = 1024; s.ocol0 = 0; s.ncols = 1024; s.act = 0;
    const float* ssq0 = (const float*)(ws + O_SSQ0); const float* ssq1 = (const float*)(ws + O_SSQ1);
    switch (ph) {
    case PH_F1I0: case PH_F2I0: case PH_F1I1: case PH_F2I1: s.epi = EPI_SWIGLU; s.o0 = ws + O_ACT; s.ssq_in = ssq0; break;
    case PH_F1O0: case PH_F1O1: s.epi = EPI_RESID; s.scale = 0.5f; s.o0 = ws + O_HB1; s.ssq_out = (float*)(ws + O_SSQ1); break;
    case PH_F2O0: case PH_F2O1:
        if (si == 0) { s.epi = EPI_RESID; s.scale = 0.5f; s.o0 = ws + O_HB1; s.ssq_out = (float*)(ws + O_SSQ1); }
        else { s.o0 = ws + O_PP; }
        break;
    case PH_RKV:
        if (si < 3) { s.o0 = ws + O_RKVB; s.opitch = 3072; s.ocol0 = si * 1024; }
        else { const int j = si - 3; s.o0 = ws + (j == 0 ? O_MW : (j == 1 ? O_MA : O_MG)); s.opitch = (j == 2) ? 256 : 128; s.ncols = s.opitch; s.act = (j == 0) ? 1 : (j == 1 ? 0 : 2); }
        break;
    case PH_L2: s.o0 = ws + (si == 0 ? O_GG : (si == 1 ? O_WL : O_AL)); s.act = (si == 0) ? 0 : (si == 1 ? 3 : 4); break;
    case PH_RWO: case PH_AO: s.epi = EPI_RESID; s.o0 = ws + O_HB0; s.ssq_out = (float*)(ws + O_SSQ0); break;
    case PH_PE0: case PH_PE1: s.epi = EPI_PE; s.o0 = ws + O_HB0; s.ssq_in = ssq1; s.ssq_out = (float*)(ws + O_SSQ0); s.pbuf = (const bf16_t*)(ws + O_PP); break;
    case PH_QKV:
        if (si == 0) { s.o0 = ws + O_Q; s.opitch = 3072; s.ncols = 3072; s.ssq_in = ssq1; }
        else { s.epi = EPI_KV; s.ssq_in = ssq0; }
        break;
    default: break;
    }
}

__device__ __forceinline__ void decode_tile(int L, int nM, int nN, int& pm, int& pn) {
    const int nwg = nM * nN;
    int wgid = L; { const int q = nwg / NXCD, r = nwg % NXCD, xcd = wgid % NXCD, off = wgid / NXCD; wgid = (xcd < r ? xcd * (q + 1) : r * (q + 1) + (xcd - r) * q) + off; }
    const int nig = WGM * nN, gid = wgid / nig, fm = gid * WGM, gsz = (nM - fm) < WGM ? (nM - fm) : WGM;
    pm = fm + ((wgid % nig) % gsz); pn = (wgid % nig) / gsz;
}
constexpr int CW_DEP = 4096;
__device__ __forceinline__ bool is_wi(int ph) { return ph == PH_F1I0 || ph == PH_F2I0 || ph == PH_F1I1 || ph == PH_F2I1; }
__device__ __forceinline__ bool is_wo(int ph) { return ph == PH_F1O0 || ph == PH_F2O0 || ph == PH_F1O1 || ph == PH_F2O1; }
__device__ __forceinline__ bool next_unit(unsigned char* ws, int ph, int i, int G, int c, Unit& u, int pass2) {
    int nN;
    if (pass2) {
        if (G == 256 && ph == PH_F2I1 && c >= 252 && i == 0) { get_gemm(ws, PH_PE1, 0, u, nN); u.pm = 64; u.pn = c - 252; u.wait = 8; u.eph = PH_PE1; return true; }
        return false;
    }
    if (G == 256 && is_wi(ph)) {
        const int pre = (ph == PH_F2I0) ? PH_RWO : (ph == PH_F1I1 ? PH_PE0 : (ph == PH_F2I1 ? PH_AO : -1));
        int L; int wt = 0;
        if (c >= 252) {
            if (i < 3) L = i * 256 + c;
            else if (i == 3) { get_gemm(ws, ph + 1, 0, u, nN); u.pm = 64; u.pn = c - 252; u.wait = 1; u.eph = ph + 1; return true; }
            else return false;
        } else if (pre >= 0 && c >= 248) {
            if (i == 0) { get_gemm(ws, pre, 0, u, nN); u.pm = 64; u.pn = c - 248; u.eph = pre; return true; }
            L = (i - 1) * 256 + c;
            if (L >= 1430) return false;
        } else {
            L = i * 256 + c;
            if (pre >= 0 && c < 22) L = (i + 1) * 256 + c;
            else if (pre >= 0 && c >= 160 && c < 182) { if (i == 2) { L = c - 160; wt = 2; } else if (i > 2) L = (i - 1) * 256 + c; }
            if (L >= 1430) {
                if (i == 5 && c >= 150 && c < 158) { const int k = c - 150; L = (3 + (k >> 2)) * 256 + 252 + (k & 3); }
                else if (pre >= 0 && (i == 5 || i == 6) && c >= 158 && c < 248 && !(c >= 160 && c < 182)) {
                    const int e = c < 160 ? c - 158 : c - 180, k = e * 2 + (i - 5);
                    if (k >= 130) return false;
                    const int fo = (ph == PH_F1I1) ? PH_F2O1 : (ph == PH_F2I1 ? PH_F2O1 : PH_F2O0);
                    const int idx = (ph == PH_F2I1) ? 126 + k : (ph == PH_F1I1 && k >= 126 ? k + 130 : k);
                    get_gemm(ws, fo, 1, u, nN); u.eph = fo; u.pm = idx >> 2; u.pn = idx & 3; return true;
                } else return false;
            }
        }
        get_gemm(ws, ph, 0, u, nN);
        if (L < 22) { u.pm = 64; u.pn = L; u.wait = wt; } else decode_tile(L - 22, 64, 22, u.pm, u.pn);
        return true;
    }
    int L = i * G + c;
    for (int si = 0; si < 6; ++si) {
        if (!get_gemm(ws, ph, si, u, nN)) return false;
        const int nM = (G == 256 && (is_wo(ph) || ph == PH_RWO || ph == PH_PE0 || ph == PH_PE1 || ph == PH_AO) && si == 0) ? 64 : M / BM;
        if (G == 256 && (ph == PH_F2O0 || ph == PH_F2O1) && si == 1) {
            const int first = (ph == PH_F2O0) ? 130 : 260, cnt = 260 - first;
            if (L < cnt) { const int idx = first + L; u.pm = idx >> 2; u.pn = idx & 3; return true; }
            L -= cnt; continue;
        }
        const int nwg = nM * nN;
        if (L < nwg) { decode_tile(L, nM, nN, u.pm, u.pn); return true; }
        L -= nwg;
    }
    return false;
}

template <int ACT>
__device__ __forceinline__ void epi_act(unsigned char* ws, f32x4 (&acc)[2][2][4][2], const Epi& s, const Unit& u, bf16_t* ob, int row0, int wc, int fq) {
#pragma unroll
    for (int bj = 0; bj < 2; ++bj) {
        const int lc = u.pn * BM + bj * HALF + wc * 32 + fq * 8;
        if (lc >= s.ncols) continue;
        float pa_[8], pb_[8];
#pragma unroll
        for (int q8 = 0; q8 < 8; ++q8) { pa_[q8] = 0.f; pb_[q8] = 0.f; }
        if (ACT >= 3) {
            const float* par = (const float*)(ws + O_PAR) + (ACT == 3 ? 0 : 2048) + lc;
            const f32x4 x0 = *(const f32x4*)par, x1 = *(const f32x4*)(par + 4);
            pa_[0] = x0.x; pa_[1] = x0.y; pa_[2] = x0.z; pa_[3] = x0.w; pa_[4] = x1.x; pa_[5] = x1.y; pa_[6] = x1.z; pa_[7] = x1.w;
            if (ACT == 3) { const f32x4 y0 = *(const f32x4*)(par + 1024), y1 = *(const f32x4*)(par + 1028);
                pb_[0] = y0.x; pb_[1] = y0.y; pb_[2] = y0.z; pb_[3] = y0.w; pb_[4] = y1.x; pb_[5] = y1.y; pb_[6] = y1.z; pb_[7] = y1.w; }
        }
#pragma unroll
        for (int ai = 0; ai < 2; ++ai)
#pragma unroll
            for (int m = 0; m < 4; ++m) {
                const int row = row0 + ai * HALF + m * 16;
                float o[8];
#pragma unroll
                for (int n = 0; n < 2; ++n)
#pragma unroll
                    for (int e = 0; e < 4; ++e) {
                        float v = acc[ai][bj][m][n][e];
                        if (ACT == 1) { const float t = __expf(2.f * v); v = 1.f - 2.f * __builtin_amdgcn_rcpf(t + 1.f); }
                        else if (ACT == 2) v = sigmoidf_(v);
                        else if (ACT == 3) v = sigmoidf_(v + pa_[n * 4 + e]) - pb_[n * 4 + e];
                        else v = sigmoidf_(v + pa_[n * 4 + e]);
                        o[n * 4 + e] = v;
                    }
                u32x4 w; w.x = pk2(o[0], o[1]); w.y = pk2(o[2], o[3]); w.z = pk2(o[4], o[5]); w.w = pk2(o[6], o[7]);
                *(u32x4*)(ob + (size_t)row * s.opitch + s.ocol0 + lc) = w;
            }
    }
}

template <bool PE>
__device__ __forceinline__ void epi_resid(unsigned char* ws, f32x4 (&acc)[2][2][4][2], const Epi& s, const Unit& u, const LAS float* rtab, int row0, int lrow0, int wc, int fq, float zs) {
    bf16_t* hb = (bf16_t*)s.o0; const bf16_t* hin = (const bf16_t*)(ws + (hb == (bf16_t*)(ws + O_HB1) ? O_HB0 : O_HB1));
    const int colb = u.pn * BM + wc * 32 + fq * 8;
    const float sc = s.scale * zs;
    u32x4 hn[2], pn_[2];
#pragma unroll
    for (int bj = 0; bj < 2; ++bj) {
        const size_t off = (size_t)row0 * D + colb + bj * HALF;
        hn[bj] = *(const u32x4*)(hin + off); pn_[bj] = (u32x4){0u, 0u, 0u, 0u};
        if (PE) pn_[bj] = *(const u32x4*)(s.pbuf + off);
    }
#pragma unroll
    for (int g = 0; g < 8; ++g) {
        const int ai = g >> 2, m = g & 3;
        const int row = row0 + ai * HALF + m * 16;
        u32x4 hc[2], pc[2];
#pragma unroll
        for (int bj = 0; bj < 2; ++bj) { hc[bj] = hn[bj]; pc[bj] = pn_[bj]; }
        if (g < 7) {
            const int rown = row0 + ((g + 1) >> 2) * HALF + ((g + 1) & 3) * 16;
#pragma unroll
            for (int bj = 0; bj < 2; ++bj) {
                const size_t off = (size_t)rown * D + colb + bj * HALF;
                hn[bj] = *(const u32x4*)(hin + off);
                if (PE) pn_[bj] = *(const u32x4*)(s.pbuf + off);
            }
        }
        float rs = 1.f; if (PE) rs = rtab[lrow0 + ai * HALF + m * 16];
        float sq = 0.f;
#pragma unroll
        for (int bj = 0; bj < 2; ++bj) {
            const size_t off = (size_t)row * D + colb + bj * HALF;
            const unsigned hw[4] = {hc[bj].x, hc[bj].y, hc[bj].z, hc[bj].w}, pw[4] = {pc[bj].x, pc[bj].y, pc[bj].z, pc[bj].w};
            unsigned ow[4];
#pragma unroll
            for (int n = 0; n < 2; ++n) {
                const f32x4 a = acc[ai][bj][m][n];
                f32x4 h = (f32x4){bflo(hw[2 * n]), bfhi(hw[2 * n]), bflo(hw[2 * n + 1]), bfhi(hw[2 * n + 1])};
                if (PE) {
                    h.x += zs * sigmoidf_(a.x * rs) * bflo(pw[2 * n]); h.y += zs * sigmoidf_(a.y * rs) * bfhi(pw[2 * n]);
                    h.z += zs * sigmoidf_(a.z * rs) * bflo(pw[2 * n + 1]); h.w += zs * sigmoidf_(a.w * rs) * bfhi(pw[2 * n + 1]);
                } else { h = h + a * sc; }
                ow[2 * n] = pk2(h.x, h.y); ow[2 * n + 1] = pk2(h.z, h.w);
                sq += (h.x * h.x + h.y * h.y) + (h.z * h.z + h.w * h.w);
            }
            *(u32x4*)(hb + off) = (u32x4){ow[0], ow[1], ow[2], ow[3]};
        }
        sq += __shfl_xor(sq, 16); sq += __shfl_xor(sq, 32);
        if (fq == 0) s.ssq_out[(size_t)row * 16 + u.pn * 4 + wc] = sq;
    }
}

__device__ __forceinline__ void epilogue(unsigned char* ws, float* outp, int ph, f32x4 (&acc)[2][2][4][2], const Unit& u, int wr, int wc, int fr, int fq, LAS unsigned char* lds, float zs) {
    Epi s; get_epi(ws, u.eph, u.si, s);
    const LAS float* rtab = (const LAS float*)(lds + LDS_CTL_OFF + 1024);
    if (s.ssq_in) {
        const int t = threadIdx.x;
        if (t < 256) ((LAS float*)(lds + LDS_CTL_OFF + 1024))[t] = rstd_of(s.ssq_in, u.pm * BM + t);
        __syncthreads();
    }
    const int lrow0 = wr * 64 + fr;
    const int row0 = u.pm * BM + wr * 64 + fr;
    if (s.epi == EPI_SWIGLU) {
        bf16_t* act = (bf16_t*)s.o0;
        const int col = u.pn * 128 + wc * 32 + fq * 8;
#pragma unroll
        for (int ai = 0; ai < 2; ++ai)
#pragma unroll
            for (int m = 0; m < 4; ++m) {
                const int row = row0 + ai * HALF + m * 16;
                const float rs = rtab[lrow0 + ai * HALF + m * 16];
                float o[8];
#pragma unroll
                for (int n = 0; n < 2; ++n)
#pragma unroll
                    for (int e = 0; e < 4; ++e) { const float g = acc[ai][0][m][n][e] * rs, up = acc[ai][1][m][n][e] * rs; o[n * 4 + e] = g * sigmoidf_(g) * up; }
                u32x4 w; w.x = pk2(o[0], o[1]); w.y = pk2(o[2], o[3]); w.z = pk2(o[4], o[5]); w.w = pk2(o[6], o[7]);
                if (u.pm == 64) {
                    unsigned long long* p8 = (unsigned long long*)(act + (size_t)row * FF + col);
                    __hip_atomic_store(p8, ((unsigned long long)w.y << 32) | w.x, __ATOMIC_RELAXED, __HIP_MEMORY_SCOPE_AGENT);
                    __hip_atomic_store(p8 + 1, ((unsigned long long)w.w << 32) | w.z, __ATOMIC_RELAXED, __HIP_MEMORY_SCOPE_AGENT);
                } else *(u32x4*)(act + (size_t)row * FF + col) = w;
            }
        if (u.pm == 64) {
            asm volatile("s_waitcnt vmcnt(0)" ::: "memory");
            __syncthreads();
            if (threadIdx.x == 0) __hip_atomic_fetch_add((unsigned*)(ws + O_CTL) + CW_DEP + ph * 64, 1u, __ATOMIC_RELAXED, __HIP_MEMORY_SCOPE_AGENT);
        }
    } else if (s.epi == EPI_RESID || s.epi == EPI_PE) {
        if (s.epi == EPI_PE) epi_resid<true>(ws, acc, s, u, rtab, row0, lrow0, wc, fq, zs);
        else epi_resid<false>(ws, acc, s, u, rtab, row0, lrow0, wc, fq, zs);
        if (u.eph != ph && (u.wait == 0 || (u.wait == 1 && ph == PH_F2I1))) {
            asm volatile("s_waitcnt vmcnt(0)" ::: "memory");
            __syncthreads();
            if (threadIdx.x == 0) {
                __builtin_amdgcn_fence(__ATOMIC_RELEASE, "agent");
                asm volatile("s_waitcnt vmcnt(0)" ::: "memory");
                __hip_atomic_fetch_add((unsigned*)(ws + O_CTL) + CW_DEP + ((u.wait == 1 ? 20 : 32) + ph) * 64, 1u, __ATOMIC_RELAXED, __HIP_MEMORY_SCOPE_AGENT);
            }
        }
    } else if (s.epi == EPI_BF16) {
        bf16_t* ob = (bf16_t*)s.o0;
        if (s.act == 0) {
#pragma unroll
            for (int ai = 0; ai < 2; ++ai)
#pragma unroll
                for (int m = 0; m < 4; ++m) {
                    const int row = row0 + ai * HALF + m * 16;
                    float rs = 1.f; if (s.ssq_in) rs = rtab[lrow0 + ai * HALF + m * 16];
#pragma unroll
                    for (int bj = 0; bj < 2; ++bj) {
                        const int lc = u.pn * BM + bj * HALF + wc * 32 + fq * 8;
                        const f32x4 v0 = acc[ai][bj][m][0] * rs, v1 = acc[ai][bj][m][1] * rs;
                        if (lc < s.ncols) {
                            u32x4 w; w.x = pk2(v0.x, v0.y); w.y = pk2(v0.z, v0.w); w.z = pk2(v1.x, v1.y); w.w = pk2(v1.z, v1.w);
                            *(u32x4*)(ob + (size_t)row * s.opitch + s.ocol0 + lc) = w;
                        }
                    }
                }
        } else if (s.act == 1) epi_act<1>(ws, acc, s, u, ob, row0, wc, fq);
        else if (s.act == 2) epi_act<2>(ws, acc, s, u, ob, row0, wc, fq);
        else if (s.act == 3) epi_act<3>(ws, acc, s, u, ob, row0, wc, fq);
        else epi_act<4>(ws, acc, s, u, ob, row0, wc, fq);
    } else {
        bf16_t* kb = (bf16_t*)(ws + O_KB); bf16_t* vt = (bf16_t*)(ws + O_VT);
#pragma unroll
        for (int ai = 0; ai < 2; ++ai)
#pragma unroll
            for (int m = 0; m < 4; ++m) {
                const int row = row0 + ai * HALF + m * 16;
                const float rs = rtab[lrow0 + ai * HALF + m * 16];
                const bool isP = row < MP; const int b = row >> 12, t = row & 4095;
                float* fo = nullptr;
                if (isP) { if (t >= 2048) fo = outp + O_KVP + ((size_t)(b * 2048 + (t - 2048)) * 512) + u.pn * 256; }
                else fo = outp + O_KVS + (size_t)(row - MP) * 512 + u.pn * 256;
#pragma unroll
                for (int bj = 0; bj < 2; ++bj) {
                    const int c = bj * HALF + wc * 32 + fq * 8;
                    const f32x4 v0 = acc[ai][bj][m][0] * rs, v1 = acc[ai][bj][m][1] * rs;
                    if (fo) { *(f32x4*)(fo + c) = v0; *(f32x4*)(fo + c + 4) = v1; }
                    if (isP) {
                        u32x4 w; w.x = pk2(v0.x, v0.y); w.y = pk2(v0.z, v0.w); w.z = pk2(v1.x, v1.y); w.w = pk2(v1.z, v1.w);
                        *(u32x4*)((u.pn == 0 ? kb : (bf16_t*)(ws + O_VB)) + (size_t)row * 256 + c) = w;
                    }
                }
            }
    }
}

__device__ __forceinline__ void gemm_phase(unsigned char* ws, float* outp, LAS unsigned char* lds, int ph, int dry, int pass2) {
    const int tid = tid_fresh(), wid = __builtin_amdgcn_readfirstlane(tid >> 6), lane = tid & 63, wr = wid >> 2, wc = wid & 3, fr = lane & 15, fq = lane >> 4;
    const int G = gdim_fresh(), cidx = bid_fresh();
    int R0, C0; stage_rc(tid * 16, R0, C0);
    const unsigned ldsw = (unsigned)wid * 1024u;
    const int aoff = lds_byte(wr * 64 + fr, fq * 8), boff = lds_byte(wc * 32 + fr, fq * 8);
    const size_t kstep = (size_t)(BK * 2);
#define PG8_SA(b, h) (((b) * 2 + (h)) * HTB)
#define PG8_SB(b, h) ((4 + (b) * 2 + (h)) * HTB)
#define PG8_STAGE(bufoff, gbase, voff, p64) do { \
        __builtin_amdgcn_global_load_lds((const unsigned*)((const char*)(gbase) + (voff)), (LAS unsigned*)(lds + (bufoff) + ldsw), 16, 0, 0); \
        __builtin_amdgcn_global_load_lds((const unsigned*)((const char*)(gbase) + (voff) + (p64)), (LAS unsigned*)(lds + (bufoff) + ldsw + 8192), 16, 0, 0); } while (0)
#define PG8_LDA(dst, b, h) do { _Pragma("unroll") for (int m = 0; m < 4; ++m) _Pragma("unroll") for (int k = 0; k < 2; ++k) dst[m][k] = *(const LAS bf16x8*)(lds + PG8_SA(b, h) + aoff + m * 2048 + k * 1024); } while (0)
#define PG8_LDB(dst, b, h) do { _Pragma("unroll") for (int n = 0; n < 2; ++n) _Pragma("unroll") for (int k = 0; k < 2; ++k) dst[n][k] = *(const LAS bf16x8*)(lds + PG8_SB(b, h) + boff + n * 2048 + k * 1024); } while (0)
#define PG8_MMA(ai, bj, At, Bt) do { __builtin_amdgcn_s_setprio(1); _Pragma("unroll") for (int m = 0; m < 4; ++m) _Pragma("unroll") for (int n = 0; n < 2; ++n) _Pragma("unroll") for (int k = 0; k < 2; ++k) \
        acc[ai][bj][m][n] = __builtin_amdgcn_mfma_f32_16x16x32_bf16(Bt[n][k], At[m][k], acc[ai][bj][m][n], 0, 0, 0); __builtin_amdgcn_s_setprio(0); } while (0)
#define PG8_WAIT_V(n) asm volatile("s_waitcnt vmcnt(" #n ")" ::: "memory")
#define PG8_WAIT_L(n) asm volatile("s_waitcnt lgkmcnt(" #n ")" ::: "memory")
#define PG8_BAR __builtin_amdgcn_s_barrier()
#define PG8_SCHED __builtin_amdgcn_sched_barrier(0)
    Unit cur, nxt; int ui = 0;
    if (!next_unit(ws, ph, 0, G, cidx, cur, pass2)) return;
    f32x4 acc[2][2][4][2];
#pragma unroll
    for (int a = 0; a < 2; ++a)
#pragma unroll
        for (int b = 0; b < 2; ++b)
#pragma unroll
            for (int m = 0; m < 4; ++m)
#pragma unroll
                for (int n = 0; n < 2; ++n) acc[a][b][m][n] = (f32x4){0.f, 0.f, 0.f, 0.f};
    bf16x8 At[4][2], B0[2][2], B1[2][2];
    const char* cA = cur.A + (size_t)cur.pm * 256 * cur.pitchA; const char* cB = cur.B + (size_t)cur.pn * 256 * cur.pitchB;
    unsigned vA = (unsigned)(R0 * cur.pitchA + C0 * 2), vB = (unsigned)(R0 * cur.pitchB + C0 * 2);
    unsigned hA = (unsigned)HALF * cur.pitchA, hB = (unsigned)HALF * cur.pitchB; unsigned pA = 64u * cur.pitchA, pB = 64u * cur.pitchB;
    PG8_STAGE(PG8_SB(0, 0), cB, vB, pB); PG8_STAGE(PG8_SB(0, 1), cB + hB, vB, pB); PG8_STAGE(PG8_SA(0, 0), cA, vA, pA); PG8_STAGE(PG8_SA(0, 1), cA + hA, vA, pA);
    if (wr == 1) PG8_BAR;
    PG8_WAIT_V(2); PG8_BAR;
    PG8_STAGE(PG8_SB(1, 0), cB + kstep, vB, pB); PG8_STAGE(PG8_SA(1, 0), cA + kstep, vA, pA); PG8_STAGE(PG8_SB(1, 1), cB + hB + kstep, vB, pB);
    PG8_WAIT_V(6); PG8_BAR;
    for (;;) {
        const bool has_next = next_unit(ws, ph, ui + 1, G, cidx, nxt, pass2);
        const char* nA = has_next ? nxt.A + (size_t)nxt.pm * 256 * nxt.pitchA : cA; const char* nB = has_next ? nxt.B + (size_t)nxt.pn * 256 * nxt.pitchB : cB;
        const int npA = has_next ? nxt.pitchA : cur.pitchA, npB = has_next ? nxt.pitchB : cur.pitchB;
        const unsigned nvA = (unsigned)(R0 * npA + C0 * 2), nvB = (unsigned)(R0 * npB + C0 * 2);
        const unsigned nhA = (unsigned)HALF * npA, nhB = (unsigned)HALF * npB; const unsigned nppA = 64u * npA, nppB = 64u * npB;
        const int nt = cur.nt;
        for (int t = 0; t < nt; t += 2) {
            const bool last = (t == nt - 2);
            if (last && has_next && nxt.wait) {
                if (wid == 0) {
                    unsigned* dep = (unsigned*)(ws + O_CTL) + CW_DEP + (nxt.wait == 2 ? 32 + ph : (nxt.wait == 4 ? 20 + ph : ph)) * 64; unsigned sp = 0; const unsigned need = (nxt.wait == 1) ? 22u : 4u;
                    while ((unsigned)__builtin_amdgcn_readfirstlane(__hip_atomic_load(dep, __ATOMIC_RELAXED, __HIP_MEMORY_SCOPE_AGENT)) < need) { __builtin_amdgcn_s_sleep(2); if (++sp > (1u << 22)) break; }
                    __builtin_amdgcn_fence(__ATOMIC_ACQUIRE, "agent");
                    asm volatile("s_waitcnt vmcnt(0)" ::: "memory");
                }
                asm volatile("" ::: "memory"); PG8_BAR; asm volatile("" ::: "memory");
            }
            const char* a1 = cA + (size_t)(t + 1) * kstep;
            const char* a2 = last ? nA : cA + (size_t)(t + 2) * kstep; const char* b2 = last ? nB : cB + (size_t)(t + 2) * kstep;
            const char* a3 = a2 + kstep; const char* b3 = b2 + kstep;
            const unsigned vA2 = last ? nvA : vA, vB2 = last ? nvB : vB, pA2 = last ? nppA : pA, pB2 = last ? nppB : pB;
            const unsigned hA2 = last ? nhA : hA, hB2 = last ? nhB : hB;
            PG8_LDB(B0, 0, 0); PG8_LDB(B1, 0, 1); PG8_SCHED; PG8_LDA(At, 0, 0); PG8_STAGE(PG8_SA(1, 1), a1 + hA, vA, pA);
            PG8_WAIT_V(8); PG8_WAIT_L(0); PG8_BAR; PG8_MMA(0, 0, At, B0); PG8_MMA(0, 1, At, B1); PG8_BAR; PG8_SCHED;
            PG8_LDA(At, 0, 1); PG8_STAGE(PG8_SB(0, 0), b2, vB2, pB2); PG8_STAGE(PG8_SB(0, 1), b2 + hB2, vB2, pB2); PG8_STAGE(PG8_SA(0, 0), a2, vA2, pA2);
            PG8_WAIT_V(8); PG8_WAIT_L(0); PG8_BAR; PG8_MMA(1, 0, At, B0); PG8_MMA(1, 1, At, B1); PG8_BAR; PG8_SCHED;
            PG8_LDB(B0, 1, 0); PG8_LDB(B1, 1, 1); PG8_SCHED; PG8_LDA(At, 1, 0); PG8_STAGE(PG8_SA(0, 1), a2 + hA2, vA2, pA2);
            PG8_WAIT_V(8); PG8_WAIT_L(0); PG8_BAR; PG8_MMA(0, 0, At, B0); PG8_MMA(0, 1, At, B1); PG8_BAR; PG8_SCHED;
            PG8_LDA(At, 1, 1); PG8_STAGE(PG8_SB(1, 0), b3, vB2, pB2); PG8_STAGE(PG8_SB(1, 1), b3 + hB2, vB2, pB2); PG8_STAGE(PG8_SA(1, 0), a3, vA2, pA2);
            PG8_WAIT_V(8); PG8_WAIT_L(0); PG8_BAR; PG8_MMA(1, 0, At, B0); PG8_MMA(1, 1, At, B1); PG8_BAR; PG8_SCHED;
        }
        if (wr == 0) PG8_BAR;
        if (dry != 1) epilogue(ws, outp, ph, acc, cur, wr, wc, fr, fq, lds, dry == 2 ? 0.f : 1.f);
        if (!has_next) break;
#pragma unroll
        for (int a = 0; a < 2; ++a)
#pragma unroll
            for (int b = 0; b < 2; ++b)
#pragma unroll
                for (int m = 0; m < 4; ++m)
#pragma unroll
                    for (int n = 0; n < 2; ++n) acc[a][b][m][n] = (f32x4){0.f, 0.f, 0.f, 0.f};
        cur = nxt; cA = nA; cB = nB; vA = nvA; vB = nvB; hA = nhA; hB = nhB; pA = nppA; pB = nppB; ++ui;
        if (wr == 1) PG8_BAR;
    }
    PG8_WAIT_V(0);
    PG8_BAR;
#undef PG8_SA
#undef PG8_SB
#undef PG8_STAGE
#undef PG8_LDA
#undef PG8_LDB
#undef PG8_MMA
#undef PG8_WAIT_V
#undef PG8_WAIT_L
#undef PG8_BAR
#undef PG8_SCHED
}

struct Job { int src, soff, Ksrc, Nsrc, Kdst, Ndst, gidx, goff, map; size_t dst; float scal; };
__device__ __forceinline__ int pinv32(int l) { return 16 * ((l >> 2) & 1) + 4 * (l >> 3) + (l & 3); }
__device__ __forceinline__ Job get_job(int j) {
    Job b; b.gidx = -1; b.goff = 0; b.scal = 1.f; b.map = 0; b.soff = 0;
    if (j < 4) { const int l = j & 1, f2 = j >> 1; b.src = f2 ? 10 : 8; b.soff = l * 1024 * 5632; b.Ksrc = 1024; b.Nsrc = 5632; b.Kdst = 1024; b.Ndst = 5632; b.gidx = 7; b.goff = l * 4096 + (f2 ? 2048 : 0); b.map = 2;
                 b.dst = (f2 ? W_F2I : W_F1I) + (size_t)l * 5632 * 1024 * 2; return b; }
    if (j < 8) { const int l = j & 1, f2 = (j - 4) >> 1; b.src = f2 ? 11 : 9; b.soff = l * 2816 * 1024; b.Ksrc = 2816; b.Nsrc = 1024; b.Kdst = 2816; b.Ndst = 1024; b.map = 1;
                 b.dst = (f2 ? W_F2O : W_F1O) + (size_t)l * 1024 * 2816 * 2; return b; }
    if (j < 10) { const int l = j - 8; b.src = 13; b.soff = l * 1024 * 1024; b.Ksrc = 1024; b.Nsrc = 1024; b.Kdst = 1024; b.Ndst = 1024; b.gidx = 7; b.goff = l * 4096 + 3072; b.map = 1; b.dst = W_PEG + (size_t)l * 1024 * 1024 * 2; return b; }
    if (j < 12) { const int l = j - 10; b.src = 12; b.soff = l * 256 * 1024; b.Ksrc = 256; b.Nsrc = 1024; b.Kdst = 256; b.Ndst = 1024; b.map = 1; b.dst = W_PEP + (size_t)l * 1024 * 256 * 2; return b; }
    if (j < 15) { const int q = j - 12; b.src = 15; b.soff = q * 1024 * 1024; b.Ksrc = 1024; b.Nsrc = 1024; b.Kdst = 1024; b.Ndst = 1024; b.map = 1; b.dst = W_RKV + (size_t)q * 1024 * 1024 * 2; return b; }
    if (j == 15) { b.src = 16; b.Ksrc = 1024; b.Nsrc = 1024; b.Kdst = 1024; b.Ndst = 1024; b.map = 1; b.dst = W_RWO; return b; }
    if (j == 16) { b.src = 18; b.Ksrc = 1024; b.Nsrc = 64; b.Kdst = 1024; b.Ndst = 256; b.map = 1; b.dst = W_L1; return b; }
    if (j == 17) { b.src = 21; b.Ksrc = 1024; b.Nsrc = 64; b.Kdst = 1024; b.Ndst = 256; b.map = 1; b.dst = W_L1 + (size_t)256 * 1024 * 2; return b; }
    if (j == 18) { b.src = 23; b.Ksrc = 1024; b.Nsrc = 160; b.Kdst = 1024; b.Ndst = 256; b.map = 1; b.dst = W_L1 + (size_t)512 * 1024 * 2; return b; }
    if (j == 19) { b.src = 19; b.Ksrc = 64; b.Nsrc = 1024; b.Kdst = 128; b.Ndst = 1024; b.map = 1; b.dst = W_L2W; return b; }
    if (j == 20) { b.src = 22; b.Ksrc = 64; b.Nsrc = 1024; b.Kdst = 128; b.Ndst = 1024; b.map = 1; b.dst = W_L2A; return b; }
    if (j == 21) { b.src = 24; b.Ksrc = 160; b.Nsrc = 1024; b.Kdst = 256; b.Ndst = 1024; b.map = 1; b.dst = W_L2G; return b; }
    if (j == 22) { b.src = 30; b.Ksrc = 1024; b.Nsrc = 3072; b.Kdst = 1024; b.Ndst = 3072; b.map = 1; b.gidx = 7; b.goff = 4096 + 1024; b.scal = 0.125f * 1.4426950408889634f; b.dst = W_Q; return b; }
    if (j == 23) { b.src = 31; b.Ksrc = 1024; b.Nsrc = 1024; b.Kdst = 1024; b.Ndst = 1024; b.map = 1; b.dst = W_AO; return b; }
    b.src = 33; b.Ksrc = 1024; b.Nsrc = 512; b.Kdst = 1024; b.Ndst = 512; b.gidx = 32; b.map = 1; b.dst = W_KV; return b;
}
constexpr int NJOBS = 25;
__device__ __forceinline__ const float* sel_in(KPtr P, int i) { return P->in[i]; }
__device__ __forceinline__ void prologue_phase(KPtr P, LAS unsigned char* lds) {
    const int tid = tid_fresh(), lane = tid & 63, wave = __builtin_amdgcn_readfirstlane(tid >> 6);
    const int bid = bid_fresh(), gdim = gdim_fresh();
    const int gw = bid * 8 + wave, NGW = gdim * 8;
    LAS unsigned char* scr = lds + wave * 9216;
    int base = 0;
    for (int j = 0; j < NJOBS; ++j) {
        const Job jb = get_job(j);
        const int nkb = jb.Kdst / 64, nnb = jb.Ndst / 64, nit = nkb * nnb;
        const float* W = sel_in(P, jb.src) + jb.soff; const float* gv = jb.gidx >= 0 ? sel_in(P, jb.gidx) + jb.goff : nullptr;
        bf16_t* dst = (bf16_t*)(P->ws + jb.dst);
        int first = (gw - (base % NGW) + NGW) % NGW;
        for (int it = first; it < nit; it += NGW) {
            const int kb = it / nnb, nb = it % nnb, k0 = kb * 64, n0 = nb * 64;
            const int nn4 = (lane & 15) * 4, n = n0 + nn4;
            f32x4 v[16];
#pragma unroll
            for (int i = 0; i < 16; ++i) {
                const int k = k0 + 4 * i + (lane >> 4);
                v[i] = (f32x4){0.f, 0.f, 0.f, 0.f};
                if (k < jb.Ksrc && n < jb.Nsrc) v[i] = *(const f32x4*)(W + (size_t)k * jb.Nsrc + n);
            }
#pragma unroll
            for (int i = 0; i < 16; ++i) {
                const int kk = 4 * i + (lane >> 4), k = k0 + kk;
                float sc = jb.scal; if (gv && k < jb.Ksrc) sc *= gv[k];
                const f32x4 x = v[i] * sc;
                LAS bf16_t* sp = (LAS bf16_t*)(scr + nn4 * 144 + kk * 2);
                sp[0] = (bf16_t)(pk2(x.x, 0.f) & 0xffffu); sp[72] = (bf16_t)(pk2(x.y, 0.f) & 0xffffu); sp[144] = (bf16_t)(pk2(x.z, 0.f) & 0xffffu); sp[216] = (bf16_t)(pk2(x.w, 0.f) & 0xffffu);
            }
            asm volatile("s_waitcnt lgkmcnt(0)" ::: "memory");
            int rbase;
            if (jb.map == 2) { const int isUp = n0 >= 2816 ? 1 : 0, j0 = n0 - isUp * 2816; rbase = 256 * (j0 >> 7) + 128 * isUp + (j0 & 127); }
            else rbase = n0;
            const int c = lane & 7;
#pragma unroll
            for (int q = 0; q < 8; ++q) {
                const int nn = (lane >> 3) + 8 * q;
                const u32x4 o = *(const LAS u32x4*)(scr + nn * 144 + c * 16);
                const int drow = rbase + (jb.map ? ((nn & 32) + pinv32(nn & 31)) : nn);
                *(u32x4*)(dst + (size_t)drow * jb.Kdst + k0 + 8 * c) = o;
            }
            asm volatile("s_waitcnt lgkmcnt(0)" ::: "memory");
        }
        base += nit;
    }
    if (bid == 0) { float* par = (float*)(P->ws + O_PAR); for (int e = tid; e < 1024; e += NTHREADS) { const float w0v = P->in[17][e]; par[e] = w0v; par[1024 + e] = sigmoidf_(w0v); par[2048 + e] = P->in[20][e]; } }
    bf16_t* hb0 = (bf16_t*)(P->ws + O_HB0); float* ssq0 = (float*)(P->ws + O_SSQ0);
    for (int row = gw; row < M; row += NGW) {
        const float* src = row < MP ? P->in[0] + (size_t)row * D : P->in[1] + (size_t)(row - MP) * D;
        float sq = 0.f;
#pragma unroll
        for (int j = 0; j < 2; ++j) {
            const int c = 8 * lane + 512 * j;
            const F8 v = load8f(src + c);
            *(u32x4*)(hb0 + (size_t)row * D + c) = pack8(v);
#pragma unroll
            for (int q = 0; q < 8; ++q) sq += v.v[q] * v.v[q];
        }
        sq = wave_sum(sq);
        if (lane < 16) ssq0[(size_t)row * 16 + lane] = (lane == 0) ? sq : 0.f;
    }
    bf16_t* pb = (bf16_t*)(P->ws + O_PB);
    const size_t nchunk = (size_t)2 * M * 32;
    for (size_t ch = (size_t)bid * NTHREADS + tid; ch < nchunk; ch += (size_t)gdim * NTHREADS) {
        const size_t e = ch * 8; const int l = (int)(e / ((size_t)M * 256)); const size_t r = e - (size_t)l * M * 256; const int row = (int)(r >> 8), col = (int)(r & 255);
        const float* src = row < MP ? P->in[5] + ((size_t)l * MP + row) * 256 + col : P->in[6] + ((size_t)l * MS + (row - MP)) * 256 + col;
        *(u32x4*)(pb + e) = pack8(load8f(src));
    }
}

__device__ __forceinline__ void mix_pass(KPtr P) {
    const int tid = tid_fresh(), lane = tid & 63, wave = tid >> 6; const int gw = bid_fresh() * 8 + wave, NGW = gdim_fresh() * 8;
    const float* ssq = (const float*)(P->ws + O_SSQ1); const bf16_t* H = (const bf16_t*)(P->ws + O_HB1); const float* g1 = P->in[7] + 1024; const float* mix = P->in[14];
#pragma unroll 1
    for (int j = 0; j < 2; ++j) {
        const int c = 8 * lane + 512 * j;
        const F8 g = load8f(g1 + c);
        F8 mq[6];
#pragma unroll
        for (int a6 = 0; a6 < 6; ++a6) mq[a6] = load8f(mix + a6 * 1024 + c);
        for (int row = gw; row < M; row += NGW) {
            int b, t, T; const bool isS = row >= MP;
            if (!isS) { b = row >> 12; t = row & 4095; T = TP; } else { const int jj = row - MP; b = jj >> 3; t = jj & 7; T = TS; }
            const float rs = rstd_of(ssq, row); const float rsp = t > 0 ? rstd_of(ssq, row - 1) : 0.f;
            const F8 hc = unpack8(*(const u32x4*)(H + (size_t)row * D + c));
            F8 xn, xx;
#pragma unroll
            for (int q = 0; q < 8; ++q) xn.v[q] = hc.v[q] * rs * g.v[q];
            if (t > 0) { const F8 hp = unpack8(*(const u32x4*)(H + (size_t)(row - 1) * D + c));
#pragma unroll
                for (int q = 0; q < 8; ++q) xx.v[q] = hp.v[q] * rsp * g.v[q] - xn.v[q]; }
            else if (isS) { const F8 sp = load8f(P->in[3] + (size_t)b * D + c);
#pragma unroll
                for (int q = 0; q < 8; ++q) xx.v[q] = sp.v[q] - xn.v[q]; }
            else {
#pragma unroll
                for (int q = 0; q < 8; ++q) xx.v[q] = -xn.v[q]; }
#pragma unroll
            for (int a6 = 0; a6 < 6; ++a6) {
                F8 v;
#pragma unroll
                for (int q = 0; q < 8; ++q) v.v[q] = xn.v[q] + xx.v[q] * mq[a6].v[q];
                *(u32x4*)((bf16_t*)(P->ws + O_R4 + (size_t)a6 * SL) + (size_t)row * D + c) = pack8(v);
            }
            if (t == T - 1) { float* so = P->out + (isS ? O_SHS : O_SHP) + (size_t)b * D + c;
                *(f32x4*)so = (f32x4){xn.v[0], xn.v[1], xn.v[2], xn.v[3]}; *(f32x4*)(so + 4) = (f32x4){xn.v[4], xn.v[5], xn.v[6], xn.v[7]}; }
        }
    }
}
__device__ __forceinline__ void post_pass(KPtr P) {
    const int tid = tid_fresh(), lane = tid & 63, wave = tid >> 6; const int gw = bid_fresh() * 8 + wave, NGW = gdim_fresh() * 8;
    const bf16_t* Y = (const bf16_t*)(P->ws + O_Y); const bf16_t* BON = (const bf16_t*)(P->ws + O_BON); const bf16_t* GG = (const bf16_t*)(P->ws + O_GG);
    bf16_t* YG = (bf16_t*)(P->ws + O_YG); const float* lw = P->in[28]; const float* lb = P->in[29];
    for (int row = gw; row < M; row += NGW) {
#pragma unroll
        for (int j = 0; j < 2; ++j) {
            const int c = 8 * lane + 512 * j; const size_t off = (size_t)row * D + c;
            const F8 y = unpack8(*(const u32x4*)(Y + off)), bo = unpack8(*(const u32x4*)(BON + off)), gg = unpack8(*(const u32x4*)(GG + off));
            const F8 w8 = load8f(lw + c), b8 = load8f(lb + c);
            float sm = 0.f;
#pragma unroll
            for (int q = 0; q < 8; ++q) sm += y.v[q];
            const float mu = row_sum8(sm) * (1.f / 64.f);
            float sv = 0.f; F8 d;
#pragma unroll
            for (int q = 0; q < 8; ++q) { d.v[q] = y.v[q] - mu; sv += d.v[q] * d.v[q]; }
            const float rs = __builtin_amdgcn_rsqf(row_sum8(sv) * (1.f / 64.f) + 64e-5f);
            F8 o;
#pragma unroll
            for (int q = 0; q < 8; ++q) o.v[q] = (d.v[q] * rs * w8.v[q] + b8.v[q] + bo.v[q]) * gg.v[q];
            *(u32x4*)(YG + off) = pack8(o);
        }
    }
}
__device__ __forceinline__ void final_pass(KPtr P) {
    const int tid = tid_fresh(), lane = tid & 63, wave = tid >> 6; const int gw = bid_fresh() * 8 + wave, NGW = gdim_fresh() * 8;
    const float* ssq = (const float*)(P->ws + O_SSQ0); const float* fn = P->in[35];
    for (int row = gw; row < M; row += NGW) {
        const float rs = rstd_of(ssq, row);
#pragma unroll
        for (int j = 0; j < 2; ++j) {
            const int c = 8 * lane + 512 * j; float* p = P->out + (size_t)row * D + c;
            const F8 h = unpack8(*(const u32x4*)((const bf16_t*)(P->ws + O_HB0) + (size_t)row * D + c)), f = load8f(fn + c);
            *(f32x4*)p = (f32x4){h.v[0] * rs * f.v[0], h.v[1] * rs * f.v[1], h.v[2] * rs * f.v[2], h.v[3] * rs * f.v[3]};
            *(f32x4*)(p + 4) = (f32x4){h.v[4] * rs * f.v[4], h.v[5] * rs * f.v[5], h.v[6] * rs * f.v[6], h.v[7] * rs * f.v[7]};
        }
    }
}

constexpr int TC = 32;
constexpr int SC_BUF = 5 * TC * 256 + TC * 64 + TC * 4;
constexpr int SC_OUT = 2 * SC_BUF;
constexpr int SC_OBUF = 2 * TC * 16 * 4;
__device__ __forceinline__ float wave_sum_fast(float x) {
    x = row_sum16(x);
    const float a = __builtin_bit_cast(float, __builtin_amdgcn_readlane(__builtin_bit_cast(int, x), 0)), b = __builtin_bit_cast(float, __builtin_amdgcn_readlane(__builtin_bit_cast(int, x), 16));
    const float c = __builtin_bit_cast(float, __builtin_amdgcn_readlane(__builtin_bit_cast(int, x), 32)), d = __builtin_bit_cast(float, __builtin_amdgcn_readlane(__builtin_bit_cast(int, x), 48));
    return (a + b) + (c + d);
}
struct PrepRegs { unsigned short lr[TC / 4], lk[TC / 4], lw[TC / 4], la[TC / 4], lv[TC / 4]; };
__device__ __forceinline__ void scan_prep_load(KPtr P, PrepRegs& g, int rowbase, int t0, int T, int h, int qi, int pw, int lane) {
    const bf16_t* RKV = (const bf16_t*)(P->ws + O_RKVB); const bf16_t* WL = (const bf16_t*)(P->ws + O_WL); const bf16_t* AL = (const bf16_t*)(P->ws + O_AL);
    const int ch = h * 64 + lane;
    constexpr int NS = TC / 4;
#pragma unroll
    for (int q = 0; q < NS; ++q) {
        int t = t0 + pw * NS + q; t = t < T ? t : T - 1;
        const size_t row = (size_t)(rowbase + t);
        g.lr[q] = RKV[row * 3072 + ch]; g.lk[q] = RKV[row * 3072 + 1024 + ch]; g.lw[q] = WL[row * 1024 + ch]; g.la[q] = AL[row * 1024 + ch];
        g.lv[q] = RKV[row * 3072 + 2048 + h * 64 + qi * 16 + (lane & 15)];
    }
}
__device__ __forceinline__ void scan_prep_compute(KPtr P, const PrepRegs& g, LAS unsigned char* buf, int h, int pw, int lane) {
    const int ch = h * 64 + lane;
    const float sw0 = ((const float*)(P->ws + O_PAR))[1024 + ch], kkw = P->in[25][ch], kaw = P->in[26][ch], rkw = P->in[27][ch];
    LAS float* fb = (LAS float*)buf;
    constexpr int NS = TC / 4;
#pragma unroll
    for (int q = 0; q < NS; ++q) {
        const int tau = pw * NS + q;
        const float r = bf2f(g.lr[q]), k = bf2f(g.lk[q]), wl = bf2f(g.lw[q]), al = bf2f(g.la[q]);
        const float dec = __builtin_amdgcn_exp2f(-0.8750387f * (sw0 + wl));
        const float a = al;
        const float kkv = k * kkw;
        const float n2 = wave_sum_fast(kkv * kkv);
        const float kkn = kkv * __builtin_amdgcn_rsqf(fmaxf(n2, 1e-24f));
        const float kp = k * (1.f + (a - 1.f) * kaw);
        const float bon = wave_sum_fast(r * kp * rkw);
        fb[0 * TC * 64 + tau * 64 + lane] = -kkn;
        fb[1 * TC * 64 + tau * 64 + lane] = dec;
        fb[2 * TC * 64 + tau * 64 + lane] = kkn * a;
        fb[3 * TC * 64 + tau * 64 + lane] = kp;
        fb[4 * TC * 64 + tau * 64 + lane] = r;
        if (lane < 16) fb[5 * TC * 64 + tau * 16 + lane] = bf2f(g.lv[q]);
        if (lane == 0) fb[5 * TC * 64 + TC * 16 + tau] = bon;
    }
}
__device__ __forceinline__ void scan_flush(KPtr P, const LAS float* ob, int rowbase, int t0, int T, int h, int qi, int p) {
    const int tau = p >> 3, pr = (p & 7) * 2; const int t = t0 + tau;
    if (t < T) {
        const size_t off = (size_t)(rowbase + t) * D + h * 64 + qi * 16 + pr;
        *(unsigned*)((bf16_t*)(P->ws + O_Y) + off) = pk2(ob[tau * 16 + pr], ob[tau * 16 + pr + 1]);
        *(unsigned*)((bf16_t*)(P->ws + O_BON) + off) = pk2(ob[TC * 16 + tau * 16 + pr], ob[TC * 16 + tau * 16 + pr + 1]);
    }
}
typedef short bf16x4 __attribute__((ext_vector_type(4)));
#ifndef NPREP_
#define NPREP_ 7
#endif
constexpr int NPREP = NPREP_;
constexpr int SL_AOP = 0, SL_RT = 2048, SL_UH = 4096, SL_Y0 = 5120, SL_MRB = 6144, SL_BTT = 6656, SL_ZV = 8704, SL_GC = 10752, SL_VTB = 11008, SL_BON = 11520, SL_RN = 11584, SLOT_B = 11776;
constexpr int SC_ATT = 0, SC_KTT = 2048, SC_LAB = 4096, SC_TM = 5120, SC_TM2 = SC_LAB  , SCR_B = 5632;
constexpr int SC_X1 = -SLOT_B + SL_AOP, SC_X2 = -SLOT_B + SL_ZV;
constexpr int CK_FLAGS = NPREP * (SLOT_B + SCR_B);
static_assert(CK_FLAGS + 64 <= LDS_CTL_OFF, "chunked scan LDS");
typedef unsigned short us2 __attribute__((ext_vector_type(2)));
struct CkRegs { us2 rk[16], wa[16], vv[8]; };
__device__ __forceinline__ void ck_load(KPtr P, CkRegs& g, int row0, int h, int qi, int lane) {
    const bf16_t* rk = (const bf16_t*)(P->ws + O_RKVB) + (size_t)row0 * 3072 + h * 64;
    const bf16_t* wl = (const bf16_t*)(P->ws + O_WL) + (size_t)row0 * 1024 + h * 64;
    const bf16_t* al = (const bf16_t*)(P->ws + O_AL) + (size_t)row0 * 1024 + h * 64;
    const bf16_t* vq = rk + 2048 + qi * 16;
    const int l15 = lane & 15;
#pragma unroll
    for (int t = 0; t < 16; ++t) {
        g.rk[t].x = rk[t * 3072 + lane]; g.rk[t].y = rk[t * 3072 + 1024 + lane]; g.wa[t].x = wl[t * 1024 + lane]; g.wa[t].y = al[t * 1024 + lane];
        const unsigned short vv_ = vq[t * 3072 + l15];
        if (t & 1) g.vv[t >> 1].y = vv_; else g.vv[t >> 1].x = vv_;
    }
}
__device__ __forceinline__ unsigned short bf1(float x) { return (unsigned short)(pk2(x, 0.f) & 0xffffu); }
__device__ __forceinline__ bf16x4 pack4(f32x4 v) { u32x2 w; w.x = pk2(v.x, v.y); w.y = pk2(v.z, v.w); return __builtin_bit_cast(bf16x4, w); }
#define MFMA16(a, b, c) __builtin_amdgcn_mfma_f32_16x16x16bf16_1k(a, b, c, 0, 0, 0)
#define MFMA32(a, b, c) __builtin_amdgcn_mfma_f32_16x16x32_bf16(a, b, c, 0, 0, 0)
#define LDSW() asm volatile("s_waitcnt lgkmcnt(0)" ::: "memory")
__device__ __forceinline__ bf16x4 ck_tr(const LAS unsigned char* a) { return __builtin_amdgcn_ds_read_tr16_b64_v4i16((LAS bf16x4*)a); }
__device__ __forceinline__ bf16x8 ck_tr8(const LAS unsigned char* a, int second) { const bf16x4 lo = ck_tr(a), hi = ck_tr(a + second); return (bf16x8){lo.x, lo.y, lo.z, lo.w, hi.x, hi.y, hi.z, hi.w}; }
struct CkPar { float sw0, kkw, kaw, rkw; };
__device__ __forceinline__ void ck_prep_a(const CkPar& cp, const CkRegs& g, LAS unsigned char* slot, LAS unsigned char* scr, int lane) {
    const float sw0 = cp.sw0, kkw = cp.kkw, kaw = cp.kaw, rkw = cp.rkw;
    float gprev = 1.f, pa = 0.f, pb = 0.f, pk = 0.f, pv = 0.f, pr = 0.f, p1 = 0.f, p2 = 0.f;
    unsigned att[8], btt[8], ktt[8], vtb[8], rtt[8], x1t[8], x2t[8];
#pragma unroll
    for (int t = 0; t < 16; ++t) {
        const float r = bf2f(g.rk[t].x), k = bf2f(g.rk[t].y), wl = bf2f(g.wa[t].x), al = bf2f(g.wa[t].y);
        const float dec = __builtin_amdgcn_exp2f(-0.8750387f * (sw0 + wl));
        const float a = al;
        const float kkv = k * kkw;
        const float kp = k * (1.f + (a - 1.f) * kaw);
        const float gcur = gprev * dec, rg = __builtin_amdgcn_rcpf(gcur);
        const float at = -kkv * gprev, bt = kkv * a * rg, kt = kp * rg, rt = r * gcur, vv = bf2f((t & 1) ? g.vv[t >> 1].y : g.vv[t >> 1].x);
        const float x1 = kkv * kkv, x2 = r * kp * rkw;
        if (t & 1) {
            att[t >> 1] = pk2(pa, at); btt[t >> 1] = pk2(pb, bt); ktt[t >> 1] = pk2(pk, kt); vtb[t >> 1] = pk2(pv, vv);
            rtt[t >> 1] = pk2(pr, rt); x1t[t >> 1] = pk2(p1, x1); x2t[t >> 1] = pk2(p2, x2);
        }
        pa = at; pb = bt; pk = kt; pv = vv; pr = rt; p1 = x1; p2 = x2;
        gprev = gcur;
    }
    *(LAS u32x4*)(slot + SL_RT + lane * 32) = (u32x4){rtt[0], rtt[1], rtt[2], rtt[3]}; *(LAS u32x4*)(slot + SL_RT + lane * 32 + 16) = (u32x4){rtt[4], rtt[5], rtt[6], rtt[7]};
    *(LAS u32x4*)(scr + SC_X1 + lane * 32) = (u32x4){x1t[0], x1t[1], x1t[2], x1t[3]}; *(LAS u32x4*)(scr + SC_X1 + lane * 32 + 16) = (u32x4){x1t[4], x1t[5], x1t[6], x1t[7]};
    *(LAS u32x4*)(scr + SC_X2 + lane * 32) = (u32x4){x2t[0], x2t[1], x2t[2], x2t[3]}; *(LAS u32x4*)(scr + SC_X2 + lane * 32 + 16) = (u32x4){x2t[4], x2t[5], x2t[6], x2t[7]};
    ((LAS float*)(slot + SL_GC))[lane] = gprev;
    *(LAS u32x4*)(scr + SC_ATT + lane * 32) = (u32x4){att[0], att[1], att[2], att[3]}; *(LAS u32x4*)(scr + SC_ATT + lane * 32 + 16) = (u32x4){att[4], att[5], att[6], att[7]};
    *(LAS u32x4*)(slot + SL_BTT + lane * 32) = (u32x4){btt[0], btt[1], btt[2], btt[3]}; *(LAS u32x4*)(slot + SL_BTT + lane * 32 + 16) = (u32x4){btt[4], btt[5], btt[6], btt[7]};
    *(LAS u32x4*)(scr + SC_KTT + lane * 32) = (u32x4){ktt[0], ktt[1], ktt[2], ktt[3]}; *(LAS u32x4*)(scr + SC_KTT + lane * 32 + 16) = (u32x4){ktt[4], ktt[5], ktt[6], ktt[7]};
    if (lane < 16) {
        *(LAS u32x4*)(slot + SL_VTB + lane * 32) = (u32x4){vtb[0], vtb[1], vtb[2], vtb[3]}; *(LAS u32x4*)(slot + SL_VTB + lane * 32 + 16) = (u32x4){vtb[4], vtb[5], vtb[6], vtb[7]};
    }
    LDSW();
}
__device__ __forceinline__ void ck_prep_b(LAS unsigned char* slot, LAS unsigned char* scr, int lane) {
    const int m = lane & 15, kg = lane >> 4;
    const f32x4 z4 = (f32x4){0.f, 0.f, 0.f, 0.f};
    f32x4 P1, P2, P3, P4;
    {
        const int tro = (8 * kg + ((lane >> 2) & 3)) * 32 + (lane & 3) * 8;
        const bf16x8 KA0 = ck_tr8(scr + SC_KTT + tro, 128), KA1 = ck_tr8(scr + SC_KTT + tro + 1024, 128);
        const bf16x8 BA0 = ck_tr8(slot + SL_BTT + tro, 128), BA1 = ck_tr8(slot + SL_BTT + tro + 1024, 128);
        const bf16x8 AB0 = ck_tr8(scr + SC_ATT + tro, 128), AB1 = ck_tr8(scr + SC_ATT + tro + 1024, 128);
        const bf16x8 RB0 = ck_tr8(slot + SL_RT + tro, 128), RB1 = ck_tr8(slot + SL_RT + tro + 1024, 128);
        P1 = MFMA32(KA0, AB0, z4); P1 = MFMA32(KA1, AB1, P1);
        P2 = MFMA32(BA0, AB0, z4); P2 = MFMA32(BA1, AB1, P2);
        P3 = MFMA32(KA0, RB0, z4); P3 = MFMA32(KA1, RB1, P3);
        P4 = MFMA32(BA0, RB0, z4); P4 = MFMA32(BA1, RB1, P4);
    }
    f32x4 rn4;
    {
        const u32x4 one4 = (u32x4){0x3f803f80u, 0x3f803f80u, 0x3f803f80u, 0x3f803f80u}; const bf16x8 ones = __builtin_bit_cast(bf16x8, one4);
        const int tro = (8 * kg + ((lane >> 2) & 3)) * 32 + (lane & 3) * 8;
        const bf16x8 X10 = ck_tr8(scr + SC_X1 + tro, 128), X11 = ck_tr8(scr + SC_X1 + tro + 1024, 128);
        const bf16x8 X20 = ck_tr8(scr + SC_X2 + tro, 128), X21 = ck_tr8(scr + SC_X2 + tro + 1024, 128);
        f32x4 N2 = MFMA32(X10, ones, z4); N2 = MFMA32(X11, ones, N2);
        f32x4 BO = MFMA32(X20, ones, z4); BO = MFMA32(X21, ones, BO);
#pragma unroll
        for (int e = 0; e < 4; ++e) rn4[e] = __builtin_amdgcn_rsqf(fmaxf(N2[e], 1e-24f));
        if (m == 0) { *(LAS f32x4*)(slot + SL_RN + 4 * kg * 4) = rn4; *(LAS f32x4*)(slot + SL_BON + 4 * kg * 4) = BO; }
    }
    LDSW();
    const float rnm = ((const LAS float*)(slot + SL_RN))[m];
    f32x4 lak, lab, mrk, mrb;
#pragma unroll
    for (int e = 0; e < 4; ++e) { P1[e] *= rnm; P2[e] *= rnm * rn4[e]; P4[e] *= rn4[e]; }
#pragma unroll
    for (int e = 0; e < 4; ++e) { const int sI = 4 * kg + e; lak[e] = sI < m ? P1[e] : 0.f; lab[e] = sI < m ? P2[e] : 0.f; mrk[e] = sI <= m ? P3[e] : 0.f; mrb[e] = sI <= m ? P4[e] : 0.f; }
    *(LAS f32x4*)(scr + SC_LAB + (m * 16 + 4 * kg) * 4) = lab;
    *(LAS bf16x4*)(slot + SL_MRB + lane * 8) = pack4(mrb);
    const bf16x4 lakop = pack4(lak), mrkop = pack4(mrk);
    LDSW();
    float x[16];
#pragma unroll
    for (int t = 0; t < 16; ++t) {
        float acc = (t == m) ? 1.f : 0.f;
#pragma unroll
        for (int s4 = 0; s4 * 4 < t; ++s4) {
            const f32x4 L4 = *(const LAS f32x4*)(scr + SC_LAB + (t * 16 + 4 * s4) * 4);
#pragma unroll
            for (int e = 0; e < 4; ++e) if (4 * s4 + e < t) acc = fmaf(L4[e], x[4 * s4 + e], acc);
        }
        x[t] = acc;
    }
    if (lane < 16) {
#pragma unroll
        for (int t = 0; t < 16; ++t) { ((LAS bf16_t*)(scr + SC_TM))[t * 16 + m] = bf1(x[t]); ((LAS bf16_t*)(scr + SC_TM2))[t * 16 + m] = bf1(x[t] * rnm); }
    }
    LDSW();
    const bf16x4 vop = *(const LAS bf16x4*)(slot + SL_VTB + (m * 16 + 4 * kg) * 2);
    const bf16x4 top = *(const LAS bf16x4*)(scr + SC_TM + (m * 16 + 4 * kg) * 2);
    const bf16x4 top2 = *(const LAS bf16x4*)(scr + SC_TM2 + (m * 16 + 4 * kg) * 2);
    const f32x4 LV = MFMA16(lakop, vop, z4);
    const f32x4 Y0 = MFMA16(mrkop, vop, z4);
    *(LAS f32x4*)(slot + SL_Y0 + lane * 16) = Y0;
    const f32x4 UH = MFMA16(top, pack4(LV), z4);
    *(LAS f32x4*)(slot + SL_UH + lane * 16) = UH;
    u32x4 o1, o2;
    {
        f32x4 AH[4], ZV[4];
#pragma unroll
        for (int tau = 0; tau < 4; ++tau) {
            const bf16x4 aop = *(const LAS bf16x4*)(scr + SC_ATT + ((16 * tau + m) * 16 + 4 * kg) * 2);
            AH[tau] = MFMA16(aop, top2, z4);
            const bf16x4 kop = *(const LAS bf16x4*)(scr + SC_KTT + ((16 * tau + m) * 16 + 4 * kg) * 2);
            ZV[tau] = MFMA16(kop, vop, z4);
        }
        o1 = (u32x4){pk2(AH[0].x, AH[0].y), pk2(AH[0].z, AH[0].w), pk2(AH[1].x, AH[1].y), pk2(AH[1].z, AH[1].w)};
        o2 = (u32x4){pk2(AH[2].x, AH[2].y), pk2(AH[2].z, AH[2].w), pk2(AH[3].x, AH[3].y), pk2(AH[3].z, AH[3].w)};
        *(LAS u32x4*)(slot + SL_AOP + lane * 32) = o1; *(LAS u32x4*)(slot + SL_AOP + lane * 32 + 16) = o2;
        o1 = (u32x4){pk2(ZV[0].x, ZV[0].y), pk2(ZV[0].z, ZV[0].w), pk2(ZV[1].x, ZV[1].y), pk2(ZV[1].z, ZV[1].w)};
        o2 = (u32x4){pk2(ZV[2].x, ZV[2].y), pk2(ZV[2].z, ZV[2].w), pk2(ZV[3].x, ZV[3].y), pk2(ZV[3].z, ZV[3].w)};
        *(LAS u32x4*)(slot + SL_ZV + lane * 32) = o1; *(LAS u32x4*)(slot + SL_ZV + lane * 32 + 16) = o2;
    }
    LDSW();
}
__device__ __forceinline__ void ck_wait(volatile LAS unsigned* f, unsigned v) { while (*f != v) __builtin_amdgcn_s_sleep(1); asm volatile("" ::: "memory"); }
__device__ __forceinline__ void scan_chunked_item(KPtr P, LAS unsigned char* lds, int it, int tid, int mode) {
    const int lane = tid & 63, w = __builtin_amdgcn_readfirstlane(tid >> 6);
    const int b = it >> 6, h = (it >> 2) & 15, qi = it & 3, rowbase = b * TP;
    constexpr int NCH = TP / 16;
    volatile LAS unsigned* flags = (volatile LAS unsigned*)(lds + CK_FLAGS);
    if (tid < 16) flags[tid] = 0u;
    __syncthreads();
    if (w == 0) {
#ifndef NO_SEQ_PRIO
        __builtin_amdgcn_s_setprio(3);
#endif
        const int m = lane & 15, kg = lane >> 4;
        f32x4 ST[4];
#pragma unroll
        for (int tau = 0; tau < 4; ++tau) ST[tau] = (f32x4){0.f, 0.f, 0.f, 0.f};
        bf16_t* Yg = (bf16_t*)(P->ws + O_Y) + (size_t)rowbase * D + h * 64 + qi * 16 + m;
        bf16_t* Bg = (bf16_t*)(P->ws + O_BON) + (size_t)rowbase * D + h * 64 + qi * 16 + m;
        int pslot = 0;
#pragma unroll 1
        for (int c = 0; c < NCH; ++c) {
            LAS unsigned char* slot = lds + pslot * (SLOT_B + SCR_B);
            ck_wait(flags + pslot, (unsigned)(c + 1));
            if (mode == 1 || mode == 3) { flags[8 + pslot] = (unsigned)(c + 1); pslot = (pslot == NPREP - 1) ? 0 : pslot + 1; continue; }
            const f32x4 z4 = (f32x4){0.f, 0.f, 0.f, 0.f};
            const u32x4 s1 = (u32x4){pk2(ST[0].x, ST[0].y), pk2(ST[0].z, ST[0].w), pk2(ST[1].x, ST[1].y), pk2(ST[1].z, ST[1].w)};
            const u32x4 s2 = (u32x4){pk2(ST[2].x, ST[2].y), pk2(ST[2].z, ST[2].w), pk2(ST[3].x, ST[3].y), pk2(ST[3].z, ST[3].w)};
            const bf16x8 sop1 = __builtin_bit_cast(bf16x8, s1), sop2 = __builtin_bit_cast(bf16x8, s2);
            const bf16x8 aop1 = *(const LAS bf16x8*)(slot + SL_AOP + lane * 32), aop2 = *(const LAS bf16x8*)(slot + SL_AOP + lane * 32 + 16);
            const LAS unsigned char* rrow = slot + SL_RT + (4 * kg + ((lane >> 2) & 3)) * 32 + (lane & 3) * 8;
            const bf16x8 rop1 = ck_tr8(rrow, 512), rop2 = ck_tr8(rrow + 1024, 512);
            f32x4 U = MFMA32(aop1, sop1, z4); U = MFMA32(aop2, sop2, U);
            f32x4 Y = MFMA32(rop1, sop1, z4); Y = MFMA32(rop2, sop2, Y);
            U = U + *(const LAS f32x4*)(slot + SL_UH + lane * 16);
            const bf16x4 uop = pack4(U);
            const bf16x4 uop2 = pack4(U * *(const LAS f32x4*)(slot + SL_RN + 4 * kg * 4));
            const bf16x4 mop = *(const LAS bf16x4*)(slot + SL_MRB + lane * 8);
            Y = MFMA16(mop, uop, Y);
            Y = Y + *(const LAS f32x4*)(slot + SL_Y0 + lane * 16);
            const u32x4 zv1 = *(const LAS u32x4*)(slot + SL_ZV + lane * 32), zv2 = *(const LAS u32x4*)(slot + SL_ZV + lane * 32 + 16);
            const unsigned zvw[8] = {zv1.x, zv1.y, zv1.z, zv1.w, zv2.x, zv2.y, zv2.z, zv2.w};
#pragma unroll
            for (int tau = 0; tau < 4; ++tau) {
                const bf16x4 bop = *(const LAS bf16x4*)(slot + SL_BTT + ((16 * tau + m) * 16 + 4 * kg) * 2);
                const f32x4 dS = MFMA16(bop, uop2, z4);
                const f32x4 gc = *(const LAS f32x4*)(slot + SL_GC + (16 * tau + 4 * kg) * 4);
                const f32x4 zv = (f32x4){bflo(zvw[2 * tau]), bfhi(zvw[2 * tau]), bflo(zvw[2 * tau + 1]), bfhi(zvw[2 * tau + 1])};
                ST[tau] = (ST[tau] + dS + zv) * gc;
            }
            const f32x4 bn = *(const LAS f32x4*)(slot + SL_BON + 4 * kg * 4); const u32x2 vtw = *(const LAS u32x2*)(slot + SL_VTB + (m * 16 + 4 * kg) * 2);
            const f32x4 vt4 = (f32x4){bflo(vtw.x), bfhi(vtw.x), bflo(vtw.y), bfhi(vtw.y)};
            LDSW();
            flags[8 + pslot] = (unsigned)(c + 1);
            if (mode == 0) {
#pragma unroll
            for (int e = 0; e < 4; ++e) {
                const size_t off = (size_t)(c * 16 + 4 * kg + e) * D;
                Yg[off] = bf1(Y[e]); Bg[off] = bf1(bn[e] * vt4[e]);
            } } else { asm volatile("" :: "v"(Y), "v"(bn), "v"(vt4)); }
            pslot = (pslot == NPREP - 1) ? 0 : pslot + 1;
        }
        __builtin_amdgcn_s_setprio(0);
        float* sout = P->out + O_WKVP + (size_t)(b * 16 + h) * 4096 + (size_t)(qi * 16 + m) * 64;
        if (mode == 0) {
#pragma unroll
        for (int tau = 0; tau < 4; ++tau) *(f32x4*)(sout + 16 * tau + 4 * kg) = ST[tau]; } else { asm volatile("" :: "v"(ST[0]), "v"(ST[1]), "v"(ST[2]), "v"(ST[3])); }
    } else if ((NPREP == 7 ? w - 1 : (w < 4 ? w - 1 : w - 2)) < NPREP && !(NPREP < 7 && w == 4)) {
        const int p = (NPREP == 7) ? w - 1 : (w < 4 ? w - 1 : w - 2);
        LAS unsigned char* slot = lds + p * (SLOT_B + SCR_B); LAS unsigned char* scr = slot + SLOT_B;
        CkRegs g;
        CkPar cp; { const int ch = h * 64 + lane; cp.sw0 = ((const float*)(P->ws + O_PAR))[1024 + ch]; cp.kkw = P->in[25][ch]; cp.kaw = P->in[26][ch]; cp.rkw = P->in[27][ch]; }
        ck_load(P, g, rowbase + p * 16, h, qi, lane);
#pragma unroll 1
        for (int c = p; c < NCH; c += NPREP) {
            if (c >= NPREP) ck_wait(flags + 8 + p, (unsigned)(c - NPREP + 1));
            if (mode == 2) { flags[p] = (unsigned)(c + 1); continue; }
            ck_prep_a(cp, g, slot, scr, lane);
            if (mode != 3) { const int cn = (c + NPREP < NCH) ? c + NPREP : c; ck_load(P, g, rowbase + cn * 16, h, qi, lane); }
            ck_prep_b(slot, scr, lane);
            flags[p] = (unsigned)(c + 1);
        }
    }
}

__device__ __forceinline__ void scan_phase(KPtr P, LAS unsigned char* lds) {
    const int tid = tid_fresh(), lane = tid & 63, w = __builtin_amdgcn_readfirstlane(tid >> 6);
    const int bid = bid_fresh(), gdim = gdim_fresh();
#ifndef SCAN_REP_P
#define SCAN_REP_P 1
#endif
#ifndef SCAN_MODE2
#define SCAN_MODE2 0
#endif
#ifndef SCAN_REP_S
#define SCAN_REP_S 1
#endif
#ifdef SCAN_PRETOUCH
    {
        const int it = (gdim == 256) ? (((bid & 7) * 8 + (bid >> 5)) * 4 + ((bid >> 3) & 3)) : bid;
        const int b = it >> 6, h = (it >> 2) & 15, qi = it & 3;
        const bf16_t* RKV = (const bf16_t*)(P->ws + O_RKVB); const bf16_t* WL = (const bf16_t*)(P->ws + O_WL); const bf16_t* AL = (const bf16_t*)(P->ws + O_AL);
        unsigned acc = 0;
        for (int r = qi * 1024 + (tid >> 3); r < qi * 1024 + 1024; r += 64) {
            const size_t row = (size_t)b * TP + r; const int sub = tid & 7;
            for (int pc = sub; pc < 10; pc += 8) {
                const int seg = pc >> 1, half = pc & 1;
                const bf16_t* p = seg < 3 ? RKV + row * 3072 + seg * 1024 + h * 64 + half * 32 : (seg == 3 ? WL : AL) + row * 1024 + h * 64 + half * 32;
                acc += *(const unsigned*)p;
            }
        }
        if (acc == 0x12345678u) ((volatile LAS unsigned*)lds)[0] = acc;
        __syncthreads();
    }
#endif
    for (int rp_ = 0; rp_ < SCAN_REP_P; ++rp_)
    for (int it0 = bid; it0 < 256; it0 += gdim) {
        const int it = (gdim == 256) ? (((it0 & 7) * 8 + (it0 >> 5)) * 4 + ((it0 >> 3) & 3)) : it0;
        scan_chunked_item(P, lds, it, tid, rp_ == 0 ? 0 : SCAN_MODE2); __syncthreads(); }
    for (int rs_ = 0; rs_ < SCAN_REP_S; ++rs_)
    for (int it = 256 + bid; it < 256 + 2048; it += gdim) {
        int rowbase, T, h, qi; const float* sin; float* sout;
        if (it < 256) { const int b = it >> 6; h = (it >> 2) & 15; qi = it & 3; rowbase = b * TP; T = TP; sin = nullptr; sout = P->out + O_WKVP + (size_t)(b * 16 + h) * 4096; }
        else { const int j = it - 256; const int b = j >> 6; h = (j >> 2) & 15; qi = j & 3; rowbase = MP + b * TS; T = TS; sin = P->in[2] + (size_t)(b * 16 + h) * 4096; sout = P->out + O_WKVS + (size_t)(b * 16 + h) * 4096; }
        const int nch = (T + TC - 1) / TC;
        const int rr = lane >> 4, q = lane & 15; const int il = (w & 3) * 4 + rr; const int irow = qi * 16 + il;
        f32x4 s = (f32x4){0.f, 0.f, 0.f, 0.f};
        PrepRegs pg;
        if (w < 4) { if (sin) s = *(const f32x4*)(sin + (size_t)irow * 64 + q * 4); }
        else { scan_prep_load(P, pg, rowbase, 0, T, h, qi, w - 4, lane); scan_prep_compute(P, pg, lds, h, w - 4, lane); if (nch > 1) scan_prep_load(P, pg, rowbase, TC, T, h, qi, w - 4, lane); }
        __syncthreads();
        for (int c = 0; c < nch; ++c) {
            LAS unsigned char* buf = lds + (c & 1) * SC_BUF;
            LAS float* ob = (LAS float*)(lds + SC_OUT + (c & 1) * SC_OBUF);
            if (w >= 4) {
                if (c > 0) scan_flush(P, (const LAS float*)(lds + SC_OUT + ((c - 1) & 1) * SC_OBUF), rowbase, (c - 1) * TC, T, h, qi, tid - 256);
                if (c + 1 < nch) { scan_prep_compute(P, pg, lds + ((c + 1) & 1) * SC_BUF, h, w - 4, lane); if (c + 2 < nch) scan_prep_load(P, pg, rowbase, (c + 2) * TC, T, h, qi, w - 4, lane); }
            } else {
                const int ns = (T - c * TC) < TC ? (T - c * TC) : TC;
                const LAS float* fb = (const LAS float*)buf;
#pragma unroll 1
                for (int t8 = 0; t8 < ns; t8 += 8) {
                    f32x4 nkk = *(const LAS f32x4*)(fb + 0 * TC * 64 + t8 * 64 + q * 4), dw = *(const LAS f32x4*)(fb + 1 * TC * 64 + t8 * 64 + q * 4);
                    f32x4 bb = *(const LAS f32x4*)(fb + 2 * TC * 64 + t8 * 64 + q * 4), kp = *(const LAS f32x4*)(fb + 3 * TC * 64 + t8 * 64 + q * 4);
                    f32x4 r4 = *(const LAS f32x4*)(fb + 4 * TC * 64 + t8 * 64 + q * 4);
                    float vv = fb[5 * TC * 64 + t8 * 16 + il], bon = fb[5 * TC * 64 + TC * 16 + t8];
                    float keep = 0.f;
#pragma unroll
                    for (int u = 0; u < 8; ++u) {
                        const int tn = t8 + (u < 7 ? u + 1 : 7);
                        const f32x4 nkk_n = *(const LAS f32x4*)(fb + 0 * TC * 64 + tn * 64 + q * 4), dw_n = *(const LAS f32x4*)(fb + 1 * TC * 64 + tn * 64 + q * 4);
                        const f32x4 bb_n = *(const LAS f32x4*)(fb + 2 * TC * 64 + tn * 64 + q * 4), kp_n = *(const LAS f32x4*)(fb + 3 * TC * 64 + tn * 64 + q * 4);
                        const f32x4 r4_n = *(const LAS f32x4*)(fb + 4 * TC * 64 + tn * 64 + q * 4);
                        const float vv_n = fb[5 * TC * 64 + tn * 16 + il], bon_n = fb[5 * TC * 64 + TC * 16 + tn];
                        float sa0 = s.x * nkk.x, sa1 = s.z * nkk.z; sa0 = fmaf(s.y, nkk.y, sa0); sa1 = fmaf(s.w, nkk.w, sa1);
                        const float sa = row_sum16(sa0 + sa1);
                        s = s * dw + bb * sa + kp * vv;
                        float y0 = s.x * r4.x, y1 = s.z * r4.z; y0 = fmaf(s.y, r4.y, y0); y1 = fmaf(s.w, r4.w, y1);
                        const float y = row_sum16(y0 + y1);
                        const float val = (q < 8) ? y : bon * vv;
                        keep = ((q & 7) == u) ? val : keep;
                        nkk = nkk_n; dw = dw_n; bb = bb_n; kp = kp_n; r4 = r4_n; vv = vv_n; bon = bon_n;
                    }
                    ob[(q < 8 ? 0 : TC * 16) + (t8 + (q & 7)) * 16 + il] = keep;
                }
            }
            __syncthreads();
        }
        if (w < 4) *(f32x4*)(sout + (size_t)irow * 64 + q * 4) = s;
        else scan_flush(P, (const LAS float*)(lds + SC_OUT + ((nch - 1) & 1) * SC_OBUF), rowbase, (nch - 1) * TC, T, h, qi, tid - 256);
        __syncthreads();
    }
}

__device__ __forceinline__ int t5_bucket(int d) {
    if (d < 16) return d;
    int b = 16;
    b += (d >= 22) + (d >= 30) + (d >= 40) + (d >= 54) + (d >= 73) + (d >= 99) + (d >= 134) + (d >= 182) + (d >= 246) + (d >= 332) + (d >= 450) + (d >= 609) + (d >= 825) + (d >= 1117) + (d >= 1513);
    return b;
}
constexpr int BIAS_LD = 465, BIAS_OFF = 288;
constexpr int ATT_BIAS_BYTES = 3 * 16 * BIAS_LD * 4;
constexpr int ATT_WSCR = 12288;
__device__ __forceinline__ void vt_build(KPtr P, LAS unsigned char* lds) {
    const int tid = tid_fresh(); const int bid = bid_fresh(), gdim = gdim_fresh();
    const bf16_t* VB = (const bf16_t*)(P->ws + O_VB); bf16_t* VT = (bf16_t*)(P->ws + O_VT);
    const bf16_t* KB = (const bf16_t*)(P->ws + O_KB); bf16_t* KT = (bf16_t*)(P->ws + O_KT);
    constexpr int PITCH = 136;
    for (int it = bid; it < 384; it += gdim) {
        const int g = it % 3, un = it / 3, b = un >> 5, kvh = (un >> 3) & 3, tb = un & 7;
        const int sh = 2 * g;
        const int nblk_loc = 16 >> sh;
        const int nblk_tot = 128 >> sh;
#pragma unroll 1
        for (int kv = 0; kv < 2; ++kv) {
            const bf16_t* src = kv ? KB : VB;
            __syncthreads();
#pragma unroll
            for (int q = 0; q < 8; ++q) {
                const int idx = q * 512 + tid, t = idx >> 3, ch = idx & 7;
                const u32x4 v = *(const u32x4*)(src + ((size_t)(b * TP + tb * 512 + t)) * 256 + kvh * 64 + ch * 8);
                LAS u32x2* d = (LAS u32x2*)(lds + t * PITCH + ch * 16);
                d[0] = (u32x2){v.x, v.y}; d[1] = (u32x2){v.z, v.w};
            }
            __syncthreads();
            if (kv == 0) {
#pragma unroll 1
                for (int q = 0; q < 8; ++q) {
                    const int idx = q * 512 + tid;
                    const int oct = idx & 3, dim = (idx >> 2) & 63, cb = idx >> 8;
                    const int cls = cb / nblk_loc, lb = cb % nblk_loc;
                    unsigned short e[8];
#pragma unroll
                    for (int i = 0; i < 8; ++i) { const int pp = 16 * (oct >> 1) + 8 * (i >> 2) + 4 * (oct & 1) + (i & 3);
                        const int tl = ((lb * 32 + pp) << sh) + cls; e[i] = *(const LAS unsigned short*)(lds + tl * PITCH + dim * 2); }
                    u32x4 o; o.x = e[0] | ((unsigned)e[1] << 16); o.y = e[2] | ((unsigned)e[3] << 16); o.z = e[4] | ((unsigned)e[5] << 16); o.w = e[6] | ((unsigned)e[7] << 16);
                    const int blk = tb * nblk_loc + lb;
                    const int inner = ((((oct >> 1) * 2 + (dim >> 5)) * 2 + (oct & 1)) * 32 + (dim & 31)) * 8;
                    *(u32x4*)(VT + (size_t)g * VT_COPY + (size_t)((((b * 4 + kvh) << sh) + cls) * nblk_tot + blk) * 2048 + inner) = o;
                }
            } else {
#pragma unroll 1
                for (int q = 0; q < 8; ++q) {
                    const int idx = q * 512 + tid;
                    const int key = idx & 31, p = (idx >> 5) & 7, cb = idx >> 8;
                    const int cls = cb / nblk_loc, lb = cb % nblk_loc;
                    const int tl = ((lb * 32 + key) << sh) + cls;
                    const LAS u32x2* sp = (const LAS u32x2*)(lds + tl * PITCH + p * 16);
                    const u32x2 a0 = sp[0], a1 = sp[1];
                    const int blk = tb * nblk_loc + lb;
                    *(u32x4*)(KT + (size_t)g * VT_COPY + (size_t)((((b * 4 + kvh) << sh) + cls) * nblk_tot + blk) * 2048 + (p * 32 + key) * 8) = (u32x4){a0.x, a0.y, a1.x, a1.y};
                }
            }
        }
    }
    __syncthreads();
}
__device__ __forceinline__ void attn_phase(KPtr P, LAS unsigned char* lds) {
    const int tid = tid_fresh(), lane = tid & 63, w = __builtin_amdgcn_readfirstlane(tid >> 6);
    LAS float* bias = (LAS float*)lds;
    for (int e = tid; e < 3 * 16 * BIAS_LD; e += NTHREADS) {
        const int gh = e / BIAS_LD, x = e % BIAS_LD, g = gh >> 4, hd = gh & 15, j = BIAS_OFF - x;
        const int dil = g == 0 ? 1 : (g == 1 ? 4 : 16);
        float v = -1e30f;
        if (j >= 0 && j <= 128) v = P->in[34][t5_bucket(dil * j) * 48 + g * 16 + hd] * 1.4426950408889634f;
        bias[e] = v;
    }
    volatile LAS unsigned* ctr = (volatile LAS unsigned*)(lds + ATT_BIAS_BYTES + 4 * ATT_WSCR);
    if (tid == 0) ctr[0] = 0u;
    __syncthreads();
    const bf16_t* Q = (const bf16_t*)(P->ws + O_Q); const bf16_t* KT = (const bf16_t*)(P->ws + O_KT); const bf16_t* VT = (const bf16_t*)(P->ws + O_VT);
    bf16_t* ATT = (bf16_t*)(P->ws + O_ATT);
    const int bidx = bid_fresh(), gdimx = gdim_fresh();
    const int n = lane & 31, hh = lane >> 5, r = n >> 3, iq = n & 7;
    LAS float* qsc = (LAS float*)(lds + ATT_BIAS_BYTES + w * ATT_WSCR);
    LAS float* psc = qsc + 768;
    const float* cache = P->in[4]; const float* kvs = P->out + O_KVS;
#ifndef ATT_REP_S
#define ATT_REP_S 1
#endif
#ifndef ATT_MODE2
#define ATT_MODE2 0
#endif
#ifndef ATT_REP_P
#define ATT_REP_P 1
#endif
    if (w < 4)
    for (int reps_ = 0; reps_ < ATT_REP_S; ++reps_)
    for (int it = bidx * 4 + w; it < 1024; it += gdimx * 4) {
        const int b = it >> 5, t = (it >> 2) & 7, kvh = it & 3;
        const size_t qrow = (size_t)MP + b * TS + t;
        for (int e = lane; e < 768; e += 64) { const int g = e >> 8, rr2 = (e >> 6) & 3, d = e & 63; qsc[e] = bf2f(Q[qrow * 3072 + g * 1024 + kvh * 256 + rr2 * 64 + d]); }
        asm volatile("s_waitcnt lgkmcnt(0)" ::: "memory");
        float mx0 = -1e30f, mx1 = -1e30f, mx2 = -1e30f, mx3 = -1e30f;
#pragma unroll 1
        for (int gj = 0; gj < 9; ++gj) {
            const int g = gj / 3, jb = gj % 3, sh = 2 * g;
            const int j = jb * 64 + lane; const bool valid = j <= 128; const int jc = valid ? j : 128;
            const int pext = 2048 + t - (jc << sh);
            const float* kp = pext < 2048 ? cache + ((size_t)(b * 2048 + pext) * 2) * 256 + kvh * 64 : kvs + (size_t)(b * TS + (pext - 2048)) * 512 + kvh * 64;
            float d0 = 0.f, d1 = 0.f, d2 = 0.f, d3 = 0.f;
#pragma unroll 4
            for (int dd = 0; dd < 16; ++dd) {
                const f32x4 kv = *(const f32x4*)(kp + dd * 4);
                const f32x4 q0 = *(const LAS f32x4*)(qsc + g * 256 + 0 * 64 + dd * 4), q1 = *(const LAS f32x4*)(qsc + g * 256 + 1 * 64 + dd * 4);
                const f32x4 q2 = *(const LAS f32x4*)(qsc + g * 256 + 2 * 64 + dd * 4), q3 = *(const LAS f32x4*)(qsc + g * 256 + 3 * 64 + dd * 4);
                d0 += (kv.x * q0.x + kv.y * q0.y) + (kv.z * q0.z + kv.w * q0.w); d1 += (kv.x * q1.x + kv.y * q1.y) + (kv.z * q1.z + kv.w * q1.w);
                d2 += (kv.x * q2.x + kv.y * q2.y) + (kv.z * q2.z + kv.w * q2.w); d3 += (kv.x * q3.x + kv.y * q3.y) + (kv.z * q3.z + kv.w * q3.w);
            }
            const LAS float* bb = bias + (g * 16 + kvh * 4) * BIAS_LD + (BIAS_OFF - jc);
            const float v0 = valid ? d0 + bb[0] : -1e30f, v1 = valid ? d1 + bb[BIAS_LD] : -1e30f, v2 = valid ? d2 + bb[2 * BIAS_LD] : -1e30f, v3 = valid ? d3 + bb[3 * BIAS_LD] : -1e30f;
            psc[(g * 4 + 0) * 192 + j] = v0; psc[(g * 4 + 1) * 192 + j] = v1; psc[(g * 4 + 2) * 192 + j] = v2; psc[(g * 4 + 3) * 192 + j] = v3;
            mx0 = fmaxf(mx0, v0); mx1 = fmaxf(mx1, v1); mx2 = fmaxf(mx2, v2); mx3 = fmaxf(mx3, v3);
        }
#pragma unroll
        for (int o = 1; o < 64; o <<= 1) { mx0 = fmaxf(mx0, __shfl_xor(mx0, o)); mx1 = fmaxf(mx1, __shfl_xor(mx1, o)); mx2 = fmaxf(mx2, __shfl_xor(mx2, o)); mx3 = fmaxf(mx3, __shfl_xor(mx3, o)); }
        asm volatile("s_waitcnt lgkmcnt(0)" ::: "memory");
        float s0 = 0.f, s1 = 0.f, s2 = 0.f, s3 = 0.f;
#pragma unroll 1
        for (int gj = 0; gj < 9; ++gj) {
            const int g = gj / 3, j = (gj % 3) * 64 + lane;
            LAS float* pp = psc + (g * 4) * 192 + j;
            const float l0 = pp[0], l1 = pp[192], l2 = pp[384], l3 = pp[576];
            const float p0 = l0 > -1e29f ? __builtin_amdgcn_exp2f(l0 - mx0) : 0.f, p1 = l1 > -1e29f ? __builtin_amdgcn_exp2f(l1 - mx1) : 0.f, p2 = l2 > -1e29f ? __builtin_amdgcn_exp2f(l2 - mx2) : 0.f, p3 = l3 > -1e29f ? __builtin_amdgcn_exp2f(l3 - mx3) : 0.f;
            pp[0] = p0; pp[192] = p1; pp[384] = p2; pp[576] = p3;
            s0 += p0; s1 += p1; s2 += p2; s3 += p3;
        }
        s0 = wave_sum(s0); s1 = wave_sum(s1); s2 = wave_sum(s2); s3 = wave_sum(s3);
        asm volatile("s_waitcnt lgkmcnt(0)" ::: "memory");
        const int ksub = lane >> 4, dq = (lane & 15) * 4;
        f32x4 oa0 = (f32x4){0.f, 0.f, 0.f, 0.f}, oa1 = oa0, oa2 = oa0, oa3 = oa0;
#pragma unroll 1
        for (int g = 0; g < 3; ++g) {
            const int sh = 2 * g;
#pragma unroll 11
            for (int j0 = 0; j0 < 132; j0 += 4) {
                const int j = j0 + ksub; const int jc = j > 128 ? 128 : j;
                const int pext = 2048 + t - (jc << sh);
                const float* vp = pext < 2048 ? cache + ((size_t)(b * 2048 + pext) * 2 + 1) * 256 + kvh * 64 + dq : kvs + (size_t)(b * TS + (pext - 2048)) * 512 + 256 + kvh * 64 + dq;
                const f32x4 vv = *(const f32x4*)vp;
                const LAS float* pp = psc + (g * 4) * 192 + jc;
                const bool ok = j <= 128;
                const float p0 = ok ? pp[0] : 0.f, p1 = ok ? pp[192] : 0.f, p2 = ok ? pp[384] : 0.f, p3 = ok ? pp[576] : 0.f;
                oa0 = oa0 + vv * p0; oa1 = oa1 + vv * p1; oa2 = oa2 + vv * p2; oa3 = oa3 + vv * p3;
            }
        }
#pragma unroll
        for (int e = 0; e < 4; ++e) {
            oa0[e] += __shfl_xor(oa0[e], 16); oa0[e] += __shfl_xor(oa0[e], 32); oa1[e] += __shfl_xor(oa1[e], 16); oa1[e] += __shfl_xor(oa1[e], 32);
            oa2[e] += __shfl_xor(oa2[e], 16); oa2[e] += __shfl_xor(oa2[e], 32); oa3[e] += __shfl_xor(oa3[e], 16); oa3[e] += __shfl_xor(oa3[e], 32);
        }
        if (ksub == 0) {
            bf16_t* op = ATT + qrow * D + kvh * 256 + dq;
            const float i0 = 1.f / s0, i1 = 1.f / s1, i2 = 1.f / s2, i3 = 1.f / s3;
            u32x2 wv;
            wv.x = pk2(oa0.x * i0, oa0.y * i0); wv.y = pk2(oa0.z * i0, oa0.w * i0); *(u32x2*)(op) = wv;
            wv.x = pk2(oa1.x * i1, oa1.y * i1); wv.y = pk2(oa1.z * i1, oa1.w * i1); *(u32x2*)(op + 64) = wv;
            wv.x = pk2(oa2.x * i2, oa2.y * i2); wv.y = pk2(oa2.z * i2, oa2.w * i2); *(u32x2*)(op + 128) = wv;
            wv.x = pk2(oa3.x * i3, oa3.y * i3); wv.y = pk2(oa3.z * i3, oa3.w * i3); *(u32x2*)(op + 192) = wv;
        }
        asm volatile("s_waitcnt lgkmcnt(0)" ::: "memory");
    }
    const int per_cu = (4096 + gdimx - 1) / gdimx;
    for (;;) {
        int kx = 0;
        if (lane == 0) kx = (int)__hip_atomic_fetch_add((LAS unsigned*)ctr, 1u, __ATOMIC_RELAXED, __HIP_MEMORY_SCOPE_WORKGROUP);
        kx = __builtin_amdgcn_readfirstlane(kx);
        if (kx >= per_cu * ATT_REP_P) break;
        const int amode = (kx >= per_cu) ? ATT_MODE2 : 0;
        kx = kx % per_cu;
        const int it = bidx * per_cu + kx;
        if (it >= 4096) break;
        const int b = it >> 10, rem = it & 1023, kvh = rem >> 8, tg = rem & 255;
        const int tbase = (tg >> 4) * 256 + (tg & 15);
        const size_t qrowA = (size_t)b * TP + tbase + 16 * iq, qrowB = qrowA + 128;
        float mA = -1e4f, lA = 0.f, mB = -1e4f, lB = 0.f;
        f32x16 oA0, oA1, oB0, oB1;
#pragma unroll
        for (int e = 0; e < 16; ++e) { oA0[e] = 0.f; oA1[e] = 0.f; oB0[e] = 0.f; oB1[e] = 0.f; }
#pragma unroll 1
        for (int g = 0; g < 3; ++g) {
            const int sh = 2 * g, dmask = (1 << sh) - 1;
            const int c = tbase & dmask, u0 = tbase >> sh, qs = 16 >> sh;
            bf16x8 qfA[4], qfB[4];
            { const bf16_t* qp = Q + qrowA * 3072 + g * 1024 + kvh * 256 + r * 64 + hh * 8;
#pragma unroll
              for (int ks = 0; ks < 4; ++ks) { qfA[ks] = *(const bf16x8*)(qp + ks * 16); qfB[ks] = *(const bf16x8*)(qp + (size_t)128 * 3072 + ks * 16); } }
            const int ustart = (u0 - 128) & ~31;
            const int ntile = ((u0 + 15 * qs) >> 5) - (ustart >> 5) + 1;
            const int tau0 = ustart < 0 ? ((-ustart) >> 5) : 0;
            const int uqA = u0 + qs * iq, uqB = uqA + 8 * qs;
            const int tA1 = ((u0 + 7 * qs) - ustart) >> 5;
            const int tB0 = ((u0 + 8 * qs - 128) - ustart) >> 5;
            const size_t tile0 = (size_t)((((b * 4 + kvh) << sh) + c) * (128 >> sh) + (ustart >> 5)) * 2048;
            const bf16_t* Kg = KT + (size_t)g * VT_COPY + tile0 + hh * 256 + n * 8;
            const bf16_t* Vg = VT + (size_t)g * VT_COPY + tile0 + hh * 256 + n * 8;
            const LAS float* btA = bias + (g * 16 + kvh * 4 + r) * BIAS_LD + (BIAS_OFF - (uqA - ustart) + 4 * hh);
            const LAS float* btB = btA - 8 * qs;
            bf16x8 kfA[4], vfA[2][2], kfB[4], vfB[2][2];
#define ATT_LOAD(KF, VF, TAU) do { if (amode == 1 && (TAU) != tau0) break; \
                const bf16_t* kp_ = Kg + (size_t)(TAU) * 2048; \
                if (amode != 4) { _Pragma("unroll") for (int ks = 0; ks < 4; ++ks) KF[ks] = *(const bf16x8*)(kp_ + ks * 512); } \
                if (amode == 3) break; \
                const bf16_t* vb_ = Vg + (size_t)(TAU) * 2048; \
                _Pragma("unroll") for (int sI = 0; sI < 2; ++sI) { \
                    _Pragma("unroll") for (int dt = 0; dt < 2; ++dt) VF[sI][dt] = *(const bf16x8*)(vb_ + (sI * 2 + dt) * 512); } } while (0)
#define ATT_BLOCK(KF, VF, TAU, QF, BT0, MR, LR, O0, O1) do { \
                f32x16 S; _Pragma("unroll") for (int e = 0; e < 16; ++e) S[e] = 0.f; \
                _Pragma("unroll") for (int ks = 0; ks < 4; ++ks) S = __builtin_amdgcn_mfma_f32_32x32x16_bf16(KF[ks], QF[ks], S, 0, 0, 0); \
                const LAS float* bt = BT0 + 32 * (TAU); \
                float mx = -1e30f; \
                _Pragma("unroll") for (int e = 0; e < 16; ++e) { S[e] += bt[(e >> 2) * 8 + (e & 3)]; } \
                _Pragma("unroll") for (int e = 0; e < 16; ++e) mx = fmaxf(mx, S[e]); \
                mx = fmaxf(mx, __shfl_xor(mx, 32)); \
                if (__any(mx > MR + 8.0f)) { const float m_new = fmaxf(MR, mx); const float alpha = __builtin_amdgcn_exp2f(MR - m_new); MR = m_new; LR *= alpha; \
                    _Pragma("unroll") for (int e = 0; e < 16; ++e) { O0[e] *= alpha; O1[e] *= alpha; } } \
                float ps = 0.f; \
                _Pragma("unroll") for (int e = 0; e < 16; ++e) { const float p = __builtin_amdgcn_exp2f(S[e] - MR); S[e] = p; ps += p; } \
                LR += ps; \
                _Pragma("unroll") for (int sI = 0; sI < 2; ++sI) { \
                    u32x4 pw; pw.x = pk2(S[8 * sI + 0], S[8 * sI + 1]); pw.y = pk2(S[8 * sI + 2], S[8 * sI + 3]); pw.z = pk2(S[8 * sI + 4], S[8 * sI + 5]); pw.w = pk2(S[8 * sI + 6], S[8 * sI + 7]); \
                    const bf16x8 pb = __builtin_bit_cast(bf16x8, pw); \
                    O0 = __builtin_amdgcn_mfma_f32_32x32x16_bf16(VF[sI][0], pb, O0, 0, 0, 0); \
                    O1 = __builtin_amdgcn_mfma_f32_32x32x16_bf16(VF[sI][1], pb, O1, 0, 0, 0); } } while (0)
#define ATT_TILE(KF, VF, TAU) do { if (amode >= 2) { asm volatile("" :: "v"(KF[0]), "v"(KF[3]), "v"(VF[0][0]), "v"(VF[1][1])); break; } \
                if ((TAU) <= tA1) ATT_BLOCK(KF, VF, TAU, qfA, btA, mA, lA, oA0, oA1); \
                if ((TAU) >= tB0) ATT_BLOCK(KF, VF, TAU, qfB, btB, mB, lB, oB0, oB1); } while (0)
            ATT_LOAD(kfA, vfA, tau0);
            int tau = tau0;
#pragma unroll 1
            for (; tau + 1 < ntile; tau += 2) {
                ATT_LOAD(kfB, vfB, tau + 1);
                ATT_TILE(kfA, vfA, tau);
                { const int tn = (tau + 2 < ntile) ? tau + 2 : tau + 1; ATT_LOAD(kfA, vfA, tn); }
                ATT_TILE(kfB, vfB, tau + 1);
            }
            if (tau < ntile) ATT_TILE(kfA, vfA, tau);
#undef ATT_LOAD
#undef ATT_BLOCK
#undef ATT_TILE
        }
#define ATT_OUT(QROW, LR, O0, O1) do { \
            const float lt = LR + __shfl_xor(LR, 32); const float inv = 1.f / lt; \
            bf16_t* op = ATT + (QROW) * D + kvh * 256 + r * 64 + hh * 4; \
            _Pragma("unroll") for (int e4 = 0; e4 < 4; ++e4) { \
                u32x2 w0; w0.x = pk2(O0[e4 * 4 + 0] * inv, O0[e4 * 4 + 1] * inv); w0.y = pk2(O0[e4 * 4 + 2] * inv, O0[e4 * 4 + 3] * inv); \
                u32x2 w1; w1.x = pk2(O1[e4 * 4 + 0] * inv, O1[e4 * 4 + 1] * inv); w1.y = pk2(O1[e4 * 4 + 2] * inv, O1[e4 * 4 + 3] * inv); \
                if (amode == 0) { *(u32x2*)(op + e4 * 8) = w0; *(u32x2*)(op + 32 + e4 * 8) = w1; } else { asm volatile("" :: "v"(w0), "v"(w1)); } } } while (0)
        ATT_OUT(qrowA, lA, oA0, oA1);
        ATT_OUT(qrowB, lB, oB0, oB1);
#undef ATT_OUT
    }
}

#define XB_TMO      128
#define XB_XCNT(j)  (256  + 64 * (j))
#define XB_XSUB(j)  (1280 + 64 * (j))
#define XB_XGEN(j)  (2304 + 64 * (j))
#define XB_TOP      3328
#define XB_TOPGEN   3392
#define XCD_BAR_WORDS 3456
#define XB_SPIN_CAP (1u << 18)
__device__ __forceinline__ unsigned xb_ld(unsigned* p)              { return __hip_atomic_load(p, __ATOMIC_RELAXED, __HIP_MEMORY_SCOPE_AGENT); }
__device__ __forceinline__ unsigned xb_add(unsigned* p, unsigned v) { return __hip_atomic_fetch_add(p, v, __ATOMIC_RELAXED, __HIP_MEMORY_SCOPE_AGENT); }
__device__ __forceinline__ unsigned xb_xcc_id() { return (unsigned)__builtin_amdgcn_s_getreg((3 << 11) | 20) & 0xFu; }
#define XB_SPIN(cond, bar) do { unsigned _sp = 0; while (cond) { __builtin_amdgcn_s_sleep(1); \
    if ((++_sp & 255u) == 0u) { if (xb_ld(&(bar)[XB_TMO])) break; if (_sp > XB_SPIN_CAP) { atomicAdd(&(bar)[XB_TMO], 1u); break; } } } } while (0)
struct XcdBarrier { unsigned* bar; unsigned x; volatile LAS unsigned* st; };
__device__ __forceinline__ XcdBarrier xcd_barrier_post(unsigned* bar, volatile LAS unsigned* st) {
    XcdBarrier b; b.bar = bar; b.x = xb_xcc_id(); b.st = st;
    if (threadIdx.x == 0) (void)xb_add(&bar[XB_XCNT(b.x)], 1u);
    return b;
}
__device__ __forceinline__ void xcd_barrier_complete(unsigned* bar, unsigned x, unsigned& nloc, unsigned& nx) {
    const unsigned G = gridDim.x * gridDim.y * gridDim.z;
    unsigned sum, cnt, mine, sp = 0u;
    for (;;) {
        sum = 0u; cnt = 0u; mine = 0u;
#pragma unroll
        for (unsigned j = 0; j < 16; ++j) { const unsigned c = xb_ld(&bar[XB_XCNT(j)]); sum += c; cnt += (c > 0u) ? 1u : 0u; mine = (j == x) ? c : mine; }
        if (sum == G) break;
        __builtin_amdgcn_s_sleep(1);
        if ((++sp & 255u) == 0u) { if (xb_ld(&bar[XB_TMO])) break; if (sp > XB_SPIN_CAP) { atomicAdd(&bar[XB_TMO], 1u); break; } }
    }
    nloc = mine > 0u ? mine : 1u; nx = cnt > 0u ? cnt : 1u;
}
__device__ __forceinline__ void xcd_barrier(const XcdBarrier& b) {
    asm volatile("s_waitcnt vmcnt(0)" ::: "memory");
    __syncthreads();
    if (threadIdx.x == 0) {
        unsigned* bar = b.bar;
        __builtin_amdgcn_s_waitcnt(0);
        unsigned nloc = b.st[0], nx = b.st[1];
        if (nloc == 0u) { xcd_barrier_complete(bar, b.x, nloc, nx); b.st[0] = nloc; b.st[1] = nx; }
        const unsigned old = xb_add(&bar[XB_XSUB(b.x)], 1u);
        const unsigned gen = old / nloc;
        if (old + 1u == (gen + 1u) * nloc) {
            __builtin_amdgcn_fence(__ATOMIC_RELEASE, "agent");
            asm volatile("s_waitcnt vmcnt(0)" ::: "memory");
            const unsigned og = xb_add(&bar[XB_TOP], 1u);
            const unsigned tg = og / nx;
            if (og + 1u == (tg + 1u) * nx) xb_add(&bar[XB_TOPGEN], 1u);
            else XB_SPIN(xb_ld(&bar[XB_TOPGEN]) == tg, bar);
            __builtin_amdgcn_fence(__ATOMIC_ACQUIRE, "agent");
            xb_add(&bar[XB_XGEN(b.x)], 1u);
            asm volatile("s_waitcnt vmcnt(0)" ::: "memory");
        } else {
            XB_SPIN(xb_ld(&bar[XB_XGEN(b.x)]) == gen, bar);
            __builtin_amdgcn_fence(__ATOMIC_ACQUIRE, "agent");
            asm volatile("s_waitcnt vmcnt(0)" ::: "memory");
        }
    }
    __syncthreads();
}

constexpr int LDS_BYTES = LDS_BYTES_ALL; static_assert(ATT_BIAS_BYTES + 4 * ATT_WSCR + 64 <= LDS_CTL_OFF && STAGE_BYTES <= LDS_CTL_OFF, "LDS");
__global__ void __launch_bounds__(NTHREADS, 2) fwd_kernel(Params P) {
    extern __shared__ __attribute__((aligned(16))) unsigned char lds_raw[];
    LAS unsigned char* lds = (LAS unsigned char*)lds_raw;
    (void)P;
#ifdef CODE_PREFETCH
    {
        const char* pcb = (const char*)((unsigned long long)__builtin_amdgcn_s_getpc() & ~0xFFull);
        u32x4 acc = (u32x4){0u, 0u, 0u, 0u};
        for (int off = (int)threadIdx.x * 16; off < CODE_PREFETCH; off += NTHREADS * 16) { const u32x4 v = *(const u32x4*)(pcb + off); acc.x ^= v.x; acc.y ^= v.y; acc.z ^= v.z; acc.w ^= v.w; }
        if ((acc.x ^ acc.y ^ acc.z ^ acc.w) == 0x9e3779b9u && threadIdx.x == 12345u) ((volatile LAS unsigned*)lds)[0] = acc.x;
    }
#endif
    volatile LAS unsigned* bst = (volatile LAS unsigned*)(lds + LDS_CTL_OFF);
    if (threadIdx.x < 4) bst[threadIdx.x] = 0u;
    __syncthreads();
    { KPtr kp = kp_fresh(); (void)xcd_barrier_post((unsigned*)(kp->ws + O_CTL), bst); }
#ifndef REPEAT_MASK
#define REPEAT_MASK 0
#endif
#ifndef DRY_MASK
#define DRY_MASK 0
#endif
#ifndef ZS_MASK
#define ZS_MASK 0
#endif
#ifndef EXTRA_SYNCS
#define EXTRA_SYNCS 0
#endif
#ifdef AMP_MASK
    long long t0amp = wall_clock64();
#endif
#pragma unroll 1
    for (int ph = 0; ph < NPH; ++ph) {
      const int reps = (((REPEAT_MASK | DRY_MASK | ZS_MASK) >> ph) & 1) ? 2 : 1;
#pragma unroll 1
      for (int rep = 0; rep < reps; ++rep) {
#ifdef REP_BARRIER
        if (rep > 0) { KPtr kp = kp_fresh(); XcdBarrier xb; xb.bar = (unsigned*)(kp->ws + O_CTL); xb.x = xb_xcc_id(); xb.st = (volatile LAS unsigned*)(lds + LDS_CTL_OFF); xcd_barrier(xb); }
#endif
        if (ph == PH_PRO) {
#ifndef NO_PRO
            prologue_phase(kp_fresh(), lds);
#endif
        }
        else if (ph == PH_MIX) {
#ifndef NO_ROW
            mix_pass(kp_fresh());
#endif
        }
        else if (ph == PH_SCAN) {
#ifndef NO_SCAN
            scan_phase(kp_fresh(), lds);
#endif
        }
        else if (ph == PH_POST) {
#ifndef NO_ROW
            post_pass(kp_fresh());
#endif
        }
        else if (ph == PH_ATTN) {
#ifndef NO_ATTN
            vt_build(kp_fresh(), lds);
            { KPtr kp = kp_fresh(); XcdBarrier xb; xb.bar = (unsigned*)(kp->ws + O_CTL); xb.x = xb_xcc_id(); xb.st = (volatile LAS unsigned*)(lds + LDS_CTL_OFF); xcd_barrier(xb); }
            attn_phase(kp_fresh(), lds);
#endif
        }
        else if (ph == PH_FINAL) {
#ifndef NO_ROW
            final_pass(kp_fresh());
#endif
        }
        else {
#ifndef NO_GEMM
#pragma unroll 1
            for (int pass2 = 0; pass2 < 2; ++pass2) {
                KPtr kp = kp_fresh();
                if (pass2) {
                    if (!(ph == PH_F2I1 && gdim_fresh() == 256 && bid_fresh() >= 252)) break;
                    if (threadIdx.x < 64) {
                        unsigned* dep = (unsigned*)(kp->ws + O_CTL) + CW_DEP + (20 + ph) * 64; unsigned sp = 0;
                        while ((unsigned)__builtin_amdgcn_readfirstlane(__hip_atomic_load(dep, __ATOMIC_RELAXED, __HIP_MEMORY_SCOPE_AGENT)) < 4u) { __builtin_amdgcn_s_sleep(2); if (++sp > (1u << 22)) break; }
                        __builtin_amdgcn_fence(__ATOMIC_ACQUIRE, "agent");
                    }
                    __syncthreads();
                }
                gemm_phase(kp->ws, kp->out, lds, ph, (rep == 0 && ((DRY_MASK >> ph) & 1)) ? 1 : ((rep == 0 && ((ZS_MASK >> ph) & 1)) ? 2 : 0), pass2);
            }
#endif
        }
      }
        if (ph + 1 < NPH) { KPtr kp = kp_fresh(); XcdBarrier xb; xb.bar = (unsigned*)(kp->ws + O_CTL); xb.x = xb_xcc_id(); xb.st = (volatile LAS unsigned*)(lds + LDS_CTL_OFF); xcd_barrier(xb); }
#ifdef AMP_MASK
        if (((AMP_MASK >> ph) & 1) && bid_fresh() == 0) { const long long t1 = wall_clock64(); const long long tend = t1 + (long long)AMP_K * (t1 - t0amp); while (wall_clock64() < tend) __builtin_amdgcn_s_sleep(32); }
        t0amp = wall_clock64();
#endif
    }
}

extern "C" void kernel_launch(void* const* d_in, const int* in_sizes, int n_in, void* d_out, int out_size, void* d_ws, size_t ws_size, hipStream_t stream) {
    static int grid_blocks = 0;
    if (grid_blocks == 0) {
        if (n_in != 36 || ws_size < WS_END) { fprintf(stderr, "kernel_launch: unexpected n_in %d or ws_size %zu (< %zu)\n", n_in, ws_size, (size_t)WS_END); grid_blocks = -1; return; }
        int dev = 0, cus = 0, per_cu = 0;
        hipGetDevice(&dev);
        hipDeviceGetAttribute(&cus, hipDeviceAttributeMultiprocessorCount, dev);
        hipFuncSetAttribute((const void*)fwd_kernel, hipFuncAttributeMaxDynamicSharedMemorySize, LDS_BYTES);
        hipOccupancyMaxActiveBlocksPerMultiprocessor(&per_cu, (const void*)fwd_kernel, NTHREADS, LDS_BYTES);
        if (per_cu < 1) { fprintf(stderr, "kernel_launch: occupancy query says %d blocks per CU\n", per_cu); grid_blocks = -1; return; }
        grid_blocks = cus;
    }
    if (grid_blocks < 0) return;
    if (hipMemsetAsync((char*)d_ws + O_CTL, 0, CTL_BYTES, stream) != hipSuccess) { fprintf(stderr, "kernel_launch: memset failed\n"); return; }
    Params p{};
    for (int i = 0; i < 36; ++i) p.in[i] = (const float*)d_in[i];
    p.out = (float*)d_out; p.ws = (unsigned char*)d_ws;
    void* args[] = {&p};
    hipError_t e = hipLaunchCooperativeKernel((const void*)fwd_kernel, dim3(grid_blocks), dim3(NTHREADS), args, LDS_BYTES, stream);
    if (e != hipSuccess) fprintf(stderr, "cooperative launch failed: %s (grid %d)\n", hipGetErrorString(e), grid_blocks);
}
```

```cpp
#include <hip/hip_runtime.h>
#include <cstdio>
#include <cstdint>

#define LAS __attribute__((address_space(3)))
typedef unsigned short bf16_t;
typedef short bf16x8 __attribute__((ext_vector_type(8)));
typedef float f32x4 __attribute__((ext_vector_type(4)));
typedef float f32x2 __attribute__((ext_vector_type(2)));
typedef float f32x16 __attribute__((ext_vector_type(16)));
typedef unsigned u32x4 __attribute__((ext_vector_type(4)));
typedef unsigned u32x2 __attribute__((ext_vector_type(2)));
typedef __bf16 bf16x2_t __attribute__((ext_vector_type(2)));

constexpr int D = 1024, FF = 2816, MP = 16384, MS = 256, M = MP + MS, TP = 4096, TS = 8;
constexpr int NTHREADS = 512;
constexpr float RMS_EPS = 1e-6f;
constexpr size_t O_YP = 0, O_YS = 16777216, O_WKVP = 17039360, O_SHP = 17301504, O_KVP = 17305600, O_WKVS = 21499904, O_SHS = 23597056, O_KVS = 23629824;
constexpr size_t SL = (size_t)M * 1024 * 2;
constexpr size_t W_F1I = 0;
constexpr size_t W_F2I = W_F1I + 2 * (size_t)5632 * 1024 * 2;
constexpr size_t W_F1O = W_F2I + 2 * (size_t)5632 * 1024 * 2;
constexpr size_t W_F2O = W_F1O + 2 * (size_t)1024 * 2816 * 2;
constexpr size_t W_PEG = W_F2O + 2 * (size_t)1024 * 2816 * 2;
constexpr size_t W_PEP = W_PEG + 2 * (size_t)1024 * 1024 * 2;
constexpr size_t W_RKV = W_PEP + 2 * (size_t)1024 * 256 * 2;
constexpr size_t W_L1 = W_RKV + (size_t)3072 * 1024 * 2;
constexpr size_t W_L2W = W_L1 + (size_t)768 * 1024 * 2;
constexpr size_t W_L2A = W_L2W + (size_t)1024 * 128 * 2;
constexpr size_t W_L2G = W_L2A + (size_t)1024 * 128 * 2;
constexpr size_t W_RWO = W_L2G + (size_t)1024 * 256 * 2;
constexpr size_t W_Q = W_RWO + (size_t)1024 * 1024 * 2;
constexpr size_t W_KV = W_Q + (size_t)3072 * 1024 * 2;
constexpr size_t W_AO = W_KV + (size_t)512 * 1024 * 2;
constexpr size_t W_END = W_AO + (size_t)1024 * 1024 * 2;
constexpr size_t O_HB0 = (W_END + 4095) & ~(size_t)4095;
constexpr size_t O_HB1 = O_HB0 + SL;
constexpr size_t O_SSQ0 = O_HB1 + SL;
constexpr size_t O_SSQ1 = O_SSQ0 + (size_t)M * 16 * 4;
constexpr size_t O_PB = O_SSQ1 + (size_t)M * 16 * 4;
constexpr size_t O_R2 = O_PB + 2 * (size_t)M * 256 * 2;
constexpr size_t R2_BYTES = (size_t)128 << 20;
constexpr size_t O_R4 = O_R2 + R2_BYTES;
constexpr size_t O_CTL = O_R4 + 6 * SL;
constexpr size_t CTL_BYTES = 65536;
constexpr size_t O_PAR = O_CTL + 32768;
constexpr size_t O_BIAS = O_CTL + CTL_BYTES;
constexpr size_t WS_END = O_BIAS + 98304;
constexpr size_t O_ACT = O_R2;
constexpr size_t O_RKVB = O_R2;
constexpr size_t O_MW = O_R2 + (size_t)M * 3072 * 2;
constexpr size_t O_MA = O_MW + (size_t)M * 128 * 2;
constexpr size_t O_MG = O_MA + (size_t)M * 128 * 2;
constexpr size_t O_YG = O_R2;
static_assert(O_MG + (size_t)M * 256 * 2 <= O_R2 + R2_BYTES, "R2");
constexpr size_t O_WL = O_R4, O_AL = O_R4 + SL, O_GG = O_R4 + 2 * SL, O_Y = O_R4 + 3 * SL, O_BON = O_R4 + 4 * SL, O_PP = O_R4 + 5 * SL;
constexpr size_t O_Q = O_R4, O_ATT = O_R4 + 3 * SL, O_KB = O_R4 + 4 * SL, O_VT = O_KB + (size_t)MP * 256 * 2;
constexpr size_t O_VB = O_R2 + ((size_t)96 << 20);
static_assert(O_VB >= O_ACT + (size_t)M * FF * 2 && O_VB + (size_t)MP * 256 * 2 <= O_R2 + R2_BYTES, "VB");
constexpr size_t VT_COPY = (size_t)MP * 256;
constexpr size_t O_KT = O_R2 + ((size_t)104 << 20);
static_assert(O_KT >= O_VB + (size_t)MP * 256 * 2 && O_KT + 3 * VT_COPY * 2 <= O_R2 + R2_BYTES, "KT");
static_assert(O_VT + 3 * VT_COPY * 2 <= O_R4 + 5 * SL, "R4 slot 4");

struct Params { const float* in[36]; float* out; unsigned char* ws; };
typedef const Params __attribute__((address_space(4)))* KPtr;
__device__ __forceinline__ int tid_fresh() { int t = threadIdx.x; asm volatile("" : "+v"(t)); return t; }
__device__ __forceinline__ int bid_fresh() { int t = blockIdx.x; asm volatile("" : "+s"(t)); return t; }
__device__ __forceinline__ int gdim_fresh() { int t = gridDim.x; asm volatile("" : "+s"(t)); return t; }
__device__ __forceinline__ KPtr kp_fresh() { KPtr p = (KPtr)__builtin_amdgcn_kernarg_segment_ptr(); asm volatile("" : "+s"(p)); return p; }

__device__ __forceinline__ unsigned pk2(float lo, float hi) { f32x2 v = {lo, hi}; bf16x2_t b = __builtin_convertvector(v, bf16x2_t); return __builtin_bit_cast(unsigned, b); }
__device__ __forceinline__ float bf2f(unsigned short h) { return __builtin_bit_cast(float, (unsigned)h << 16); }
__device__ __forceinline__ float bflo(unsigned w) { return __builtin_bit_cast(float, w << 16); }
__device__ __forceinline__ float bfhi(unsigned w) { return __builtin_bit_cast(float, w & 0xffff0000u); }
template <int CTRL> __device__ __forceinline__ float dpp_mov(float x) { return __builtin_bit_cast(float, __builtin_amdgcn_update_dpp(0, __builtin_bit_cast(int, x), CTRL, 0xF, 0xF, true)); }
__device__ __forceinline__ float row_sum16(float x) {
    x += dpp_mov<0x128>(x); x += dpp_mov<0x124>(x); x += dpp_mov<0x122>(x); x += dpp_mov<0x121>(x); return x;
}
__device__ __forceinline__ float wave_sum(float v) {
#pragma unroll
    for (int o = 1; o < 64; o <<= 1) v += __shfl_xor(v, o);
    return v;
}
__device__ __forceinline__ float rstd_of(const float* ssq, int row) {
    const f32x4* p = (const f32x4*)(ssq + (size_t)row * 16);
    const f32x4 a = p[0], b = p[1], c = p[2], d = p[3];
    const float s = ((a.x + a.y) + (a.z + a.w)) + ((b.x + b.y) + (b.z + b.w)) + ((c.x + c.y) + (c.z + c.w)) + ((d.x + d.y) + (d.z + d.w));
    return __builtin_amdgcn_rsqf(s * (1.0f / 1024.0f) + RMS_EPS);
}
struct F8 { float v[8]; };
__device__ __forceinline__ F8 unpack8(u32x4 w) { F8 r; r.v[0] = bflo(w.x); r.v[1] = bfhi(w.x); r.v[2] = bflo(w.y); r.v[3] = bfhi(w.y); r.v[4] = bflo(w.z); r.v[5] = bfhi(w.z); r.v[6] = bflo(w.w); r.v[7] = bfhi(w.w); return r; }
__device__ __forceinline__ u32x4 pack8(const F8& f) { u32x4 w; w.x = pk2(f.v[0], f.v[1]); w.y = pk2(f.v[2], f.v[3]); w.z = pk2(f.v[4], f.v[5]); w.w = pk2(f.v[6], f.v[7]); return w; }
__device__ __forceinline__ F8 load8f(const float* p) { const f32x4 a = *(const f32x4*)p, b = *(const f32x4*)(p + 4); F8 r; r.v[0] = a.x; r.v[1] = a.y; r.v[2] = a.z; r.v[3] = a.w; r.v[4] = b.x; r.v[5] = b.y; r.v[6] = b.z; r.v[7] = b.w; return r; }
__device__ __forceinline__ float row_sum8(float x) {
    x += dpp_mov<0xB1>(x); x += dpp_mov<0x4E>(x); x += dpp_mov<0x141>(x); return x;
}
__device__ __forceinline__ float sigmoidf_(float x) { return __builtin_amdgcn_rcpf(1.0f + __expf(-x)); }

constexpr int LDS_BYTES_ALL = 147456, LDS_CTL_OFF = LDS_BYTES_ALL - 2048;
constexpr int BM = 256, BK = 64, HALF = 128, HTB = HALF * BK * 2, STAGE_BYTES = 8 * HTB, NXCD = 8, WGM = 8;
__host__ __device__ __forceinline__ int lds_byte(int r, int c) { const int st = (r >> 4) * 2 + (c >> 5), rr = r & 15, cc = c & 31, ob = rr * 64 + cc * 2; return st * 1024 + (ob ^ (((ob >> 9) & 1) << 5)); }
__host__ __device__ __forceinline__ void stage_rc(int b, int& R, int& C) { const int st = b / 1024, sb = b % 1024, swz = sb ^ (((sb >> 9) & 1) << 5); R = (st >> 1) * 16 + swz / 64; C = (st & 1) * 32 + (swz % 64) / 2; }

enum { EPI_SWIGLU = 0, EPI_RESID = 1, EPI_PE = 2, EPI_BF16 = 3, EPI_KV = 4 };
struct Unit { const char* A; const char* B; int pitchA, pitchB, nt, si, pm, pn, wait, eph; };
struct Epi { int epi; void* o0; const float* ssq_in; float* ssq_out; const bf16_t* pbuf; float scale; int opitch, ocol0, ncols, act; };

enum { PH_PRO = 0, PH_F1I0, PH_F1O0, PH_MIX, PH_RKV, PH_L2, PH_SCAN, PH_POST, PH_RWO, PH_F2I0, PH_F2O0, PH_PE0,
       PH_F1I1, PH_F1O1, PH_QKV, PH_ATTN, PH_AO, PH_F2I1, PH_F2O1, PH_PE1, PH_FINAL, NPH };

__device__ __forceinline__ bool get_gemm(unsigned char* ws, int ph, int si, Unit& u, int& nN) {
    size_t a = 0, b = 0; int pA = 2048, pB = 2048, nt = 16; nN = 4;
    switch (ph) {
    case PH_F1I0: case PH_F2I0: case PH_F1I1: case PH_F2I1: {
        if (si > 0) return false;
        const int l = (ph == PH_F1I1 || ph == PH_F2I1) ? 1 : 0; const bool f2 = (ph == PH_F2I0 || ph == PH_F2I1);
        a = O_HB0; b = (f2 ? W_F2I : W_F1I) + (size_t)l * 5632 * 1024 * 2; nN = 22; break; }
    case PH_F1O0: case PH_F1O1: {
        if (si > 0) return false;
        a = O_ACT; b = W_F1O + (size_t)(ph == PH_F1O1 ? 1 : 0) * 1024 * 2816 * 2; pA = 5632; pB = 5632; nt = 44; break; }
    case PH_F2O0: case PH_F2O1: {
        const int l = (ph == PH_F2O1) ? 1 : 0;
        if (si == 0) { a = O_ACT; b = W_F2O + (size_t)l * 1024 * 2816 * 2; pA = 5632; pB = 5632; nt = 44; }
        else if (si == 1) { a = O_PB + (size_t)l * M * 256 * 2; b = W_PEP + (size_t)l * 1024 * 256 * 2; pA = 512; pB = 512; nt = 4; }
        else return false;
        break; }
    case PH_RKV: {
        if (si < 3) { const int xi = (si == 0) ? 0 : (si == 1 ? 2 : 3); a = O_R4 + (size_t)xi * SL; b = W_RKV + (size_t)si * 1024 * 1024 * 2; }
        else if (si < 6) { const int j = si - 3; const int xi = (j == 0) ? 1 : (j == 1 ? 4 : 5); a = O_R4 + (size_t)xi * SL; b = W_L1 + (size_t)j * 256 * 1024 * 2; nN = 1; }
        else return false;
        break; }
    case PH_L2: {
        if (si == 0) { a = O_MG; b = W_L2G; pA = 512; pB = 512; nt = 4; }
        else if (si == 1) { a = O_MW; b = W_L2W; pA = 256; pB = 256; nt = 2; }
        else if (si == 2) { a = O_MA; b = W_L2A; pA = 256; pB = 256; nt = 2; }
        else return false;
        break; }
    case PH_RWO: if (si > 0) return false; a = O_YG; b = W_RWO; break;
    case PH_AO: if (si > 0) return false; a = O_ATT; b = W_AO; break;
    case PH_PE0: case PH_PE1: if (si > 0) return false; a = O_HB1; b = W_PEG + (size_t)(ph == PH_PE1 ? 1 : 0) * 1024 * 1024 * 2; break;
    case PH_QKV: {
        if (si == 0) { a = O_HB1; b = W_Q; nN = 12; }
        else if (si == 1) { a = O_HB0; b = W_KV; nN = 2; }
        else return false;
        break; }
    default: return false;
    }
    u.A = (const char*)(ws + a); u.B = (const char*)(ws + b); u.pitchA = pA; u.pitchB = pB; u.nt = nt; u.si = si; u.wait = 0; u.eph = ph; return true;
}
__device__ __forceinline__ void get_epi(unsigned char* ws, int ph, int si, Epi& s) {
    s.epi = EPI_BF16; s.o0 = nullptr; s.ssq_in = nullptr; s.ssq_out = nullptr; s.pbuf = nullptr; s.scale = 1.f; s.opitch = 1024; s.ocol0 = 0; s.ncols = 1024; s.act = 0;
    const float* ssq0 = (const float*)(ws + O_SSQ0); const float* ssq1 = (const float*)(ws + O_SSQ1);
    switch (ph) {
    case PH_F1I0: case PH_F2I0: case PH_F1I1: case PH_F2I1: s.epi = EPI_SWIGLU; s.o0 = ws + O_ACT; s.ssq_in = ssq0; break;
    case PH_F1O0: case PH_F1O1: s.epi = EPI_RESID; s.scale = 0.5f; s.o0 = ws + O_HB1; s.ssq_out = (float*)(ws + O_SSQ1); break;
    case PH_F2O0: case PH_F2O1:
        if (si == 0) { s.epi = EPI_RESID; s.scale = 0.5f; s.o0 = ws + O_HB1; s.ssq_out = (float*)(ws + O_SSQ1); }
        else { s.o0 = ws + O_PP; }
        break;
    case PH_RKV:
        if (si < 3) { s.o0 = ws + O_RKVB; s.opitch = 3072; s.ocol0 = si * 1024; }
        else { const int j = si - 3; s.o0 = ws + (j == 0 ? O_MW : (j == 1 ? O_MA : O_MG)); s.opitch = (j == 2) ? 256 : 128; s.ncols = s.opitch; s.act = (j == 0) ? 1 : (j == 1 ? 0 : 2); }
        break;
    case PH_L2: s.o0 = ws + (si == 0 ? O_GG : (si == 1 ? O_WL : O_AL)); s.act = (si == 0) ? 0 : (si == 1 ? 3 : 4); break;
    case PH_RWO: case PH_AO: s.epi = EPI_RESID; s.o0 = ws + O_HB0; s.ssq_out = (float*)(ws + O_SSQ0); break;
    case PH_PE0: case PH_PE1: s.epi = EPI_PE; s.o0 = ws + O_HB0; s.ssq_in = ssq1; s.ssq_out = (float*)(ws + O_SSQ0); s.pbuf = (const bf16_t*)(ws + O_PP); break;
    case PH_QKV:
        if (si == 0) { s.o0 = ws + O_Q; s.opitch = 3072; s.ncols = 3072; s.ssq_in = ssq1; }
        else { s.epi = EPI_KV; s.ssq_in = ssq0; }
        break;
    default: break;
    }
}

__device__ __forceinline__ void decode_tile(int L, int nM, int nN, int& pm, int& pn) {
    const int nwg = nM * nN;
    int wgid = L; { const int q = nwg / NXCD, r = nwg % NXCD, xcd = wgid % NXCD, off = wgid / NXCD; wgid = (xcd < r ? xcd * (q + 1) : r * (q + 1) + (xcd - r) * q) + off; }
    const int nig = WGM * nN; int gid;
    switch (nN) { case 22: gid = wgid / (WGM * 22); break; case 12: gid = wgid / (WGM * 12); break; case 4: gid = wgid / (WGM * 4); break; case 2: gid = wgid / (WGM * 2); break; case 1: gid = wgid / WGM; break; default: gid = wgid / nig; break; }
    const int fm = gid * WGM, gsz = (nM - fm) < WGM ? (nM - fm) : WGM, rem = wgid - gid * nig;
    if (gsz == WGM) { pm = fm + (rem & (WGM - 1)); pn = rem >> 3; } else { pm = fm + (rem % gsz); pn = rem / gsz; }
}
constexpr int CW_DEP = 4096;
__device__ __forceinline__ bool is_wi(int ph) { return ph == PH_F1I0 || ph == PH_F2I0 || ph == PH_F1I1 || ph == PH_F2I1; }
__device__ __forceinline__ bool is_wo(int ph) { return ph == PH_F1O0 || ph == PH_F2O0 || ph == PH_F1O1 || ph == PH_F2O1; }
__device__ __forceinline__ bool next_unit(unsigned char* ws, int ph, int i, int G, int c, Unit& u, int pass2) {
    int nN;
    if (pass2) {
        if (G == 256 && ph == PH_F2I1 && c >= 252 && i == 0) { get_gemm(ws, PH_PE1, 0, u, nN); u.pm = 64; u.pn = c - 252; u.wait = 8; u.eph = PH_PE1; return true; }
        return false;
    }
    if (G == 256 && is_wi(ph)) {
        const int pre = (ph == PH_F2I0) ? PH_RWO : (ph == PH_F1I1 ? PH_PE0 : (ph == PH_F2I1 ? PH_AO : -1));
        int L; int wt = 0;
        if (c >= 252) {
            if (i < 2) L = i * 256 + c;
            else if (i == 2) { get_gemm(ws, ph + 1, 0, u, nN); u.pm = 64; u.pn = c - 252; u.wait = 1; u.eph = ph + 1; return true; }
            else return false;
        } else if (pre >= 0 && c >= 248) {
            if (i == 0) { get_gemm(ws, pre, 0, u, nN); u.pm = 64; u.pn = c - 248; u.eph = pre; return true; }
            L = (i - 1) * 256 + c;
            if (L >= 1430) return false;
        } else {
            L = i * 256 + c;
            if (pre >= 0 && c < 22) { L = (i + 1) * 256 + c; if (i == 5 && c < 4) L = 2 * 256 + 252 + c; }
            else if (pre >= 0 && c >= 160 && c < 182) { if (i == 1) { L = c - 160; wt = 2; } else if (i > 1) L = (i - 1) * 256 + c; }
            if (L >= 1430) {
                if (i == 5 && c >= 150 && c < 158) { const int k = c - 150; L = (3 + (k >> 2)) * 256 + 252 + (k & 3); }
                else if (pre < 0 && i == 5 && c >= 158 && c < 162) L = 2 * 256 + 252 + (c - 158);
                else if (pre >= 0 && (i == 5 || i == 6) && c >= 158 && c < 248 && !(c >= 160 && c < 182)) {
                    const int e = c < 160 ? c - 158 : c - 180, k = e * 2 + (i - 5);
                    if (k >= 130) return false;
                    const int fo = (ph == PH_F1I1) ? PH_F2O1 : (ph == PH_F2I1 ? PH_F2O1 : PH_F2O0);
                    const int idx = (ph == PH_F2I1) ? 126 + k : (ph == PH_F1I1 && k >= 126 ? k + 130 : k);
                    get_gemm(ws, fo, 1, u, nN); u.eph = fo; u.pm = idx >> 2; u.pn = idx & 3;
                    if (idx >= 256) u.wait = 2;
                    return true;
                } else return false;
            }
        }
        get_gemm(ws, ph, 0, u, nN);
        if (L < 22) { u.pm = 64; u.pn = L; u.wait = wt; } else decode_tile(L - 22, 64, 22, u.pm, u.pn);
        return true;
    }
    if (G == 256 && ph == PH_QKV) {
        int iq = i;
        if (c >= 126) { if (i == 0) { get_gemm(ws, ph, 1, u, nN); decode_tile(c - 126, 65, 2, u.pm, u.pn); return true; } iq = i - 1; }
        const int L = iq * 256 + c;
        if (iq > 3 || L >= 780) return false;
        get_gemm(ws, ph, 0, u, nN); decode_tile(L, 65, 12, u.pm, u.pn); return true;
    }
    int L = i * G + c;
    for (int si = 0; si < 6; ++si) {
        if (!get_gemm(ws, ph, si, u, nN)) return false;
        const int nM = (G == 256 && (is_wo(ph) || ph == PH_RWO || ph == PH_PE0 || ph == PH_PE1 || ph == PH_AO) && si == 0) ? 64 : M / BM;
        if (G == 256 && (ph == PH_F2O0 || ph == PH_F2O1) && si == 1) {
            const int first = (ph == PH_F2O0) ? 130 : 260, cnt = 260 - first;
            if (L < cnt) { const int idx = first + L; u.pm = idx >> 2; u.pn = idx & 3; return true; }
            L -= cnt; continue;
        }
        const int nwg = nM * nN;
        if (L < nwg) { decode_tile(L, nM, nN, u.pm, u.pn); return true; }
        L -= nwg;
    }
    return false;
}

template <int ACT>
__device__ __forceinline__ void epi_act(unsigned char* ws, f32x4 (&acc)[2][2][4][2], const Epi& s, const Unit& u, bf16_t* ob, int row0, int wc, int fq) {
#pragma unroll
    for (int bj = 0; bj < 2; ++bj) {
        const int lc = u.pn * BM + bj * HALF + wc * 32 + fq * 8;
        if (lc >= s.ncols) continue;
        float pa_[8], pb_[8];
#pragma unroll
        for (int q8 = 0; q8 < 8; ++q8) { pa_[q8] = 0.f; pb_[q8] = 0.f; }
        if (ACT >= 3) {
            const float* par = (const float*)(ws + O_PAR) + (ACT == 3 ? 0 : 2048) + lc;
            const f32x4 x0 = *(const f32x4*)par, x1 = *(const f32x4*)(par + 4);
            pa_[0] = x0.x; pa_[1] = x0.y; pa_[2] = x0.z; pa_[3] = x0.w; pa_[4] = x1.x; pa_[5] = x1.y; pa_[6] = x1.z; pa_[7] = x1.w;
            if (ACT == 3) { const f32x4 y0 = *(const f32x4*)(par + 1024), y1 = *(const f32x4*)(par + 1028);
                pb_[0] = y0.x; pb_[1] = y0.y; pb_[2] = y0.z; pb_[3] = y0.w; pb_[4] = y1.x; pb_[5] = y1.y; pb_[6] = y1.z; pb_[7] = y1.w; }
        }
#pragma unroll
        for (int ai = 0; ai < 2; ++ai)
#pragma unroll
            for (int m = 0; m < 4; ++m) {
                const int row = row0 + ai * HALF + m * 16;
                float o[8];
#pragma unroll
                for (int n = 0; n < 2; ++n)
#pragma unroll
                    for (int e = 0; e < 4; ++e) {
                        float v = acc[ai][bj][m][n][e];
                        if (ACT == 1) { const float t = __expf(2.f * v); v = 1.f - 2.f * __builtin_amdgcn_rcpf(t + 1.f); }
                        else if (ACT == 2) v = sigmoidf_(v);
                        else if (ACT == 3) v = sigmoidf_(v + pa_[n * 4 + e]) - pb_[n * 4 + e];
                        else v = sigmoidf_(v + pa_[n * 4 + e]);
                        o[n * 4 + e] = v;
                    }
                u32x4 w; w.x = pk2(o[0], o[1]); w.y = pk2(o[2], o[3]); w.z = pk2(o[4], o[5]); w.w = pk2(o[6], o[7]);
                *(u32x4*)(ob + (size_t)row * s.opitch + s.ocol0 + lc) = w;
            }
    }
}

template <bool PE>
__device__ __forceinline__ void epi_resid(unsigned char* ws, f32x4 (&acc)[2][2][4][2], const Epi& s, const Unit& u, const LAS float* rtab, int row0, int lrow0, int wc, int fq, float zs) {
    bf16_t* hb = (bf16_t*)s.o0; const bf16_t* hin = (const bf16_t*)(ws + (hb == (bf16_t*)(ws + O_HB1) ? O_HB0 : O_HB1));
    const int colb = u.pn * BM + wc * 32 + fq * 8;
    const float sc = s.scale * zs;
    u32x4 hn[2], pn_[2];
#pragma unroll
    for (int bj = 0; bj < 2; ++bj) {
        const size_t off = (size_t)row0 * D + colb + bj * HALF;
        hn[bj] = *(const u32x4*)(hin + off); pn_[bj] = (u32x4){0u, 0u, 0u, 0u};
        if (PE) pn_[bj] = *(const u32x4*)(s.pbuf + off);
    }
#pragma unroll
    for (int g = 0; g < 8; ++g) {
        const int ai = g >> 2, m = g & 3;
        const int row = row0 + ai * HALF + m * 16;
        u32x4 hc[2], pc[2];
#pragma unroll
        for (int bj = 0; bj < 2; ++bj) { hc[bj] = hn[bj]; pc[bj] = pn_[bj]; }
        if (g < 7) {
            const int rown = row0 + ((g + 1) >> 2) * HALF + ((g + 1) & 3) * 16;
#pragma unroll
            for (int bj = 0; bj < 2; ++bj) {
                const size_t off = (size_t)rown * D + colb + bj * HALF;
                hn[bj] = *(const u32x4*)(hin + off);
                if (PE) pn_[bj] = *(const u32x4*)(s.pbuf + off);
            }
        }
        float rs = 1.f; if (PE) rs = rtab[lrow0 + ai * HALF + m * 16];
        float sq = 0.f;
#pragma unroll
        for (int bj = 0; bj < 2; ++bj) {
            const size_t off = (size_t)row * D + colb + bj * HALF;
            const unsigned hw[4] = {hc[bj].x, hc[bj].y, hc[bj].z, hc[bj].w}, pw[4] = {pc[bj].x, pc[bj].y, pc[bj].z, pc[bj].w};
            unsigned ow[4];
#pragma unroll
            for (int n = 0; n < 2; ++n) {
                const f32x4 a = acc[ai][bj][m][n];
                f32x4 h = (f32x4){bflo(hw[2 * n]), bfhi(hw[2 * n]), bflo(hw[2 * n + 1]), bfhi(hw[2 * n + 1])};
                if (PE) {
                    h.x += zs * sigmoidf_(a.x * rs) * bflo(pw[2 * n]); h.y += zs * sigmoidf_(a.y * rs) * bfhi(pw[2 * n]);
                    h.z += zs * sigmoidf_(a.z * rs) * bflo(pw[2 * n + 1]); h.w += zs * sigmoidf_(a.w * rs) * bfhi(pw[2 * n + 1]);
                } else { h = h + a * sc; }
                ow[2 * n] = pk2(h.x, h.y); ow[2 * n + 1] = pk2(h.z, h.w);
                sq += (h.x * h.x + h.y * h.y) + (h.z * h.z + h.w * h.w);
            }
            *(u32x4*)(hb + off) = (u32x4){ow[0], ow[1], ow[2], ow[3]};
        }
        sq += __shfl_xor(sq, 16); sq += __shfl_xor(sq, 32);
        if (fq == 0) s.ssq_out[(size_t)row * 16 + u.pn * 4 + wc] = sq;
    }
}

__device__ __forceinline__ void epilogue(unsigned char* ws, float* outp, int ph, f32x4 (&acc)[2][2][4][2], const Unit& u, int wr, int wc, int fr, int fq, LAS unsigned char* lds, float zs) {
    Epi s; get_epi(ws, u.eph, u.si, s);
    const LAS float* rtab = (const LAS float*)(lds + LDS_CTL_OFF + 1024);
    if (s.ssq_in) {
        const int t = threadIdx.x;
        if (t < 256) ((LAS float*)(lds + LDS_CTL_OFF + 1024))[t] = rstd_of(s.ssq_in, u.pm * BM + t);
        __syncthreads();
    }
    const int lrow0 = wr * 64 + fr;
    const int row0 = u.pm * BM + wr * 64 + fr;
    if (s.epi == EPI_SWIGLU) {
        bf16_t* act = (bf16_t*)s.o0;
        const int col = u.pn * 128 + wc * 32 + fq * 8;
#pragma unroll
        for (int ai = 0; ai < 2; ++ai)
#pragma unroll
            for (int m = 0; m < 4; ++m) {
                const int row = row0 + ai * HALF + m * 16;
                const float rs = rtab[lrow0 + ai * HALF + m * 16];
                float o[8];
#pragma unroll
                for (int n = 0; n < 2; ++n)
#pragma unroll
                    for (int e = 0; e < 4; ++e) { const float g = acc[ai][0][m][n][e] * rs, up = acc[ai][1][m][n][e] * rs; o[n * 4 + e] = g * sigmoidf_(g) * up; acc[ai][0][m][n][e] = 0.f; acc[ai][1][m][n][e] = 0.f; }
                u32x4 w; w.x = pk2(o[0], o[1]); w.y = pk2(o[2], o[3]); w.z = pk2(o[4], o[5]); w.w = pk2(o[6], o[7]);
                if (u.pm == 64) {
                    unsigned long long* p8 = (unsigned long long*)(act + (size_t)row * FF + col);
                    __hip_atomic_store(p8, ((unsigned long long)w.y << 32) | w.x, __ATOMIC_RELAXED, __HIP_MEMORY_SCOPE_AGENT);
                    __hip_atomic_store(p8 + 1, ((unsigned long long)w.w << 32) | w.z, __ATOMIC_RELAXED, __HIP_MEMORY_SCOPE_AGENT);
                } else *(u32x4*)(act + (size_t)row * FF + col) = w;
            }
        if (u.pm == 64) {
            asm volatile("s_waitcnt vmcnt(0)" ::: "memory");
            __syncthreads();
            if (threadIdx.x == 0) __hip_atomic_fetch_add((unsigned*)(ws + O_CTL) + CW_DEP + ph * 64, 1u, __ATOMIC_RELAXED, __HIP_MEMORY_SCOPE_AGENT);
        }
    } else if (s.epi == EPI_RESID || s.epi == EPI_PE) {
        if (s.epi == EPI_PE) epi_resid<true>(ws, acc, s, u, rtab, row0, lrow0, wc, fq, zs);
        else epi_resid<false>(ws, acc, s, u, rtab, row0, lrow0, wc, fq, zs);
        if (u.eph != ph && (u.wait == 0 || (u.wait == 1 && ph == PH_F2I1))) {
            asm volatile("s_waitcnt vmcnt(0)" ::: "memory");
            __syncthreads();
            if (threadIdx.x == 0) {
                __builtin_amdgcn_fence(__ATOMIC_RELEASE, "agent");
                asm volatile("s_waitcnt vmcnt(0)" ::: "memory");
                __hip_atomic_fetch_add((unsigned*)(ws + O_CTL) + CW_DEP + ((u.wait == 1 ? 20 : 32) + ph) * 64, 1u, __ATOMIC_RELAXED, __HIP_MEMORY_SCOPE_AGENT);
            }
        }
    } else if (s.epi == EPI_BF16) {
        bf16_t* ob = (bf16_t*)s.o0;
        if (s.act == 0) {
#pragma unroll
            for (int ai = 0; ai < 2; ++ai)
#pragma unroll
                for (int m = 0; m < 4; ++m) {
                    const int row = row0 + ai * HALF + m * 16;
                    float rs = 1.f; if (s.ssq_in) rs = rtab[lrow0 + ai * HALF + m * 16];
#pragma unroll
                    for (int bj = 0; bj < 2; ++bj) {
                        const int lc = u.pn * BM + bj * HALF + wc * 32 + fq * 8;
                        const f32x4 v0 = acc[ai][bj][m][0] * rs, v1 = acc[ai][bj][m][1] * rs;
                        if (lc < s.ncols) {
                            u32x4 w; w.x = pk2(v0.x, v0.y); w.y = pk2(v0.z, v0.w); w.z = pk2(v1.x, v1.y); w.w = pk2(v1.z, v1.w);
                            *(u32x4*)(ob + (size_t)row * s.opitch + s.ocol0 + lc) = w;
                        }
                    }
                }
        } else if (s.act == 1) epi_act<1>(ws, acc, s, u, ob, row0, wc, fq);
        else if (s.act == 2) epi_act<2>(ws, acc, s, u, ob, row0, wc, fq);
        else if (s.act == 3) epi_act<3>(ws, acc, s, u, ob, row0, wc, fq);
        else epi_act<4>(ws, acc, s, u, ob, row0, wc, fq);
    } else {
        bf16_t* kb = (bf16_t*)(ws + O_KB); bf16_t* vt = (bf16_t*)(ws + O_VT);
#pragma unroll
        for (int ai = 0; ai < 2; ++ai)
#pragma unroll
            for (int m = 0; m < 4; ++m) {
                const int row = row0 + ai * HALF + m * 16;
                const float rs = rtab[lrow0 + ai * HALF + m * 16];
                const bool isP = row < MP; const int b = row >> 12, t = row & 4095;
                float* fo = nullptr;
                if (isP) { if (t >= 2048) fo = outp + O_KVP + ((size_t)(b * 2048 + (t - 2048)) * 512) + u.pn * 256; }
                else fo = outp + O_KVS + (size_t)(row - MP) * 512 + u.pn * 256;
#pragma unroll
                for (int bj = 0; bj < 2; ++bj) {
                    const int c = bj * HALF + wc * 32 + fq * 8;
                    const f32x4 v0 = acc[ai][bj][m][0] * rs, v1 = acc[ai][bj][m][1] * rs;
                    if (fo) { *(f32x4*)(fo + c) = v0; *(f32x4*)(fo + c + 4) = v1; }
                    if (isP) {
                        u32x4 w; w.x = pk2(v0.x, v0.y); w.y = pk2(v0.z, v0.w); w.z = pk2(v1.x, v1.y); w.w = pk2(v1.z, v1.w);
                        if (u.pn == 0) {
                            const int kvh = c >> 6, p = (c & 63) >> 3;
                            bf16_t* kt = (bf16_t*)(ws + O_KT);
#pragma unroll
                            for (int g = 0; g < 3; ++g) {
                                const int sh = 2 * g, ucls = t >> sh, cls = t & ((1 << sh) - 1);
                                *(u32x4*)(kt + (size_t)g * VT_COPY + (size_t)((((b * 4 + kvh) << sh) + cls) * (128 >> sh) + (ucls >> 5)) * 2048 + (p * 32 + (ucls & 31)) * 8) = w;
                            }
                        } else *(u32x4*)((bf16_t*)(ws + O_VB) + (size_t)row * 256 + c) = w;
                    }
                }
            }
        if (gridDim.x == 256) {
            asm volatile("s_waitcnt vmcnt(0)" ::: "memory");
            __syncthreads();
            if (threadIdx.x == 0) {
                __builtin_amdgcn_fence(__ATOMIC_RELEASE, "agent");
                asm volatile("s_waitcnt vmcnt(0)" ::: "memory");
                __hip_atomic_fetch_add((unsigned*)(ws + O_CTL) + CW_DEP + (48 + PH_QKV) * 64, 1u, __ATOMIC_RELAXED, __HIP_MEMORY_SCOPE_AGENT);
            }
        }
    }
}

template <bool FB>
__device__ __forceinline__ void gemm_phase(unsigned char* ws, float* outp, LAS unsigned char* lds, int ph, int dry, int pass2) {
    const int tid = tid_fresh(), wid = __builtin_amdgcn_readfirstlane(tid >> 6), lane = tid & 63, wr = wid >> 2, wc = wid & 3, fr = lane & 15, fq = lane >> 4;
    const int G = gdim_fresh(), cidx = bid_fresh();
    int R0, C0; stage_rc(tid * 16, R0, C0);
    const unsigned ldsw = (unsigned)wid * 1024u;
    const int aoff = lds_byte(wr * 64 + fr, fq * 8), boff = lds_byte(wc * 32 + fr, fq * 8);
    const size_t kstep = (size_t)(BK * 2);
#define PG8_SA(b, h) (((b) * 2 + (h)) * HTB)
#define PG8_SB(b, h) ((4 + (b) * 2 + (h)) * HTB)
#define PG8_STAGE(bufoff, gbase, voff, p64) do { \
        __builtin_amdgcn_global_load_lds((const unsigned*)((const char*)(gbase) + (voff)), (LAS unsigned*)(lds + (bufoff) + ldsw), 16, 0, 0); \
        __builtin_amdgcn_global_load_lds((const unsigned*)((const char*)(gbase) + (voff) + (p64)), (LAS unsigned*)(lds + (bufoff) + ldsw + 8192), 16, 0, 0); } while (0)
#define PG8_LDA(dst, b, h) do { _Pragma("unroll") for (int m = 0; m < 4; ++m) _Pragma("unroll") for (int k = 0; k < 2; ++k) dst[m][k] = *(const LAS bf16x8*)(lds + PG8_SA(b, h) + aoff + m * 2048 + k * 1024); } while (0)
#define PG8_LDB(dst, b, h) do { _Pragma("unroll") for (int n = 0; n < 2; ++n) _Pragma("unroll") for (int k = 0; k < 2; ++k) dst[n][k] = *(const LAS bf16x8*)(lds + PG8_SB(b, h) + boff + n * 2048 + k * 1024); } while (0)
#define PG8_MMA(ai, bj, At, Bt) do { __builtin_amdgcn_s_setprio(1); _Pragma("unroll") for (int m = 0; m < 4; ++m) _Pragma("unroll") for (int n = 0; n < 2; ++n) _Pragma("unroll") for (int k = 0; k < 2; ++k) \
        acc[ai][bj][m][n] = __builtin_amdgcn_mfma_f32_16x16x32_bf16(Bt[n][k], At[m][k], acc[ai][bj][m][n], 0, 0, 0); __builtin_amdgcn_s_setprio(0); } while (0)
#define PG8_WAIT_V(n) asm volatile("s_waitcnt vmcnt(" #n ")" ::: "memory")
#define PG8_WAIT_L(n) asm volatile("s_waitcnt lgkmcnt(" #n ")" ::: "memory")
#define PG8_BAR __builtin_amdgcn_s_barrier()
#define PG8_SCHED __builtin_amdgcn_sched_barrier(0)
    Unit cur, nxt; int ui = 0;
    LAS unsigned* utab = (LAS unsigned*)(lds + LDS_CTL_OFF + 128);
#ifdef BUSY_AMP
    const long long tb0 = wall_clock64();
#endif
#ifdef KL_AMP
    long long tkl = 0, tcy = 0;
#endif
#ifdef EPI_AMP
    long long tepi = 0;
#endif
#define PG8_RFL(x) ((unsigned)__builtin_amdgcn_readfirstlane((int)(x)))
#define PG8_TABREAD(u, idx, valid) do { const LAS unsigned* te_ = utab + (idx) * 12; asm volatile("" ::: "memory"); \
        const u32x4 t0_ = *(const LAS u32x4*)te_, t1_ = *(const LAS u32x4*)(te_ + 4), t2_ = *(const LAS u32x4*)(te_ + 8); \
        valid = PG8_RFL(t0_.x) != 0u; \
        u.A = (const char*)(((unsigned long long)PG8_RFL(t0_.z) << 32) | PG8_RFL(t0_.y)); u.B = (const char*)(((unsigned long long)PG8_RFL(t1_.x) << 32) | PG8_RFL(t0_.w)); \
        u.pitchA = (int)PG8_RFL(t1_.y); u.pitchB = (int)PG8_RFL(t1_.z); u.nt = (int)PG8_RFL(t1_.w); u.si = (int)PG8_RFL(t2_.x); u.pm = (int)PG8_RFL(t2_.y); u.pn = (int)PG8_RFL(t2_.z); \
        { const unsigned we_ = PG8_RFL(t2_.w); u.wait = (int)(we_ & 255u); u.eph = (int)(we_ >> 8); } } while (0)
    if (pass2) { if (!next_unit(ws, ph, 0, G, cidx, cur, pass2)) return; }
    else { bool v0; PG8_TABREAD(cur, 0, v0); if (!v0) return; }
    f32x4 acc[2][2][4][2];
#pragma unroll
    for (int a = 0; a < 2; ++a)
#pragma unroll
        for (int b = 0; b < 2; ++b)
#pragma unroll
            for (int m = 0; m < 4; ++m)
#pragma unroll
                for (int n = 0; n < 2; ++n) acc[a][b][m][n] = (f32x4){0.f, 0.f, 0.f, 0.f};
    bf16x8 At[4][2], B0[2][2], B1[2][2];
    const char* cA = cur.A + (size_t)cur.pm * 256 * cur.pitchA; const char* cB = cur.B + (size_t)cur.pn * 256 * cur.pitchB;
    unsigned vA = (unsigned)(R0 * cur.pitchA + C0 * 2), vB = (unsigned)(R0 * cur.pitchB + C0 * 2);
    unsigned hA = (unsigned)HALF * cur.pitchA, hB = (unsigned)HALF * cur.pitchB; unsigned pA = 64u * cur.pitchA, pB = 64u * cur.pitchB;
    PG8_STAGE(PG8_SB(0, 0), cB, vB, pB); PG8_STAGE(PG8_SB(0, 1), cB + hB, vB, pB); PG8_STAGE(PG8_SA(0, 0), cA, vA, pA); PG8_STAGE(PG8_SA(0, 1), cA + hA, vA, pA);
    if (wr == 1) PG8_BAR;
    PG8_WAIT_V(2); PG8_BAR;
    PG8_STAGE(PG8_SB(1, 0), cB + kstep, vB, pB); PG8_STAGE(PG8_SA(1, 0), cA + kstep, vA, pA); PG8_STAGE(PG8_SB(1, 1), cB + hB + kstep, vB, pB);
    PG8_WAIT_V(6); PG8_BAR;
    for (;;) {
        bool has_next = false;
        if (!pass2) { if (ui < 8) PG8_TABREAD(nxt, ui + 1, has_next); else if (FB) has_next = next_unit(ws, ph, ui + 1, G, cidx, nxt, pass2); }
        const char* nA = has_next ? nxt.A + (size_t)nxt.pm * 256 * nxt.pitchA : cA; const char* nB = has_next ? nxt.B + (size_t)nxt.pn * 256 * nxt.pitchB : cB;
        const int npA = has_next ? nxt.pitchA : cur.pitchA, npB = has_next ? nxt.pitchB : cur.pitchB;
        const unsigned nvA = (unsigned)(R0 * npA + C0 * 2), nvB = (unsigned)(R0 * npB + C0 * 2);
        const unsigned nhA = (unsigned)HALF * npA, nhB = (unsigned)HALF * npB; const unsigned nppA = 64u * npA, nppB = 64u * npB;
        const int nt = cur.nt;
#ifdef KL_AMP
        const long long tk0 = wall_clock64(); const long long tc0 = (long long)__builtin_readcyclecounter();
#endif
        for (int t = 0; t < nt; t += 2) {
            const bool last = (t == nt - 2);
            if (last && has_next && nxt.wait) {
                if (wid == 0) {
                    unsigned* dep = (unsigned*)(ws + O_CTL) + CW_DEP + (nxt.wait == 2 ? 32 + ph : (nxt.wait == 4 ? 20 + ph : ph)) * 64; unsigned sp = 0; const unsigned need = (nxt.wait == 1) ? 22u : 4u;
                    asm volatile("buffer_inv sc1" ::: "memory");
                    while ((unsigned)__builtin_amdgcn_readfirstlane(__hip_atomic_load(dep, __ATOMIC_RELAXED, __HIP_MEMORY_SCOPE_AGENT)) < need) { __builtin_amdgcn_s_sleep(2); if (++sp > (1u << 22)) break; }
                    asm volatile("s_waitcnt vmcnt(0)" ::: "memory");
                }
                asm volatile("" ::: "memory"); PG8_BAR; asm volatile("" ::: "memory");
            }
            const char* a1 = cA + (size_t)(t + 1) * kstep;
            const char* a2 = last ? nA : cA + (size_t)(t + 2) * kstep; const char* b2 = last ? nB : cB + (size_t)(t + 2) * kstep;
            const char* a3 = a2 + kstep; const char* b3 = b2 + kstep;
            const unsigned vA2 = last ? nvA : vA, vB2 = last ? nvB : vB, pA2 = last ? nppA : pA, pB2 = last ? nppB : pB;
            const unsigned hA2 = last ? nhA : hA, hB2 = last ? nhB : hB;
            PG8_LDB(B0, 0, 0); PG8_LDB(B1, 0, 1); PG8_SCHED; PG8_LDA(At, 0, 0); PG8_STAGE(PG8_SA(1, 1), a1 + hA, vA, pA);
            PG8_WAIT_V(8); PG8_WAIT_L(0); PG8_BAR; PG8_MMA(0, 0, At, B0); PG8_MMA(0, 1, At, B1); PG8_BAR; PG8_SCHED;
            PG8_LDA(At, 0, 1); PG8_STAGE(PG8_SB(0, 0), b2, vB2, pB2); PG8_STAGE(PG8_SB(0, 1), b2 + hB2, vB2, pB2); PG8_STAGE(PG8_SA(0, 0), a2, vA2, pA2);
            PG8_WAIT_V(8); PG8_WAIT_L(0); PG8_BAR; PG8_MMA(1, 0, At, B0); PG8_MMA(1, 1, At, B1); PG8_BAR; PG8_SCHED;
            PG8_LDB(B0, 1, 0); PG8_LDB(B1, 1, 1); PG8_SCHED; PG8_LDA(At, 1, 0); PG8_STAGE(PG8_SA(0, 1), a2 + hA2, vA2, pA2);
            PG8_WAIT_V(8); PG8_WAIT_L(0); PG8_BAR; PG8_MMA(0, 0, At, B0); PG8_MMA(0, 1, At, B1); PG8_BAR; PG8_SCHED;
            PG8_LDA(At, 1, 1); PG8_STAGE(PG8_SB(1, 0), b3, vB2, pB2); PG8_STAGE(PG8_SB(1, 1), b3 + hB2, vB2, pB2); PG8_STAGE(PG8_SA(1, 0), a3, vA2, pA2);
            PG8_WAIT_V(8); PG8_WAIT_L(0); PG8_BAR; PG8_MMA(1, 0, At, B0); PG8_MMA(1, 1, At, B1); PG8_BAR; PG8_SCHED;
        }
#ifdef KL_AMP
        tkl += wall_clock64() - tk0; tcy += (long long)__builtin_readcyclecounter() - tc0;
#endif
        if (wr == 0) PG8_BAR;
#ifdef EPI_AMP
        const long long te0 = wall_clock64();
#endif
        if (dry != 1) epilogue(ws, outp, ph, acc, cur, wr, wc, fr, fq, lds, dry == 2 ? 0.f : 1.f);
#ifdef EPI_AMP
        tepi += wall_clock64() - te0;
#endif
        if (!has_next) break;
        if (!(is_wi(cur.eph) && dry == 0)) {
#pragma unroll
        for (int a = 0; a < 2; ++a)
#pragma unroll
            for (int b = 0; b < 2; ++b)
#pragma unroll
                for (int m = 0; m < 4; ++m)
#pragma unroll
                    for (int n = 0; n < 2; ++n) acc[a][b][m][n] = (f32x4){0.f, 0.f, 0.f, 0.f};
        }
        cur = nxt; cA = nA; cB = nB; vA = nvA; vB = nvB; hA = nhA; hB = nhB; pA = nppA; pB = nppB; ++ui;
        if (wr == 1) PG8_BAR;
    }
    PG8_WAIT_V(0);
    PG8_BAR;
#ifdef BUSY_AMP
    if (((BUSY_MASK >> ph) & 1) && (BUSY_PRED)) { const long long t1 = wall_clock64(); const long long tend = t1 + (long long)BUSY_AMP * (t1 - tb0); while (wall_clock64() < tend) __builtin_amdgcn_s_sleep(32); }
#endif
#ifdef KL_AMP
    if (cidx == 0 && ((KL_AMP_MASK >> ph) & 1)) { const long long tend = wall_clock64() + (KL_AMP == 1 ? tkl : (KL_AMP == 3 ? 2 * tkl : tcy / 24)); while (wall_clock64() < tend) __builtin_amdgcn_s_sleep(32); }
#endif
#ifdef EPI_AMP
    if (cidx == 0 && ((EPI_AMP_MASK >> ph) & 1)) { const long long tend = wall_clock64() + (long long)EPI_AMP * tepi; while (wall_clock64() < tend) __builtin_amdgcn_s_sleep(32); }
#endif
#undef PG8_TABREAD
#undef PG8_RFL
#undef PG8_SA
#undef PG8_SB
#undef PG8_STAGE
#undef PG8_LDA
#undef PG8_LDB
#undef PG8_MMA
#undef PG8_WAIT_V
#undef PG8_WAIT_L
#undef PG8_BAR
#undef PG8_SCHED
}

__device__ __forceinline__ int t5_bucket(int d) {
    if (d < 16) return d;
    int b = 16;
    b += (d >= 22) + (d >= 30) + (d >= 40) + (d >= 54) + (d >= 73) + (d >= 99) + (d >= 134) + (d >= 182) + (d >= 246) + (d >= 332) + (d >= 450) + (d >= 609) + (d >= 825) + (d >= 1117) + (d >= 1513);
    return b;
}
constexpr int ATT_BIAS_LD_ = 465, ATT_BIAS_OFF_ = 288;
struct Job { int src, soff, Ksrc, Nsrc, Kdst, Ndst, gidx, goff, map; size_t dst; float scal; };
__device__ __forceinline__ int pinv32(int l) { return 16 * ((l >> 2) & 1) + 4 * (l >> 3) + (l & 3); }
__device__ __forceinline__ Job get_job(int j) {
    Job b; b.gidx = -1; b.goff = 0; b.scal = 1.f; b.map = 0; b.soff = 0;
    if (j < 4) { const int l = j & 1, f2 = j >> 1; b.src = f2 ? 10 : 8; b.soff = l * 1024 * 5632; b.Ksrc = 1024; b.Nsrc = 5632; b.Kdst = 1024; b.Ndst = 5632; b.gidx = 7; b.goff = l * 4096 + (f2 ? 2048 : 0); b.map = 2;
                 b.dst = (f2 ? W_F2I : W_F1I) + (size_t)l * 5632 * 1024 * 2; return b; }
    if (j < 8) { const int l = j & 1, f2 = (j - 4) >> 1; b.src = f2 ? 11 : 9; b.soff = l * 2816 * 1024; b.Ksrc = 2816; b.Nsrc = 1024; b.Kdst = 2816; b.Ndst = 1024; b.map = 1;
                 b.dst = (f2 ? W_F2O : W_F1O) + (size_t)l * 1024 * 2816 * 2; return b; }
    if (j < 10) { const int l = j - 8; b.src = 13; b.soff = l * 1024 * 1024; b.Ksrc = 1024; b.Nsrc = 1024; b.Kdst = 1024; b.Ndst = 1024; b.gidx = 7; b.goff = l * 4096 + 3072; b.map = 1; b.dst = W_PEG + (size_t)l * 1024 * 1024 * 2; return b; }
    if (j < 12) { const int l = j - 10; b.src = 12; b.soff = l * 256 * 1024; b.Ksrc = 256; b.Nsrc = 1024; b.Kdst = 256; b.Ndst = 1024; b.map = 1; b.dst = W_PEP + (size_t)l * 1024 * 256 * 2; return b; }
    if (j < 15) { const int q = j - 12; b.src = 15; b.soff = q * 1024 * 1024; b.Ksrc = 1024; b.Nsrc = 1024; b.Kdst = 1024; b.Ndst = 1024; b.map = 1; b.dst = W_RKV + (size_t)q * 1024 * 1024 * 2; return b; }
    if (j == 15) { b.src = 16; b.Ksrc = 1024; b.Nsrc = 1024; b.Kdst = 1024; b.Ndst = 1024; b.map = 1; b.dst = W_RWO; return b; }
    if (j == 16) { b.src = 18; b.Ksrc = 1024; b.Nsrc = 64; b.Kdst = 1024; b.Ndst = 256; b.map = 1; b.dst = W_L1; return b; }
    if (j == 17) { b.src = 21; b.Ksrc = 1024; b.Nsrc = 64; b.Kdst = 1024; b.Ndst = 256; b.map = 1; b.dst = W_L1 + (size_t)256 * 1024 * 2; return b; }
    if (j == 18) { b.src = 23; b.Ksrc = 1024; b.Nsrc = 160; b.Kdst = 1024; b.Ndst = 256; b.map = 1; b.dst = W_L1 + (size_t)512 * 1024 * 2; return b; }
    if (j == 19) { b.src = 19; b.Ksrc = 64; b.Nsrc = 1024; b.Kdst = 128; b.Ndst = 1024; b.map = 1; b.dst = W_L2W; return b; }
    if (j == 20) { b.src = 22; b.Ksrc = 64; b.Nsrc = 1024; b.Kdst = 128; b.Ndst = 1024; b.map = 1; b.dst = W_L2A; return b; }
    if (j == 21) { b.src = 24; b.Ksrc = 160; b.Nsrc = 1024; b.Kdst = 256; b.Ndst = 1024; b.map = 1; b.dst = W_L2G; return b; }
    if (j == 22) { b.src = 30; b.Ksrc = 1024; b.Nsrc = 3072; b.Kdst = 1024; b.Ndst = 3072; b.map = 1; b.gidx = 7; b.goff = 4096 + 1024; b.scal = 0.125f * 1.4426950408889634f; b.dst = W_Q; return b; }
    if (j == 23) { b.src = 31; b.Ksrc = 1024; b.Nsrc = 1024; b.Kdst = 1024; b.Ndst = 1024; b.map = 1; b.dst = W_AO; return b; }
    b.src = 33; b.Ksrc = 1024; b.Nsrc = 512; b.Kdst = 1024; b.Ndst = 512; b.gidx = 32; b.map = 1; b.dst = W_KV; return b;
}
constexpr int NJOBS = 25;
__device__ __forceinline__ const float* sel_in(KPtr P, int i) { return P->in[i]; }
__device__ __forceinline__ void prologue_phase(KPtr P, LAS unsigned char* lds) {
    const int tid = tid_fresh(), lane = tid & 63, wave = __builtin_amdgcn_readfirstlane(tid >> 6);
    const int bid = bid_fresh(), gdim = gdim_fresh();
    const int gw = bid * 8 + wave, NGW = gdim * 8;
    LAS unsigned char* scr = lds + wave * 9216;
    int base = 0;
    for (int j = 0; j < NJOBS; ++j) {
        const Job jb = get_job(j);
        const int nkb = jb.Kdst / 64, nnb = jb.Ndst / 64, nit = nkb * nnb;
        const float* W = sel_in(P, jb.src) + jb.soff; const float* gv = jb.gidx >= 0 ? sel_in(P, jb.gidx) + jb.goff : nullptr;
        bf16_t* dst = (bf16_t*)(P->ws + jb.dst);
        int first = (gw - (base % NGW) + NGW) % NGW;
        for (int it = first; it < nit; it += NGW) {
            const int kb = it / nnb, nb = it % nnb, k0 = kb * 64, n0 = nb * 64;
            const int nn4 = (lane & 15) * 4, n = n0 + nn4;
            f32x4 v[16];
#pragma unroll
            for (int i = 0; i < 16; ++i) {
                const int k = k0 + 4 * i + (lane >> 4);
                v[i] = (f32x4){0.f, 0.f, 0.f, 0.f};
                if (k < jb.Ksrc && n < jb.Nsrc) v[i] = *(const f32x4*)(W + (size_t)k * jb.Nsrc + n);
            }
#pragma unroll
            for (int i = 0; i < 16; ++i) {
                const int kk = 4 * i + (lane >> 4), k = k0 + kk;
                float sc = jb.scal; if (gv && k < jb.Ksrc) sc *= gv[k];
                const f32x4 x = v[i] * sc;
                LAS bf16_t* sp = (LAS bf16_t*)(scr + nn4 * 144 + kk * 2);
                sp[0] = (bf16_t)(pk2(x.x, 0.f) & 0xffffu); sp[72] = (bf16_t)(pk2(x.y, 0.f) & 0xffffu); sp[144] = (bf16_t)(pk2(x.z, 0.f) & 0xffffu); sp[216] = (bf16_t)(pk2(x.w, 0.f) & 0xffffu);
            }
            asm volatile("s_waitcnt lgkmcnt(0)" ::: "memory");
            int rbase;
            if (jb.map == 2) { const int isUp = n0 >= 2816 ? 1 : 0, j0 = n0 - isUp * 2816; rbase = 256 * (j0 >> 7) + 128 * isUp + (j0 & 127); }
            else rbase = n0;
            const int c = lane & 7;
#pragma unroll
            for (int q = 0; q < 8; ++q) {
                const int nn = (lane >> 3) + 8 * q;
                const u32x4 o = *(const LAS u32x4*)(scr + nn * 144 + c * 16);
                const int drow = rbase + (jb.map ? ((nn & 32) + pinv32(nn & 31)) : nn);
                *(u32x4*)(dst + (size_t)drow * jb.Kdst + k0 + 8 * c) = o;
            }
            asm volatile("s_waitcnt lgkmcnt(0)" ::: "memory");
        }
        base += nit;
    }
    {
        float* bt = (float*)(P->ws + O_BIAS);
        for (int e = bid * NTHREADS + tid; e < 3 * 16 * ATT_BIAS_LD_; e += gdim * NTHREADS) {
            const int gh = e / ATT_BIAS_LD_, x = e % ATT_BIAS_LD_, g = gh >> 4, hd = gh & 15, j = ATT_BIAS_OFF_ - x;
            const int dil = g == 0 ? 1 : (g == 1 ? 4 : 16);
            float v = -1e30f;
            if (j >= 0 && j <= 128) v = P->in[34][t5_bucket(dil * j) * 48 + g * 16 + hd] * 1.4426950408889634f;
            bt[e] = v;
        }
    }
    if (bid == 0) { float* par = (float*)(P->ws + O_PAR); for (int e = tid; e < 1024; e += NTHREADS) { const float w0v = P->in[17][e]; par[e] = w0v; par[1024 + e] = sigmoidf_(w0v); par[2048 + e] = P->in[20][e]; } }
    bf16_t* hb0 = (bf16_t*)(P->ws + O_HB0); float* ssq0 = (float*)(P->ws + O_SSQ0);
    for (int row0 = gw; row0 < M; row0 += 4 * NGW) {
        F8 v[4][2];
#pragma unroll
        for (int k = 0; k < 4; ++k) {
            const int row = row0 + k * NGW;
            if (row < M) {
                const float* src = row < MP ? P->in[0] + (size_t)row * D : P->in[1] + (size_t)(row - MP) * D;
                v[k][0] = load8f(src + 8 * lane); v[k][1] = load8f(src + 8 * lane + 512);
            }
        }
#pragma unroll
        for (int k = 0; k < 4; ++k) {
            const int row = row0 + k * NGW;
            if (row < M) {
                float sq = 0.f;
#pragma unroll
                for (int j = 0; j < 2; ++j) {
                    const int c = 8 * lane + 512 * j;
                    *(u32x4*)(hb0 + (size_t)row * D + c) = pack8(v[k][j]);
#pragma unroll
                    for (int q = 0; q < 8; ++q) sq += v[k][j].v[q] * v[k][j].v[q];
                }
                sq = wave_sum(sq);
                if (lane < 16) ssq0[(size_t)row * 16 + lane] = (lane == 0) ? sq : 0.f;
            }
        }
    }
    bf16_t* pb = (bf16_t*)(P->ws + O_PB);
    const size_t nchunk = (size_t)2 * M * 32;
    const size_t cstride = (size_t)gdim * NTHREADS;
    for (size_t ch0 = (size_t)bid * NTHREADS + tid; ch0 < nchunk; ch0 += 4 * cstride) {
        F8 v[4];
#pragma unroll
        for (int k = 0; k < 4; ++k) {
            const size_t ch = ch0 + k * cstride;
            if (ch < nchunk) {
                const size_t e = ch * 8; const int l = (int)(e / ((size_t)M * 256)); const size_t r = e - (size_t)l * M * 256; const int row = (int)(r >> 8), col = (int)(r & 255);
                const float* src = row < MP ? P->in[5] + ((size_t)l * MP + row) * 256 + col : P->in[6] + ((size_t)l * MS + (row - MP)) * 256 + col;
                v[k] = load8f(src);
            }
        }
#pragma unroll
        for (int k = 0; k < 4; ++k) { const size_t ch = ch0 + k * cstride; if (ch < nchunk) *(u32x4*)(pb + ch * 8) = pack8(v[k]); }
    }
}

__device__ __forceinline__ void mix_pass(KPtr P) {
    const int tid = tid_fresh(), lane = tid & 63, wave = tid >> 6; const int gw = bid_fresh() * 8 + wave, NGW = gdim_fresh() * 8;
    const float* ssq = (const float*)(P->ws + O_SSQ1); const bf16_t* H = (const bf16_t*)(P->ws + O_HB1); const float* g1 = P->in[7] + 1024; const float* mix = P->in[14];
#pragma unroll 1
    for (int j = 0; j < 2; ++j) {
        const int c = 8 * lane + 512 * j;
        const F8 g = load8f(g1 + c);
        F8 mq[6];
#pragma unroll
        for (int a6 = 0; a6 < 6; ++a6) mq[a6] = load8f(mix + a6 * 1024 + c);
        for (int row0 = gw; row0 < M; row0 += 2 * NGW) {
            u32x4 hcv[2], hpv[2]; float rsv[2], rspv[2];
#pragma unroll
            for (int k = 0; k < 2; ++k) {
                const int row = row0 + k * NGW;
                if (row < M) {
                    const int t = row < MP ? (row & 4095) : ((row - MP) & 7);
                    rsv[k] = rstd_of(ssq, row); rspv[k] = t > 0 ? rstd_of(ssq, row - 1) : 0.f;
                    hcv[k] = *(const u32x4*)(H + (size_t)row * D + c);
                    hpv[k] = t > 0 ? *(const u32x4*)(H + (size_t)(row - 1) * D + c) : (u32x4){0u, 0u, 0u, 0u};
                }
            }
#pragma unroll
            for (int k = 0; k < 2; ++k) {
            const int row = row0 + k * NGW;
            if (row < M) {
            int b, t, T; const bool isS = row >= MP;
            if (!isS) { b = row >> 12; t = row & 4095; T = TP; } else { const int jj = row - MP; b = jj >> 3; t = jj & 7; T = TS; }
            const float rs = rsv[k]; const float rsp = rspv[k];
            const F8 hc = unpack8(hcv[k]);
            F8 xn, xx;
#pragma unroll
            for (int q = 0; q < 8; ++q) xn.v[q] = hc.v[q] * rs * g.v[q];
            if (t > 0) { const F8 hp = unpack8(hpv[k]);
#pragma unroll
                for (int q = 0; q < 8; ++q) xx.v[q] = hp.v[q] * rsp * g.v[q] - xn.v[q]; }
            else if (isS) { const F8 sp = load8f(P->in[3] + (size_t)b * D + c);
#pragma unroll
                for (int q = 0; q < 8; ++q) xx.v[q] = sp.v[q] - xn.v[q]; }
            else {
#pragma unroll
                for (int q = 0; q < 8; ++q) xx.v[q] = -xn.v[q]; }
#pragma unroll
            for (int a6 = 0; a6 < 6; ++a6) {
                F8 v;
#pragma unroll
                for (int q = 0; q < 8; ++q) v.v[q] = xn.v[q] + xx.v[q] * mq[a6].v[q];
                *(u32x4*)((bf16_t*)(P->ws + O_R4 + (size_t)a6 * SL) + (size_t)row * D + c) = pack8(v);
            }
            if (t == T - 1) { float* so = P->out + (isS ? O_SHS : O_SHP) + (size_t)b * D + c;
                *(f32x4*)so = (f32x4){xn.v[0], xn.v[1], xn.v[2], xn.v[3]}; *(f32x4*)(so + 4) = (f32x4){xn.v[4], xn.v[5], xn.v[6], xn.v[7]}; }
            } }
        }
    }
}
__device__ __forceinline__ void post_pass(KPtr P) {
    const int tid = tid_fresh(), lane = tid & 63, wave = tid >> 6; const int gw = bid_fresh() * 8 + wave, NGW = gdim_fresh() * 8;
    const bf16_t* Y = (const bf16_t*)(P->ws + O_Y); const bf16_t* BON = (const bf16_t*)(P->ws + O_BON); const bf16_t* GG = (const bf16_t*)(P->ws + O_GG);
    bf16_t* YG = (bf16_t*)(P->ws + O_YG); const float* lw = P->in[28]; const float* lb = P->in[29];
    F8 w8[2], b8[2];
#pragma unroll
    for (int j = 0; j < 2; ++j) { w8[j] = load8f(lw + 8 * lane + 512 * j); b8[j] = load8f(lb + 8 * lane + 512 * j); }
    for (int row0 = gw; row0 < M; row0 += 2 * NGW) {
        u32x4 yv[2][2], bv[2][2], gv[2][2];
#pragma unroll
        for (int k = 0; k < 2; ++k) {
            const int row = row0 + k * NGW;
            if (row < M) {
#pragma unroll
                for (int j = 0; j < 2; ++j) { const size_t off = (size_t)row * D + 8 * lane + 512 * j; yv[k][j] = *(const u32x4*)(Y + off); bv[k][j] = *(const u32x4*)(BON + off); gv[k][j] = *(const u32x4*)(GG + off); }
            }
        }
#pragma unroll
        for (int k = 0; k < 2; ++k) {
            const int row = row0 + k * NGW;
            if (row < M) {
#pragma unroll
                for (int j = 0; j < 2; ++j) {
                    const int c = 8 * lane + 512 * j; const size_t off = (size_t)row * D + c;
                    const F8 y = unpack8(yv[k][j]), bo = unpack8(bv[k][j]), gg = unpack8(gv[k][j]);
                    float sm = 0.f;
#pragma unroll
                    for (int q = 0; q < 8; ++q) sm += y.v[q];
                    const float mu = row_sum8(sm) * (1.f / 64.f);
                    float sv = 0.f; F8 d;
#pragma unroll
                    for (int q = 0; q < 8; ++q) { d.v[q] = y.v[q] - mu; sv += d.v[q] * d.v[q]; }
                    const float rs = __builtin_amdgcn_rsqf(row_sum8(sv) * (1.f / 64.f) + 64e-5f);
                    F8 o;
#pragma unroll
                    for (int q = 0; q < 8; ++q) o.v[q] = (d.v[q] * rs * w8[j].v[q] + b8[j].v[q] + bo.v[q]) * gg.v[q];
                    *(u32x4*)(YG + off) = pack8(o);
                }
            }
        }
    }
}
__device__ __forceinline__ void final_pass(KPtr P) {
    const int tid = tid_fresh(), lane = tid & 63, wave = tid >> 6; const int gw = bid_fresh() * 8 + wave, NGW = gdim_fresh() * 8;
    const float* ssq = (const float*)(P->ws + O_SSQ0); const float* fn = P->in[35];
    F8 f[2];
#pragma unroll
    for (int j = 0; j < 2; ++j) f[j] = load8f(fn + 8 * lane + 512 * j);
    for (int row0 = gw; row0 < M; row0 += 4 * NGW) {
        u32x4 hv[4][2]; float rs[4];
#pragma unroll
        for (int k = 0; k < 4; ++k) {
            const int row = row0 + k * NGW;
            if (row < M) {
                rs[k] = rstd_of(ssq, row);
#pragma unroll
                for (int j = 0; j < 2; ++j) hv[k][j] = *(const u32x4*)((const bf16_t*)(P->ws + O_HB0) + (size_t)row * D + 8 * lane + 512 * j);
            }
        }
#pragma unroll
        for (int k = 0; k < 4; ++k) {
            const int row = row0 + k * NGW;
            if (row < M) {
#pragma unroll
                for (int j = 0; j < 2; ++j) {
                    const int c = 8 * lane + 512 * j; float* p = P->out + (size_t)row * D + c;
                    const F8 h = unpack8(hv[k][j]); const float r = rs[k];
                    *(f32x4*)p = (f32x4){h.v[0] * r * f[j].v[0], h.v[1] * r * f[j].v[1], h.v[2] * r * f[j].v[2], h.v[3] * r * f[j].v[3]};
                    *(f32x4*)(p + 4) = (f32x4){h.v[4] * r * f[j].v[4], h.v[5] * r * f[j].v[5], h.v[6] * r * f[j].v[6], h.v[7] * r * f[j].v[7]};
                }
            }
        }
    }
}

constexpr int TC = 8;
constexpr int SC_BUF = 6 * TC * 256 + TC * 4;
constexpr int SC_OUT = 2 * SC_BUF;
constexpr int SC_OBUF = 2 * TC * 64 * 4;
__device__ __forceinline__ float wave_sum_fast(float x) {
    x = row_sum16(x);
    const float a = __builtin_bit_cast(float, __builtin_amdgcn_readlane(__builtin_bit_cast(int, x), 0)), b = __builtin_bit_cast(float, __builtin_amdgcn_readlane(__builtin_bit_cast(int, x), 16));
    const float c = __builtin_bit_cast(float, __builtin_amdgcn_readlane(__builtin_bit_cast(int, x), 32)), d = __builtin_bit_cast(float, __builtin_amdgcn_readlane(__builtin_bit_cast(int, x), 48));
    return (a + b) + (c + d);
}
struct PrepRegs { unsigned short lr[TC / 4], lk[TC / 4], lw[TC / 4], la[TC / 4], lv[TC / 4]; };
__device__ __forceinline__ void scan_prep_load(KPtr P, PrepRegs& g, int rowbase, int t0, int T, int h, int qi, int pw, int lane) {
    const bf16_t* RKV = (const bf16_t*)(P->ws + O_RKVB); const bf16_t* WL = (const bf16_t*)(P->ws + O_WL); const bf16_t* AL = (const bf16_t*)(P->ws + O_AL);
    const int ch = h * 64 + lane;
    constexpr int NS = TC / 4;
#pragma unroll
    for (int q = 0; q < NS; ++q) {
        int t = t0 + pw * NS + q; t = t < T ? t : T - 1;
        const size_t row = (size_t)(rowbase + t);
        g.lr[q] = RKV[row * 3072 + ch]; g.lk[q] = RKV[row * 3072 + 1024 + ch]; g.lw[q] = WL[row * 1024 + ch]; g.la[q] = AL[row * 1024 + ch];
        g.lv[q] = RKV[row * 3072 + 2048 + ch];
    }
}
__device__ __forceinline__ void scan_prep_compute(KPtr P, const PrepRegs& g, LAS unsigned char* buf, int h, int pw, int lane) {
    const int ch = h * 64 + lane;
    const float sw0 = ((const float*)(P->ws + O_PAR))[1024 + ch], kkw = P->in[25][ch], kaw = P->in[26][ch], rkw = P->in[27][ch];
    LAS float* fb = (LAS float*)buf;
    constexpr int NS = TC / 4;
#pragma unroll
    for (int q = 0; q < NS; ++q) {
        const int tau = pw * NS + q;
        const float r = bf2f(g.lr[q]), k = bf2f(g.lk[q]), wl = bf2f(g.lw[q]), al = bf2f(g.la[q]);
        const float dec = __builtin_amdgcn_exp2f(-0.8750387f * (sw0 + wl));
        const float a = al;
        const float kkv = k * kkw;
        const float n2 = wave_sum_fast(kkv * kkv);
        const float kkn = kkv * __builtin_amdgcn_rsqf(fmaxf(n2, 1e-24f));
        const float kp = k * (1.f + (a - 1.f) * kaw);
        const float bon = wave_sum_fast(r * kp * rkw);
        fb[0 * TC * 64 + tau * 64 + lane] = -kkn;
        fb[1 * TC * 64 + tau * 64 + lane] = dec;
        fb[2 * TC * 64 + tau * 64 + lane] = kkn * a;
        fb[3 * TC * 64 + tau * 64 + lane] = kp;
        fb[4 * TC * 64 + tau * 64 + lane] = r;
        fb[5 * TC * 64 + tau * 64 + lane] = bf2f(g.lv[q]);
        if (lane == 0) fb[6 * TC * 64 + tau] = bon;
    }
}
__device__ __forceinline__ void scan_flush(KPtr P, const LAS float* ob, int rowbase, int t0, int T, int h, int p) {
    const int tau = p >> 5, pr = (p & 31) * 2; const int t = t0 + tau;
    if (t < T) {
        const size_t off = (size_t)(rowbase + t) * D + h * 64 + pr;
        *(unsigned*)((bf16_t*)(P->ws + O_Y) + off) = pk2(ob[tau * 64 + pr], ob[tau * 64 + pr + 1]);
        *(unsigned*)((bf16_t*)(P->ws + O_BON) + off) = pk2(ob[TC * 64 + tau * 64 + pr], ob[TC * 64 + tau * 64 + pr + 1]);
    }
}
typedef short bf16x4 __attribute__((ext_vector_type(4)));
#ifndef NPREP_
#define NPREP_ 7
#endif
constexpr int NPREP = NPREP_;
constexpr int SL_AOP = 0, SL_RT = 2048, SL_UH = 4096, SL_Y0 = 5120, SL_MRB = 6144, SL_BTT = 6656, SL_ZV = 8704, SL_GC = 10752, SL_VTB = 11008, SL_BON = 11520, SL_RN = 11584, SLOT_B = 11776;
constexpr int SC_ATT = 0, SC_KTT = 2048, SCR_B = 4096;
constexpr int SC_X1 = -SLOT_B + SL_AOP, SC_X2 = -SLOT_B + SL_ZV;
constexpr int CK_FLAGS = NPREP * (SLOT_B + SCR_B);
static_assert(CK_FLAGS + 64 <= LDS_CTL_OFF, "chunked scan LDS");
typedef unsigned short us2 __attribute__((ext_vector_type(2)));
struct CkRegs { us2 rk[16], wa[16], vv[8]; };
__device__ __forceinline__ void ck_load(KPtr P, CkRegs& g, int row0, int h, int qi, int lane) {
    const bf16_t* rk = (const bf16_t*)(P->ws + O_RKVB) + (size_t)row0 * 3072 + h * 64;
    const bf16_t* wl = (const bf16_t*)(P->ws + O_WL) + (size_t)row0 * 1024 + h * 64;
    const bf16_t* al = (const bf16_t*)(P->ws + O_AL) + (size_t)row0 * 1024 + h * 64;
    const bf16_t* vq = rk + 2048 + qi * 16;
    const int l15 = lane & 15;
#pragma unroll
    for (int t = 0; t < 16; ++t) {
        g.rk[t].x = rk[t * 3072 + lane]; g.rk[t].y = rk[t * 3072 + 1024 + lane]; g.wa[t].x = wl[t * 1024 + lane]; g.wa[t].y = al[t * 1024 + lane];
        const unsigned short vv_ = vq[t * 3072 + l15];
        if (t & 1) g.vv[t >> 1].y = vv_; else g.vv[t >> 1].x = vv_;
    }
}
__device__ __forceinline__ unsigned short bf1(float x) { return (unsigned short)(pk2(x, 0.f) & 0xffffu); }
__device__ __forceinline__ bf16x4 pack4(f32x4 v) { u32x2 w; w.x = pk2(v.x, v.y); w.y = pk2(v.z, v.w); return __builtin_bit_cast(bf16x4, w); }
#define MFMA16(a, b, c) __builtin_amdgcn_mfma_f32_16x16x16bf16_1k(a, b, c, 0, 0, 0)
#define MFMA32(a, b, c) __builtin_amdgcn_mfma_f32_16x16x32_bf16(a, b, c, 0, 0, 0)
#define LDSW() asm volatile("s_waitcnt lgkmcnt(0)" ::: "memory")
__device__ __forceinline__ bf16x4 ck_tr(const LAS unsigned char* a) { return __builtin_amdgcn_ds_read_tr16_b64_v4i16((LAS bf16x4*)a); }
__device__ __forceinline__ bf16x8 ck_tr8(const LAS unsigned char* a, int second) { const bf16x4 lo = ck_tr(a), hi = ck_tr(a + second); return (bf16x8){lo.x, lo.y, lo.z, lo.w, hi.x, hi.y, hi.z, hi.w}; }
struct CkPar { float sw0, kkw, kaw, rkw; };
__device__ __forceinline__ void ck_prep_a(const CkPar& cp, const CkRegs& g, LAS unsigned char* slot, LAS unsigned char* scr, int lane) {
    const float sw0 = cp.sw0, kkw = cp.kkw, kaw = cp.kaw, rkw = cp.rkw;
    float gprev = 1.f, pa = 0.f, pb = 0.f, pk = 0.f, pv = 0.f, pr = 0.f, p1 = 0.f, p2 = 0.f;
    unsigned att[8], btt[8], ktt[8], vtb[8], rtt[8], x1t[8], x2t[8];
#pragma unroll
    for (int t = 0; t < 16; ++t) {
        const float r = bf2f(g.rk[t].x), k = bf2f(g.rk[t].y), wl = bf2f(g.wa[t].x), al = bf2f(g.wa[t].y);
        const float dec = __builtin_amdgcn_exp2f(-0.8750387f * (sw0 + wl));
        const float a = al;
        const float kkv = k * kkw;
        const float kp = k * (1.f + (a - 1.f) * kaw);
        const float gcur = gprev * dec, rg = __builtin_amdgcn_rcpf(gcur);
        const float at = -kkv * gprev, bt = kkv * a * rg, kt = kp * rg, rt = r * gcur, vv = bf2f((t & 1) ? g.vv[t >> 1].y : g.vv[t >> 1].x);
        const float x1 = kkv * kkv, x2 = r * kp * rkw;
        if (t & 1) {
            att[t >> 1] = pk2(pa, at); btt[t >> 1] = pk2(pb, bt); ktt[t >> 1] = pk2(pk, kt); vtb[t >> 1] = pk2(pv, vv);
            rtt[t >> 1] = pk2(pr, rt); x1t[t >> 1] = pk2(p1, x1); x2t[t >> 1] = pk2(p2, x2);
        }
        pa = at; pb = bt; pk = kt; pv = vv; pr = rt; p1 = x1; p2 = x2;
        gprev = gcur;
    }
    *(LAS u32x4*)(slot + SL_RT + lane * 32) = (u32x4){rtt[0], rtt[1], rtt[2], rtt[3]}; *(LAS u32x4*)(slot + SL_RT + lane * 32 + 16) = (u32x4){rtt[4], rtt[5], rtt[6], rtt[7]};
    *(LAS u32x4*)(scr + SC_X1 + lane * 32) = (u32x4){x1t[0], x1t[1], x1t[2], x1t[3]}; *(LAS u32x4*)(scr + SC_X1 + lane * 32 + 16) = (u32x4){x1t[4], x1t[5], x1t[6], x1t[7]};
    *(LAS u32x4*)(scr + SC_X2 + lane * 32) = (u32x4){x2t[0], x2t[1], x2t[2], x2t[3]}; *(LAS u32x4*)(scr + SC_X2 + lane * 32 + 16) = (u32x4){x2t[4], x2t[5], x2t[6], x2t[7]};
    ((LAS float*)(slot + SL_GC))[lane] = gprev;
    *(LAS u32x4*)(scr + SC_ATT + lane * 32) = (u32x4){att[0], att[1], att[2], att[3]}; *(LAS u32x4*)(scr + SC_ATT + lane * 32 + 16) = (u32x4){att[4], att[5], att[6], att[7]};
    *(LAS u32x4*)(slot + SL_BTT + lane * 32) = (u32x4){btt[0], btt[1], btt[2], btt[3]}; *(LAS u32x4*)(slot + SL_BTT + lane * 32 + 16) = (u32x4){btt[4], btt[5], btt[6], btt[7]};
    *(LAS u32x4*)(scr + SC_KTT + lane * 32) = (u32x4){ktt[0], ktt[1], ktt[2], ktt[3]}; *(LAS u32x4*)(scr + SC_KTT + lane * 32 + 16) = (u32x4){ktt[4], ktt[5], ktt[6], ktt[7]};
    if (lane < 16) {
        *(LAS u32x4*)(slot + SL_VTB + lane * 32) = (u32x4){vtb[0], vtb[1], vtb[2], vtb[3]}; *(LAS u32x4*)(slot + SL_VTB + lane * 32 + 16) = (u32x4){vtb[4], vtb[5], vtb[6], vtb[7]};
    }
    LDSW();
}
__device__ __forceinline__ void ck_prep_b(LAS unsigned char* slot, LAS unsigned char* scr, int lane) {
    const int m = lane & 15, kg = lane >> 4;
    const f32x4 z4 = (f32x4){0.f, 0.f, 0.f, 0.f};
    f32x4 P1, P2, P3, P4, P2t;
    {
        const int tro = (8 * kg + ((lane >> 2) & 3)) * 32 + (lane & 3) * 8;
        const bf16x8 KA0 = ck_tr8(scr + SC_KTT + tro, 128), KA1 = ck_tr8(scr + SC_KTT + tro + 1024, 128);
        const bf16x8 BA0 = ck_tr8(slot + SL_BTT + tro, 128), BA1 = ck_tr8(slot + SL_BTT + tro + 1024, 128);
        const bf16x8 AB0 = ck_tr8(scr + SC_ATT + tro, 128), AB1 = ck_tr8(scr + SC_ATT + tro + 1024, 128);
        const bf16x8 RB0 = ck_tr8(slot + SL_RT + tro, 128), RB1 = ck_tr8(slot + SL_RT + tro + 1024, 128);
        P1 = MFMA32(KA0, AB0, z4); P1 = MFMA32(KA1, AB1, P1);
        P2 = MFMA32(BA0, AB0, z4); P2 = MFMA32(BA1, AB1, P2);
        P3 = MFMA32(KA0, RB0, z4); P3 = MFMA32(KA1, RB1, P3);
        P4 = MFMA32(BA0, RB0, z4); P4 = MFMA32(BA1, RB1, P4);
        P2t = MFMA32(AB0, BA0, z4); P2t = MFMA32(AB1, BA1, P2t);
    }
    f32x4 rn4;
    {
        const u32x4 one4 = (u32x4){0x3f803f80u, 0x3f803f80u, 0x3f803f80u, 0x3f803f80u}; const bf16x8 ones = __builtin_bit_cast(bf16x8, one4);
        const int tro = (8 * kg + ((lane >> 2) & 3)) * 32 + (lane & 3) * 8;
        const bf16x8 X10 = ck_tr8(scr + SC_X1 + tro, 128), X11 = ck_tr8(scr + SC_X1 + tro + 1024, 128);
        const bf16x8 X20 = ck_tr8(scr + SC_X2 + tro, 128), X21 = ck_tr8(scr + SC_X2 + tro + 1024, 128);
        f32x4 N2 = MFMA32(X10, ones, z4); N2 = MFMA32(X11, ones, N2);
        f32x4 BO = MFMA32(X20, ones, z4); BO = MFMA32(X21, ones, BO);
#pragma unroll
        for (int e = 0; e < 4; ++e) rn4[e] = __builtin_amdgcn_rsqf(fmaxf(N2[e], 1e-24f));
        if (m == 0) { *(LAS f32x4*)(slot + SL_RN + 4 * kg * 4) = rn4; *(LAS f32x4*)(slot + SL_BON + 4 * kg * 4) = BO; }
    }
    LDSW();
    const float rnm = ((const LAS float*)(slot + SL_RN))[m];
    f32x4 lak, lab, labt, mrk, mrb, R;
#pragma unroll
    for (int e = 0; e < 4; ++e) { const float sc = rnm * rn4[e]; P1[e] *= rnm; P2[e] *= sc; P2t[e] *= sc; P4[e] *= rn4[e]; }
#pragma unroll
    for (int e = 0; e < 4; ++e) { const int sI = 4 * kg + e; lak[e] = sI < m ? P1[e] : 0.f; lab[e] = sI < m ? P2[e] : 0.f; labt[e] = m < sI ? P2t[e] : 0.f; mrk[e] = sI <= m ? P3[e] : 0.f; mrb[e] = sI <= m ? P4[e] : 0.f;
                                  R[e] = lab[e] + (sI == m ? 1.f : 0.f); }
    *(LAS bf16x4*)(slot + SL_MRB + lane * 8) = pack4(mrb);
    const bf16x4 lakop = pack4(lak), mrkop = pack4(mrk);
    {
        const bf16x4 x1 = pack4(lab), x1t = pack4(labt);
        const f32x4 M2 = MFMA16(x1t, x1, z4), M2t = MFMA16(x1, x1t, z4);
        const bf16x4 m2 = pack4(M2), m2t = pack4(M2t);
        R = MFMA16(m2t, pack4(R), R);
        const f32x4 M4 = MFMA16(m2t, m2, z4), M4t = MFMA16(m2, m2t, z4);
        const bf16x4 m4 = pack4(M4), m4t = pack4(M4t);
        R = MFMA16(m4t, pack4(R), R);
        const f32x4 M8t = MFMA16(m4, m4t, z4);
        R = MFMA16(pack4(M8t), pack4(R), R);
    }
    const bf16x4 top = pack4(R);
    const bf16x4 top2 = pack4(R * rn4);
    const bf16x4 vop = *(const LAS bf16x4*)(slot + SL_VTB + (m * 16 + 4 * kg) * 2);
    const f32x4 LV = MFMA16(lakop, vop, z4);
    const f32x4 Y0 = MFMA16(mrkop, vop, z4);
    *(LAS f32x4*)(slot + SL_Y0 + lane * 16) = Y0;
    const f32x4 UH = MFMA16(top, pack4(LV), z4);
    *(LAS f32x4*)(slot + SL_UH + lane * 16) = UH;
    u32x4 o1, o2;
    {
        f32x4 AH[4], ZV[4];
#pragma unroll
        for (int tau = 0; tau < 4; ++tau) {
            const bf16x4 aop = *(const LAS bf16x4*)(scr + SC_ATT + ((16 * tau + m) * 16 + 4 * kg) * 2);
            AH[tau] = MFMA16(aop, top2, z4);
            const bf16x4 kop = *(const LAS bf16x4*)(scr + SC_KTT + ((16 * tau + m) * 16 + 4 * kg) * 2);
            ZV[tau] = MFMA16(kop, vop, z4);
        }
        o1 = (u32x4){pk2(AH[0].x, AH[0].y), pk2(AH[0].z, AH[0].w), pk2(AH[1].x, AH[1].y), pk2(AH[1].z, AH[1].w)};
        o2 = (u32x4){pk2(AH[2].x, AH[2].y), pk2(AH[2].z, AH[2].w), pk2(AH[3].x, AH[3].y), pk2(AH[3].z, AH[3].w)};
        *(LAS u32x4*)(slot + SL_AOP + lane * 32) = o1; *(LAS u32x4*)(slot + SL_AOP + lane * 32 + 16) = o2;
        o1 = (u32x4){pk2(ZV[0].x, ZV[0].y), pk2(ZV[0].z, ZV[0].w), pk2(ZV[1].x, ZV[1].y), pk2(ZV[1].z, ZV[1].w)};
        o2 = (u32x4){pk2(ZV[2].x, ZV[2].y), pk2(ZV[2].z, ZV[2].w), pk2(ZV[3].x, ZV[3].y), pk2(ZV[3].z, ZV[3].w)};
        *(LAS u32x4*)(slot + SL_ZV + lane * 32) = o1; *(LAS u32x4*)(slot + SL_ZV + lane * 32 + 16) = o2;
    }
    LDSW();
}
struct SeqOps { bf16x8 aop1, aop2, rop1, rop2; f32x4 uh, rn, y0, gc[4], bn; bf16x4 mop, bop[4]; u32x4 zv1, zv2; u32x2 vtw; };
__device__ __forceinline__ void seq_load(SeqOps& o, const LAS unsigned char* slot, int lane, int m, int kg) {
    o.aop1 = *(const LAS bf16x8*)(slot + SL_AOP + lane * 32); o.aop2 = *(const LAS bf16x8*)(slot + SL_AOP + lane * 32 + 16);
    const LAS unsigned char* rrow = slot + SL_RT + (4 * kg + ((lane >> 2) & 3)) * 32 + (lane & 3) * 8;
    o.rop1 = ck_tr8(rrow, 512); o.rop2 = ck_tr8(rrow + 1024, 512);
    o.uh = *(const LAS f32x4*)(slot + SL_UH + lane * 16);
    o.rn = *(const LAS f32x4*)(slot + SL_RN + 4 * kg * 4);
    o.mop = *(const LAS bf16x4*)(slot + SL_MRB + lane * 8);
    o.y0 = *(const LAS f32x4*)(slot + SL_Y0 + lane * 16);
    o.zv1 = *(const LAS u32x4*)(slot + SL_ZV + lane * 32); o.zv2 = *(const LAS u32x4*)(slot + SL_ZV + lane * 32 + 16);
#pragma unroll
    for (int tau = 0; tau < 4; ++tau) {
        o.bop[tau] = *(const LAS bf16x4*)(slot + SL_BTT + ((16 * tau + m) * 16 + 4 * kg) * 2);
        o.gc[tau] = *(const LAS f32x4*)(slot + SL_GC + (16 * tau + 4 * kg) * 4);
    }
    o.bn = *(const LAS f32x4*)(slot + SL_BON + 4 * kg * 4); o.vtw = *(const LAS u32x2*)(slot + SL_VTB + (m * 16 + 4 * kg) * 2);
}
__device__ __forceinline__ void ck_wait(volatile LAS unsigned* f, unsigned v) { while (*f != v) __builtin_amdgcn_s_sleep(1); asm volatile("" ::: "memory"); }
__device__ __forceinline__ void scan_chunked_item(KPtr P, LAS unsigned char* lds, int it, int tid, int mode) {
    const int lane = tid & 63, w = __builtin_amdgcn_readfirstlane(tid >> 6);
    const int b = it >> 6, h = (it >> 2) & 15, qi = it & 3, rowbase = b * TP;
    constexpr int NCH = TP / 16;
    volatile LAS unsigned* flags = (volatile LAS unsigned*)(lds + CK_FLAGS);
    if (tid < 16) flags[tid] = 0u;
    __syncthreads();
    if (w == 0) {
#ifdef SEQ_PRIO
        __builtin_amdgcn_s_setprio(SEQ_PRIO);
#endif
        const int m = lane & 15, kg = lane >> 4;
        f32x4 ST[4];
#pragma unroll
        for (int tau = 0; tau < 4; ++tau) ST[tau] = (f32x4){0.f, 0.f, 0.f, 0.f};
        bf16_t* Yg = (bf16_t*)(P->ws + O_Y) + (size_t)rowbase * D + h * 64 + qi * 16 + m;
        bf16_t* Bg = (bf16_t*)(P->ws + O_BON) + (size_t)rowbase * D + h * 64 + qi * 16 + m;
        int pslot = 0;
        if (mode == 1 || mode == 3) {
#pragma unroll 1
            for (int c = 0; c < NCH; ++c) { ck_wait(flags + pslot, (unsigned)(c + 1)); flags[8 + pslot] = (unsigned)(c + 1); pslot = (pslot == NPREP - 1) ? 0 : pslot + 1; }
        } else {
        SeqOps oa, ob;
        ck_wait(flags, 1u); seq_load(oa, lds, lane, m, kg); LDSW(); flags[8] = 1u; pslot = 1;
#define CK_SEQ_STEP(cur, nxt, cc) do { \
            const f32x4 z4 = (f32x4){0.f, 0.f, 0.f, 0.f}; \
            const u32x4 s1 = (u32x4){pk2(ST[0].x, ST[0].y), pk2(ST[0].z, ST[0].w), pk2(ST[1].x, ST[1].y), pk2(ST[1].z, ST[1].w)}; \
            const u32x4 s2 = (u32x4){pk2(ST[2].x, ST[2].y), pk2(ST[2].z, ST[2].w), pk2(ST[3].x, ST[3].y), pk2(ST[3].z, ST[3].w)}; \
            const bf16x8 sop1 = __builtin_bit_cast(bf16x8, s1), sop2 = __builtin_bit_cast(bf16x8, s2); \
            f32x4 U = MFMA32(cur.aop1, sop1, z4); U = MFMA32(cur.aop2, sop2, U);           \
            f32x4 Y = MFMA32(cur.rop1, sop1, z4); Y = MFMA32(cur.rop2, sop2, Y);           \
            const bool more = (cc) + 1 < NCH; \
            if (more) { ck_wait(flags + pslot, (unsigned)((cc) + 2)); seq_load(nxt, lds + pslot * (SLOT_B + SCR_B), lane, m, kg); } \
            U = U + cur.uh; \
            const bf16x4 uop = pack4(U); \
            const bf16x4 uop2 = pack4(U * cur.rn);                                         \
            Y = MFMA16(cur.mop, uop, Y); \
            Y = Y + cur.y0; \
            const unsigned zvw[8] = {cur.zv1.x, cur.zv1.y, cur.zv1.z, cur.zv1.w, cur.zv2.x, cur.zv2.y, cur.zv2.z, cur.zv2.w}; \
            _Pragma("unroll") \
            for (int tau = 0; tau < 4; ++tau) { \
                const f32x4 dS = MFMA16(cur.bop[tau], uop2, z4);                            \
                const f32x4 zv = (f32x4){bflo(zvw[2 * tau]), bfhi(zvw[2 * tau]), bflo(zvw[2 * tau + 1]), bfhi(zvw[2 * tau + 1])}; \
                ST[tau] = (ST[tau] + dS + zv) * cur.gc[tau]; \
            } \
            const f32x4 vt4 = (f32x4){bflo(cur.vtw.x), bfhi(cur.vtw.x), bflo(cur.vtw.y), bfhi(cur.vtw.y)}; \
            if (more) { LDSW(); flags[8 + pslot] = (unsigned)((cc) + 2); pslot = (pslot == NPREP - 1) ? 0 : pslot + 1; }       \
            if (mode == 0) { \
                _Pragma("unroll") \
                for (int e = 0; e < 4; ++e) { \
                    const size_t off = (size_t)((cc) * 16 + 4 * kg + e) * D; \
                    Yg[off] = bf1(Y[e]); Bg[off] = bf1(cur.bn[e] * vt4[e]); \
                } } else { asm volatile("" :: "v"(Y), "v"(cur.bn), "v"(vt4)); } \
        } while (0)
#pragma unroll 1
        for (int c = 0; c < NCH; c += 2) { CK_SEQ_STEP(oa, ob, c); CK_SEQ_STEP(ob, oa, c + 1); }
#undef CK_SEQ_STEP
        }
#ifdef SEQ_PRIO
        __builtin_amdgcn_s_setprio(0);
#endif
        float* sout = P->out + O_WKVP + (size_t)(b * 16 + h) * 4096 + (size_t)(qi * 16 + m) * 64;
        if (mode == 0) {
#pragma unroll
        for (int tau = 0; tau < 4; ++tau) *(f32x4*)(sout + 16 * tau + 4 * kg) = ST[tau]; } else { asm volatile("" :: "v"(ST[0]), "v"(ST[1]), "v"(ST[2]), "v"(ST[3])); }
    } else if ((NPREP == 7 ? w - 1 : (w < 4 ? w - 1 : w - 2)) < NPREP && !(NPREP < 7 && w == 4)) {
        const int p = (NPREP == 7) ? w - 1 : (w < 4 ? w - 1 : w - 2);
#ifdef PREP4_PRIO
        if (w == 4) __builtin_amdgcn_s_setprio(PREP4_PRIO);
#endif
        LAS unsigned char* slot = lds + p * (SLOT_B + SCR_B); LAS unsigned char* scr = slot + SLOT_B;
        CkRegs g;
        CkPar cp; { const int ch = h * 64 + lane; cp.sw0 = ((const float*)(P->ws + O_PAR))[1024 + ch]; cp.kkw = P->in[25][ch]; cp.kaw = P->in[26][ch]; cp.rkw = P->in[27][ch]; }
        ck_load(P, g, rowbase + p * 16, h, qi, lane);
#pragma unroll 1
        for (int c = p; c < NCH; c += NPREP) {
            if (c >= NPREP) ck_wait(flags + 8 + p, (unsigned)(c - NPREP + 1));
            if (mode == 2) { flags[p] = (unsigned)(c + 1); continue; }
            ck_prep_a(cp, g, slot, scr, lane);
            if (mode != 3) { const int cn = (c + NPREP < NCH) ? c + NPREP : c; ck_load(P, g, rowbase + cn * 16, h, qi, lane); }
            ck_prep_b(slot, scr, lane);
            flags[p] = (unsigned)(c + 1);
        }
    }
}

__device__ __forceinline__ void scan_phase(KPtr P, LAS unsigned char* lds) {
    const int tid = tid_fresh(), lane = tid & 63, w = __builtin_amdgcn_readfirstlane(tid >> 6);
    const int bid = bid_fresh(), gdim = gdim_fresh();
#ifndef SCAN_REP_P
#define SCAN_REP_P 1
#endif
#ifndef SCAN_MODE2
#define SCAN_MODE2 0
#endif
#ifndef SCAN_REP_S
#define SCAN_REP_S 1
#endif
#ifdef SCAN_PRETOUCH
    {
        const int it = (gdim == 256) ? (((bid & 7) * 8 + (bid >> 5)) * 4 + ((bid >> 3) & 3)) : bid;
        const int b = it >> 6, h = (it >> 2) & 15, qi = it & 3;
        const bf16_t* RKV = (const bf16_t*)(P->ws + O_RKVB); const bf16_t* WL = (const bf16_t*)(P->ws + O_WL); const bf16_t* AL = (const bf16_t*)(P->ws + O_AL);
        unsigned acc = 0;
        for (int r = qi * 1024 + (tid >> 3); r < qi * 1024 + 1024; r += 64) {
            const size_t row = (size_t)b * TP + r; const int sub = tid & 7;
            for (int pc = sub; pc < 10; pc += 8) {
                const int seg = pc >> 1, half = pc & 1;
                const bf16_t* p = seg < 3 ? RKV + row * 3072 + seg * 1024 + h * 64 + half * 32 : (seg == 3 ? WL : AL) + row * 1024 + h * 64 + half * 32;
                acc += *(const unsigned*)p;
            }
        }
        if (acc == 0x12345678u) ((volatile LAS unsigned*)lds)[0] = acc;
        __syncthreads();
    }
#endif
    for (int rp_ = 0; rp_ < SCAN_REP_P; ++rp_)
    for (int it0 = bid; it0 < 256; it0 += gdim) {
        const int it = (gdim == 256) ? (((it0 & 7) * 8 + (it0 >> 5)) * 4 + ((it0 >> 3) & 3)) : it0;
        scan_chunked_item(P, lds, it, tid, rp_ == 0 ? 0 : SCAN_MODE2); __syncthreads(); }
    for (int rs_ = 0; rs_ < SCAN_REP_S; ++rs_)
    for (int it = bid; it < 512; it += gdim) {
        const int b = it >> 4, h = it & 15, rowbase = MP + b * TS, T = TS;
        const float* sin = P->in[2] + (size_t)(b * 16 + h) * 4096; float* sout = P->out + O_WKVS + (size_t)(b * 16 + h) * 4096;
        const int rr = lane >> 4, q = lane & 15; const int r0 = (w & 3) * 16 + rr;
        f32x4 s[4];
        PrepRegs pg;
        if (w < 4) {
#pragma unroll
            for (int k = 0; k < 4; ++k) s[k] = *(const f32x4*)(sin + (size_t)(r0 + 4 * k) * 64 + q * 4);
        } else { scan_prep_load(P, pg, rowbase, 0, T, h, 0, w - 4, lane); scan_prep_compute(P, pg, lds, h, w - 4, lane); }
        __syncthreads();
        LAS float* ob = (LAS float*)(lds + SC_OUT);
        if (w < 4) {
            const LAS float* fb = (const LAS float*)lds;
            f32x4 nkk = *(const LAS f32x4*)(fb + 0 * TC * 64 + q * 4), dw = *(const LAS f32x4*)(fb + 1 * TC * 64 + q * 4);
            f32x4 bb = *(const LAS f32x4*)(fb + 2 * TC * 64 + q * 4), kp = *(const LAS f32x4*)(fb + 3 * TC * 64 + q * 4);
            f32x4 r4 = *(const LAS f32x4*)(fb + 4 * TC * 64 + q * 4);
            float vv[4], keep[4]; float bon = fb[6 * TC * 64];
#pragma unroll
            for (int k = 0; k < 4; ++k) { vv[k] = fb[5 * TC * 64 + r0 + 4 * k]; keep[k] = 0.f; }
#pragma unroll
            for (int u = 0; u < 8; ++u) {
                const int tn = (u < 7 ? u + 1 : 7);
                const f32x4 nkk_n = *(const LAS f32x4*)(fb + 0 * TC * 64 + tn * 64 + q * 4), dw_n = *(const LAS f32x4*)(fb + 1 * TC * 64 + tn * 64 + q * 4);
                const f32x4 bb_n = *(const LAS f32x4*)(fb + 2 * TC * 64 + tn * 64 + q * 4), kp_n = *(const LAS f32x4*)(fb + 3 * TC * 64 + tn * 64 + q * 4);
                const f32x4 r4_n = *(const LAS f32x4*)(fb + 4 * TC * 64 + tn * 64 + q * 4);
                float vv_n[4]; const float bon_n = fb[6 * TC * 64 + tn];
#pragma unroll
                for (int k = 0; k < 4; ++k) vv_n[k] = fb[5 * TC * 64 + tn * 64 + r0 + 4 * k];
                float sa[4];
#pragma unroll
                for (int k = 0; k < 4; ++k) { float sa0 = s[k].x * nkk.x, sa1 = s[k].z * nkk.z; sa0 = fmaf(s[k].y, nkk.y, sa0); sa1 = fmaf(s[k].w, nkk.w, sa1); sa[k] = sa0 + sa1; }
#pragma unroll
                for (int k = 0; k < 4; ++k) sa[k] = row_sum16(sa[k]);
                float yy[4];
#pragma unroll
                for (int k = 0; k < 4; ++k) {
                    s[k] = s[k] * dw + bb * sa[k] + kp * vv[k];
                    float y0 = s[k].x * r4.x, y1 = s[k].z * r4.z; y0 = fmaf(s[k].y, r4.y, y0); y1 = fmaf(s[k].w, r4.w, y1); yy[k] = y0 + y1;
                }
#pragma unroll
                for (int k = 0; k < 4; ++k) yy[k] = row_sum16(yy[k]);
#pragma unroll
                for (int k = 0; k < 4; ++k) { const float val = (q < 8) ? yy[k] : bon * vv[k]; keep[k] = ((q & 7) == u) ? val : keep[k]; vv[k] = vv_n[k]; }
                nkk = nkk_n; dw = dw_n; bb = bb_n; kp = kp_n; r4 = r4_n; bon = bon_n;
            }
#pragma unroll
            for (int k = 0; k < 4; ++k) ob[(q < 8 ? 0 : TC * 64) + (q & 7) * 64 + r0 + 4 * k] = keep[k];
        }
        __syncthreads();
        if (w < 4) {
#pragma unroll
            for (int k = 0; k < 4; ++k) *(f32x4*)(sout + (size_t)(r0 + 4 * k) * 64 + q * 4) = s[k];
        } else scan_flush(P, ob, rowbase, 0, T, h, tid - 256);
        __syncthreads();
    }
}

constexpr int BIAS_LD = ATT_BIAS_LD_, BIAS_OFF = ATT_BIAS_OFF_;
constexpr int ATT_BIAS_BYTES = 3 * 16 * BIAS_LD * 4;
constexpr int ATT_WSCR = 12288;
__device__ __forceinline__ void vt_build(KPtr P, LAS unsigned char* lds, int it0, int itstep) {
    const int tid = tid_fresh();
    const bf16_t* VB = (const bf16_t*)(P->ws + O_VB); bf16_t* VT = (bf16_t*)(P->ws + O_VT);
    const bf16_t* KB = (const bf16_t*)(P->ws + O_KB); bf16_t* KT = (bf16_t*)(P->ws + O_KT);
    constexpr int PITCH = 136;
    for (int it = it0; it < 384; it += itstep) {
        const int g = it % 3, un = it / 3, b = un >> 5, kvh = (un >> 3) & 3, tb = un & 7;
        const int sh = 2 * g;
        const int nblk_loc = 16 >> sh;
        const int nblk_tot = 128 >> sh;
#pragma unroll 1
        for (int kv = 0; kv < 1; ++kv) {
            const bf16_t* src = kv ? KB : VB;
            __syncthreads();
#pragma unroll
            for (int q = 0; q < 8; ++q) {
                const int idx = q * 512 + tid, t = idx >> 3, ch = idx & 7;
                const u32x4 v = *(const u32x4*)(src + ((size_t)(b * TP + tb * 512 + t)) * 256 + kvh * 64 + ch * 8);
                LAS u32x2* d = (LAS u32x2*)(lds + t * PITCH + ch * 16);
                d[0] = (u32x2){v.x, v.y}; d[1] = (u32x2){v.z, v.w};
            }
            __syncthreads();
            if (kv == 0) {
#pragma unroll 1
                for (int q = 0; q < 8; ++q) {
                    const int idx = q * 512 + tid;
                    const int oct = idx & 3, dim = (idx >> 2) & 63, cb = idx >> 8;
                    const int cls = cb / nblk_loc, lb = cb % nblk_loc;
                    unsigned short e[8];
#pragma unroll
                    for (int i = 0; i < 8; ++i) { const int pp = 16 * (oct >> 1) + 8 * (i >> 2) + 4 * (oct & 1) + (i & 3);
                        const int tl = ((lb * 32 + pp) << sh) + cls; e[i] = *(const LAS unsigned short*)(lds + tl * PITCH + dim * 2); }
                    u32x4 o; o.x = e[0] | ((unsigned)e[1] << 16); o.y = e[2] | ((unsigned)e[3] << 16); o.z = e[4] | ((unsigned)e[5] << 16); o.w = e[6] | ((unsigned)e[7] << 16);
                    const int blk = tb * nblk_loc + lb;
                    const int inner = ((((oct >> 1) * 2 + (dim >> 5)) * 2 + (oct & 1)) * 32 + (dim & 31)) * 8;
                    *(u32x4*)(VT + (size_t)g * VT_COPY + (size_t)((((b * 4 + kvh) << sh) + cls) * nblk_tot + blk) * 2048 + inner) = o;
                }
            } else {
#pragma unroll 1
                for (int q = 0; q < 8; ++q) {
                    const int idx = q * 512 + tid;
                    const int key = idx & 31, p = (idx >> 5) & 7, cb = idx >> 8;
                    const int cls = cb / nblk_loc, lb = cb % nblk_loc;
                    const int tl = ((lb * 32 + key) << sh) + cls;
                    const LAS u32x2* sp = (const LAS u32x2*)(lds + tl * PITCH + p * 16);
                    const u32x2 a0 = sp[0], a1 = sp[1];
                    const int blk = tb * nblk_loc + lb;
                    *(u32x4*)(KT + (size_t)g * VT_COPY + (size_t)((((b * 4 + kvh) << sh) + cls) * nblk_tot + blk) * 2048 + (p * 32 + key) * 8) = (u32x4){a0.x, a0.y, a1.x, a1.y};
                }
            }
        }
    }
    __syncthreads();
}
__device__ __forceinline__ void attn_phase(KPtr P, LAS unsigned char* lds) {
    const int tid = tid_fresh(), lane = tid & 63, w = __builtin_amdgcn_readfirstlane(tid >> 6);
    LAS float* bias = (LAS float*)lds;
    { const f32x4* gb = (const f32x4*)(P->ws + O_BIAS);
      for (int e = tid; e < 3 * 16 * BIAS_LD / 4; e += NTHREADS) ((LAS f32x4*)bias)[e] = gb[e]; }
    volatile LAS unsigned* ctr = (volatile LAS unsigned*)(lds + ATT_BIAS_BYTES + 4 * ATT_WSCR);
    if (tid == 0) ctr[0] = 0u;
    __syncthreads();
    const bf16_t* Q = (const bf16_t*)(P->ws + O_Q); const bf16_t* KT = (const bf16_t*)(P->ws + O_KT); const bf16_t* VT = (const bf16_t*)(P->ws + O_VT);
    bf16_t* ATT = (bf16_t*)(P->ws + O_ATT);
    const int bidx = bid_fresh(), gdimx = gdim_fresh();
    const int n = lane & 31, hh = lane >> 5, r = n >> 3, iq = n & 7;
    LAS float* qsc = (LAS float*)(lds + ATT_BIAS_BYTES + w * ATT_WSCR);
    LAS float* psc = qsc + 768;
    const float* cache = P->in[4]; const float* kvs = P->out + O_KVS;
#ifndef ATT_REP_S
#define ATT_REP_S 1
#endif
#ifndef ATT_MODE2
#define ATT_MODE2 0
#endif
#ifndef ATT_REP_P
#define ATT_REP_P 1
#endif
    if (w < 4)
    for (int reps_ = 0; reps_ < ATT_REP_S; ++reps_)
    for (int it = bidx * 4 + w; it < 1024; it += gdimx * 4) {
        const int b = it >> 5, t = (it >> 2) & 7, kvh = it & 3;
        const size_t qrow = (size_t)MP + b * TS + t;
        for (int e = lane; e < 768; e += 64) { const int g = e >> 8, rr2 = (e >> 6) & 3, d = e & 63; qsc[e] = bf2f(Q[qrow * 3072 + g * 1024 + kvh * 256 + rr2 * 64 + d]); }
        asm volatile("s_waitcnt lgkmcnt(0)" ::: "memory");
        float mx0 = -1e30f, mx1 = -1e30f, mx2 = -1e30f, mx3 = -1e30f;
#pragma unroll 1
        for (int gj = 0; gj < 9; ++gj) {
            const int g = gj / 3, jb = gj % 3, sh = 2 * g;
            const int j = jb * 64 + lane; const bool valid = j <= 128; const int jc = valid ? j : 128;
            const int pext = 2048 + t - (jc << sh);
            const float* kp = pext < 2048 ? cache + ((size_t)(b * 2048 + pext) * 2) * 256 + kvh * 64 : kvs + (size_t)(b * TS + (pext - 2048)) * 512 + kvh * 64;
            float d0 = 0.f, d1 = 0.f, d2 = 0.f, d3 = 0.f;
#pragma unroll 4
            for (int dd = 0; dd < 16; ++dd) {
                const f32x4 kv = *(const f32x4*)(kp + dd * 4);
                const f32x4 q0 = *(const LAS f32x4*)(qsc + g * 256 + 0 * 64 + dd * 4), q1 = *(const LAS f32x4*)(qsc + g * 256 + 1 * 64 + dd * 4);
                const f32x4 q2 = *(const LAS f32x4*)(qsc + g * 256 + 2 * 64 + dd * 4), q3 = *(const LAS f32x4*)(qsc + g * 256 + 3 * 64 + dd * 4);
                d0 += (kv.x * q0.x + kv.y * q0.y) + (kv.z * q0.z + kv.w * q0.w); d1 += (kv.x * q1.x + kv.y * q1.y) + (kv.z * q1.z + kv.w * q1.w);
                d2 += (kv.x * q2.x + kv.y * q2.y) + (kv.z * q2.z + kv.w * q2.w); d3 += (kv.x * q3.x + kv.y * q3.y) + (kv.z * q3.z + kv.w * q3.w);
            }
            const LAS float* bb = bias + (g * 16 + kvh * 4) * BIAS_LD + (BIAS_OFF - jc);
            const float v0 = valid ? d0 + bb[0] : -1e30f, v1 = valid ? d1 + bb[BIAS_LD] : -1e30f, v2 = valid ? d2 + bb[2 * BIAS_LD] : -1e30f, v3 = valid ? d3 + bb[3 * BIAS_LD] : -1e30f;
            psc[(g * 4 + 0) * 192 + j] = v0; psc[(g * 4 + 1) * 192 + j] = v1; psc[(g * 4 + 2) * 192 + j] = v2; psc[(g * 4 + 3) * 192 + j] = v3;
            mx0 = fmaxf(mx0, v0); mx1 = fmaxf(mx1, v1); mx2 = fmaxf(mx2, v2); mx3 = fmaxf(mx3, v3);
        }
#pragma unroll
        for (int o = 1; o < 64; o <<= 1) { mx0 = fmaxf(mx0, __shfl_xor(mx0, o)); mx1 = fmaxf(mx1, __shfl_xor(mx1, o)); mx2 = fmaxf(mx2, __shfl_xor(mx2, o)); mx3 = fmaxf(mx3, __shfl_xor(mx3, o)); }
        asm volatile("s_waitcnt lgkmcnt(0)" ::: "memory");
        float s0 = 0.f, s1 = 0.f, s2 = 0.f, s3 = 0.f;
#pragma unroll 1
        for (int gj = 0; gj < 9; ++gj) {
            const int g = gj / 3, j = (gj % 3) * 64 + lane;
            LAS float* pp = psc + (g * 4) * 192 + j;
            const float l0 = pp[0], l1 = pp[192], l2 = pp[384], l3 = pp[576];
            const float p0 = l0 > -1e29f ? __builtin_amdgcn_exp2f(l0 - mx0) : 0.f, p1 = l1 > -1e29f ? __builtin_amdgcn_exp2f(l1 - mx1) : 0.f, p2 = l2 > -1e29f ? __builtin_amdgcn_exp2f(l2 - mx2) : 0.f, p3 = l3 > -1e29f ? __builtin_amdgcn_exp2f(l3 - mx3) : 0.f;
            pp[0] = p0; pp[192] = p1; pp[384] = p2; pp[576] = p3;
            s0 += p0; s1 += p1; s2 += p2; s3 += p3;
        }
        s0 = wave_sum(s0); s1 = wave_sum(s1); s2 = wave_sum(s2); s3 = wave_sum(s3);
        asm volatile("s_waitcnt lgkmcnt(0)" ::: "memory");
        const int ksub = lane >> 4, dq = (lane & 15) * 4;
        f32x4 oa0 = (f32x4){0.f, 0.f, 0.f, 0.f}, oa1 = oa0, oa2 = oa0, oa3 = oa0;
#pragma unroll 1
        for (int g = 0; g < 3; ++g) {
            const int sh = 2 * g;
#pragma unroll 11
            for (int j0 = 0; j0 < 132; j0 += 4) {
                const int j = j0 + ksub; const int jc = j > 128 ? 128 : j;
                const int pext = 2048 + t - (jc << sh);
                const float* vp = pext < 2048 ? cache + ((size_t)(b * 2048 + pext) * 2 + 1) * 256 + kvh * 64 + dq : kvs + (size_t)(b * TS + (pext - 2048)) * 512 + 256 + kvh * 64 + dq;
                const f32x4 vv = *(const f32x4*)vp;
                const LAS float* pp = psc + (g * 4) * 192 + jc;
                const bool ok = j <= 128;
                const float p0 = ok ? pp[0] : 0.f, p1 = ok ? pp[192] : 0.f, p2 = ok ? pp[384] : 0.f, p3 = ok ? pp[576] : 0.f;
                oa0 = oa0 + vv * p0; oa1 = oa1 + vv * p1; oa2 = oa2 + vv * p2; oa3 = oa3 + vv * p3;
            }
        }
#pragma unroll
        for (int e = 0; e < 4; ++e) {
            oa0[e] += __shfl_xor(oa0[e], 16); oa0[e] += __shfl_xor(oa0[e], 32); oa1[e] += __shfl_xor(oa1[e], 16); oa1[e] += __shfl_xor(oa1[e], 32);
            oa2[e] += __shfl_xor(oa2[e], 16); oa2[e] += __shfl_xor(oa2[e], 32); oa3[e] += __shfl_xor(oa3[e], 16); oa3[e] += __shfl_xor(oa3[e], 32);
        }
        if (ksub == 0) {
            bf16_t* op = ATT + qrow * D + kvh * 256 + dq;
            const float i0 = 1.f / s0, i1 = 1.f / s1, i2 = 1.f / s2, i3 = 1.f / s3;
            u32x2 wv;
            wv.x = pk2(oa0.x * i0, oa0.y * i0); wv.y = pk2(oa0.z * i0, oa0.w * i0); *(u32x2*)(op) = wv;
            wv.x = pk2(oa1.x * i1, oa1.y * i1); wv.y = pk2(oa1.z * i1, oa1.w * i1); *(u32x2*)(op + 64) = wv;
            wv.x = pk2(oa2.x * i2, oa2.y * i2); wv.y = pk2(oa2.z * i2, oa2.w * i2); *(u32x2*)(op + 128) = wv;
            wv.x = pk2(oa3.x * i3, oa3.y * i3); wv.y = pk2(oa3.z * i3, oa3.w * i3); *(u32x2*)(op + 192) = wv;
        }
        asm volatile("s_waitcnt lgkmcnt(0)" ::: "memory");
    }
    const int per_cu = (4096 + gdimx - 1) / gdimx;
    for (;;) {
        int kx = 0;
        if (lane == 0) kx = (int)__hip_atomic_fetch_add((LAS unsigned*)ctr, 1u, __ATOMIC_RELAXED, __HIP_MEMORY_SCOPE_WORKGROUP);
        kx = __builtin_amdgcn_readfirstlane(kx);
        if (kx >= per_cu * ATT_REP_P) break;
        const int amode = (kx >= per_cu) ? ATT_MODE2 : 0;
        kx = kx % per_cu;
        const int it = bidx * per_cu + kx;
        if (it >= 4096) break;
        const int b = it >> 10, rem = it & 1023, kvh = rem >> 8, tg = rem & 255;
        const int tbase = (tg >> 4) * 256 + (tg & 15);
        const size_t qrowA = (size_t)b * TP + tbase + 16 * iq, qrowB = qrowA + 128;
        float mA = -1e4f, lA = 0.f, mB = -1e4f, lB = 0.f;
        f32x16 oA0, oA1, oB0, oB1;
#pragma unroll
        for (int e = 0; e < 16; ++e) { oA0[e] = 0.f; oA1[e] = 0.f; oB0[e] = 0.f; oB1[e] = 0.f; }
#pragma unroll 1
        for (int g = 0; g < 3; ++g) {
            const int sh = 2 * g, dmask = (1 << sh) - 1;
            const int c = tbase & dmask, u0 = tbase >> sh, qs = 16 >> sh;
            bf16x8 qfA[4], qfB[4];
            { const bf16_t* qp = Q + qrowA * 3072 + g * 1024 + kvh * 256 + r * 64 + hh * 8;
#pragma unroll
              for (int ks = 0; ks < 4; ++ks) { qfA[ks] = *(const bf16x8*)(qp + ks * 16); qfB[ks] = *(const bf16x8*)(qp + (size_t)128 * 3072 + ks * 16); } }
            const int ustart = (u0 - 128) & ~31;
            const int ntile = ((u0 + 15 * qs) >> 5) - (ustart >> 5) + 1;
            const int tau0 = ustart < 0 ? ((-ustart) >> 5) : 0;
            const int uqA = u0 + qs * iq, uqB = uqA + 8 * qs;
            const int tA1 = ((u0 + 7 * qs) - ustart) >> 5;
            const int tB0 = ((u0 + 8 * qs - 128) - ustart) >> 5;
            const size_t tile0 = (size_t)((((b * 4 + kvh) << sh) + c) * (128 >> sh) + (ustart >> 5)) * 2048;
            const bf16_t* Kg = KT + (size_t)g * VT_COPY + tile0 + hh * 256 + n * 8;
            const bf16_t* Vg = VT + (size_t)g * VT_COPY + tile0 + hh * 256 + n * 8;
            const LAS float* btA = bias + (g * 16 + kvh * 4 + r) * BIAS_LD + (BIAS_OFF - (uqA - ustart) + 4 * hh);
            const LAS float* btB = btA - 8 * qs;
            bf16x8 kfA[4], vfA[2][2], kfB[4], vfB[2][2];
#define ATT_LOAD(KF, VF, TAU) do { if (amode == 1 && (TAU) != tau0) break; \
                const bf16_t* kp_ = Kg + (size_t)(TAU) * 2048; \
                if (amode != 4) { _Pragma("unroll") for (int ks = 0; ks < 4; ++ks) KF[ks] = *(const bf16x8*)(kp_ + ks * 512); } \
                if (amode == 3) break; \
                const bf16_t* vb_ = Vg + (size_t)(TAU) * 2048; \
                _Pragma("unroll") for (int sI = 0; sI < 2; ++sI) { \
                    _Pragma("unroll") for (int dt = 0; dt < 2; ++dt) VF[sI][dt] = *(const bf16x8*)(vb_ + (sI * 2 + dt) * 512); } } while (0)
#define ATT_BLOCK(KF, VF, TAU, QF, BT0, MR, LR, O0, O1) do { \
                f32x16 S; _Pragma("unroll") for (int e = 0; e < 16; ++e) S[e] = 0.f; \
                _Pragma("unroll") for (int ks = 0; ks < 4; ++ks) S = __builtin_amdgcn_mfma_f32_32x32x16_bf16(KF[ks], QF[ks], S, 0, 0, 0); \
                const LAS float* bt = BT0 + 32 * (TAU); \
                float mx = -1e30f; \
                _Pragma("unroll") for (int e = 0; e < 16; ++e) { S[e] += bt[(e >> 2) * 8 + (e & 3)]; } \
                _Pragma("unroll") for (int e = 0; e < 16; ++e) mx = fmaxf(mx, S[e]); \
                mx = fmaxf(mx, __shfl_xor(mx, 32)); \
                if (__any(mx > MR + 8.0f)) { const float m_new = fmaxf(MR, mx); const float alpha = __builtin_amdgcn_exp2f(MR - m_new); MR = m_new; LR *= alpha; \
                    _Pragma("unroll") for (int e = 0; e < 16; ++e) { O0[e] *= alpha; O1[e] *= alpha; } } \
                float ps = 0.f; \
                _Pragma("unroll") for (int e = 0; e < 16; ++e) { const float p = __builtin_amdgcn_exp2f(S[e] - MR); S[e] = p; ps += p; } \
                LR += ps; \
                _Pragma("unroll") for (int sI = 0; sI < 2; ++sI) { \
                    u32x4 pw; pw.x = pk2(S[8 * sI + 0], S[8 * sI + 1]); pw.y = pk2(S[8 * sI + 2], S[8 * sI + 3]); pw.z = pk2(S[8 * sI + 4], S[8 * sI + 5]); pw.w = pk2(S[8 * sI + 6], S[8 * sI + 7]); \
                    const bf16x8 pb = __builtin_bit_cast(bf16x8, pw); \
                    O0 = __builtin_amdgcn_mfma_f32_32x32x16_bf16(VF[sI][0], pb, O0, 0, 0, 0); \
                    O1 = __builtin_amdgcn_mfma_f32_32x32x16_bf16(VF[sI][1], pb, O1, 0, 0, 0); } } while (0)
#define ATT_TILE(KF, VF, TAU) do { if (amode >= 2) { asm volatile("" :: "v"(KF[0]), "v"(KF[3]), "v"(VF[0][0]), "v"(VF[1][1])); break; } \
                if ((TAU) <= tA1) ATT_BLOCK(KF, VF, TAU, qfA, btA, mA, lA, oA0, oA1); \
                if ((TAU) >= tB0) ATT_BLOCK(KF, VF, TAU, qfB, btB, mB, lB, oB0, oB1); } while (0)
            ATT_LOAD(kfA, vfA, tau0);
            int tau = tau0;
#pragma unroll 1
            for (; tau + 1 < ntile; tau += 2) {
                ATT_LOAD(kfB, vfB, tau + 1);
                ATT_TILE(kfA, vfA, tau);
                { const int tn = (tau + 2 < ntile) ? tau + 2 : tau + 1; ATT_LOAD(kfA, vfA, tn); }
                ATT_TILE(kfB, vfB, tau + 1);
            }
            if (tau < ntile) ATT_TILE(kfA, vfA, tau);
#undef ATT_LOAD
#undef ATT_BLOCK
#undef ATT_TILE
        }
#define ATT_OUT(QROW, LR, O0, O1) do { \
            const float lt = LR + __shfl_xor(LR, 32); const float inv = 1.f / lt; \
            bf16_t* op = ATT + (QROW) * D + kvh * 256 + r * 64 + hh * 4; \
            _Pragma("unroll") for (int e4 = 0; e4 < 4; ++e4) { \
                u32x2 w0; w0.x = pk2(O0[e4 * 4 + 0] * inv, O0[e4 * 4 + 1] * inv); w0.y = pk2(O0[e4 * 4 + 2] * inv, O0[e4 * 4 + 3] * inv); \
                u32x2 w1; w1.x = pk2(O1[e4 * 4 + 0] * inv, O1[e4 * 4 + 1] * inv); w1.y = pk2(O1[e4 * 4 + 2] * inv, O1[e4 * 4 + 3] * inv); \
                if (amode == 0) { *(u32x2*)(op + e4 * 8) = w0; *(u32x2*)(op + 32 + e4 * 8) = w1; } else { asm volatile("" :: "v"(w0), "v"(w1)); } } } while (0)
        ATT_OUT(qrowA, lA, oA0, oA1);
        ATT_OUT(qrowB, lB, oB0, oB1);
#undef ATT_OUT
    }
}

#define XB_TMO      128
#define XB_XCNT(j)  (256  + 64 * (j))
#define XB_XSUB(j)  (1280 + 64 * (j))
#define XB_XGEN(j)  (2304 + 64 * (j))
#define XB_TOP      3328
#define XB_TOPGEN   3392
#define XCD_BAR_WORDS 3456
#define XB_SPIN_CAP (1u << 18)
__device__ __forceinline__ unsigned xb_ld(unsigned* p)              { return __hip_atomic_load(p, __ATOMIC_RELAXED, __HIP_MEMORY_SCOPE_AGENT); }
__device__ __forceinline__ unsigned xb_add(unsigned* p, unsigned v) { return __hip_atomic_fetch_add(p, v, __ATOMIC_RELAXED, __HIP_MEMORY_SCOPE_AGENT); }
__device__ __forceinline__ unsigned xb_xcc_id() { return (unsigned)__builtin_amdgcn_s_getreg((3 << 11) | 20) & 0xFu; }
#define XB_SPIN(cond, bar) do { unsigned _sp = 0; while (cond) { __builtin_amdgcn_s_sleep(1); \
    if ((++_sp & 255u) == 0u) { if (xb_ld(&(bar)[XB_TMO])) break; if (_sp > XB_SPIN_CAP) { atomicAdd(&(bar)[XB_TMO], 1u); break; } } } } while (0)
struct XcdBarrier { unsigned* bar; unsigned x; volatile LAS unsigned* st; };
__device__ __forceinline__ XcdBarrier xcd_barrier_post(unsigned* bar, volatile LAS unsigned* st) {
    XcdBarrier b; b.bar = bar; b.x = xb_xcc_id(); b.st = st;
    if (threadIdx.x == 0) (void)xb_add(&bar[XB_XCNT(b.x)], 1u);
    return b;
}
__device__ __forceinline__ void xcd_barrier_complete(unsigned* bar, unsigned x, unsigned& nloc, unsigned& nx) {
    const unsigned G = gridDim.x * gridDim.y * gridDim.z;
    unsigned sum, cnt, mine, sp = 0u;
    for (;;) {
        sum = 0u; cnt = 0u; mine = 0u;
#pragma unroll
        for (unsigned j = 0; j < 16; ++j) { const unsigned c = xb_ld(&bar[XB_XCNT(j)]); sum += c; cnt += (c > 0u) ? 1u : 0u; mine = (j == x) ? c : mine; }
        if (sum == G) break;
        __builtin_amdgcn_s_sleep(1);
        if ((++sp & 255u) == 0u) { if (xb_ld(&bar[XB_TMO])) break; if (sp > XB_SPIN_CAP) { atomicAdd(&bar[XB_TMO], 1u); break; } }
    }
    nloc = mine > 0u ? mine : 1u; nx = cnt > 0u ? cnt : 1u;
}
__device__ __forceinline__ void xcd_barrier(const XcdBarrier& b, const unsigned* wptr = nullptr, unsigned wlines = 0u, const unsigned* wptr2 = nullptr, unsigned wlines2 = 0u, unsigned char* tabws = nullptr, int tabph = -1) {
    asm volatile("s_waitcnt vmcnt(0)" ::: "memory");
    __syncthreads();
    unsigned tacc = 0u;
#ifndef NO_WARM
    if (wptr != nullptr && threadIdx.x >= 64) {
        for (unsigned line = blockIdx.x * 448u + (threadIdx.x - 64u); line < wlines; line += gridDim.x * 448u) tacc += wptr[(size_t)line * 32];
        if (wptr2 != nullptr) for (unsigned line = blockIdx.x * 448u + (threadIdx.x - 64u); line < wlines2; line += gridDim.x * 448u) tacc += wptr2[(size_t)line * 32];
    }
#endif
    if (tabph >= 0) {
        const int tq = tid_fresh();
        if ((tq >> 6) == 1) {
            const int li = tq & 63;
            Unit tu; tu.A = nullptr; tu.B = nullptr; tu.pitchA = 0; tu.pitchB = 0; tu.nt = 0; tu.si = 0; tu.pm = 0; tu.pn = 0; tu.wait = 0; tu.eph = 0;
            const bool ok = next_unit(tabws, tabph, li, gdim_fresh(), bid_fresh(), tu, 0);
            if (li < 9) {
                volatile LAS unsigned* te = b.st + 32 + li * 12;
                const unsigned long long ua = (unsigned long long)tu.A, ub = (unsigned long long)tu.B;
                te[0] = ok ? 1u : 0u; te[1] = (unsigned)ua; te[2] = (unsigned)(ua >> 32); te[3] = (unsigned)ub; te[4] = (unsigned)(ub >> 32);
                te[5] = (unsigned)tu.pitchA; te[6] = (unsigned)tu.pitchB; te[7] = (unsigned)tu.nt; te[8] = (unsigned)tu.si; te[9] = (unsigned)tu.pm; te[10] = (unsigned)tu.pn; te[11] = (unsigned)tu.wait | ((unsigned)tu.eph << 8);
            }
        }
    }
    if (threadIdx.x == 0) {
        unsigned* bar = b.bar;
        __builtin_amdgcn_s_waitcnt(0);
        unsigned nloc = b.st[0], nx = b.st[1];
        if (nloc == 0u) { xcd_barrier_complete(bar, b.x, nloc, nx); b.st[0] = nloc; b.st[1] = nx; }
        const unsigned old = xb_add(&bar[XB_XSUB(b.x)], 1u);
        const unsigned gen = old / nloc;
        if (old + 1u == (gen + 1u) * nloc) {
            __builtin_amdgcn_fence(__ATOMIC_RELEASE, "agent");
            asm volatile("s_waitcnt vmcnt(0)" ::: "memory");
            const unsigned og = xb_add(&bar[XB_TOP], 1u);
            const unsigned tg = og / nx;
            asm volatile("buffer_inv sc1" ::: "memory");
            if (og + 1u == (tg + 1u) * nx) xb_add(&bar[XB_TOPGEN], 1u);
            else XB_SPIN(xb_ld(&bar[XB_TOPGEN]) == tg, bar);
            xb_add(&bar[XB_XGEN(b.x)], 1u);
            asm volatile("s_waitcnt vmcnt(0)" ::: "memory");
        } else {
            asm volatile("buffer_inv sc1" ::: "memory");
            XB_SPIN(xb_ld(&bar[XB_XGEN(b.x)]) == gen, bar);
            asm volatile("s_waitcnt vmcnt(0)" ::: "memory");
        }
    }
    __syncthreads();
    if (tacc == 0x9e3779b9u) b.st[8] = tacc;
}
__device__ __forceinline__ bool phase_weights(int ph, size_t& off, unsigned& bytes) {
    switch (ph) {
    case PH_F1O0: off = W_F1O; bytes = 5767168u; return true;
    case PH_RKV: off = W_RKV; bytes = 7864320u; return true;
    case PH_L2: off = W_L2W; bytes = 1048576u; return true;
    case PH_RWO: off = W_RWO; bytes = 2097152u; return true;
    case PH_F2I0: off = W_F2I; bytes = 11534336u; return true;
    case PH_F2O0: off = W_F2O; bytes = 5767168u; return true;
    case PH_PE0: off = W_PEG; bytes = 2097152u; return true;
    case PH_F1I1: off = W_F1I + 11534336u; bytes = 11534336u; return true;
    case PH_F1O1: off = W_F1O + 5767168u; bytes = 5767168u; return true;
    case PH_QKV: off = W_Q; bytes = 7340032u; return true;
    case PH_AO: off = W_AO; bytes = 2097152u; return true;
    case PH_F2I1: off = W_F2I + 11534336u; bytes = 11534336u; return true;
    case PH_F2O1: off = W_F2O + 5767168u; bytes = 5767168u; return true;
    case PH_PE1: off = W_PEG + 2097152u; bytes = 2097152u; return true;
    default: return false;
    }
}

constexpr int LDS_BYTES = LDS_BYTES_ALL; static_assert(ATT_BIAS_BYTES + 4 * ATT_WSCR + 64 <= LDS_CTL_OFF && STAGE_BYTES <= LDS_CTL_OFF, "LDS");
template <bool FB>
__global__ void __launch_bounds__(NTHREADS, 2) fwd_kernel(Params P) {
    extern __shared__ __attribute__((aligned(16))) unsigned char lds_raw[];
    LAS unsigned char* lds = (LAS unsigned char*)lds_raw;
    (void)P;
#ifdef CODE_PREFETCH
    {
        const char* pcb = (const char*)((unsigned long long)__builtin_amdgcn_s_getpc() & ~0xFFull);
        u32x4 acc = (u32x4){0u, 0u, 0u, 0u};
        for (int off = (int)threadIdx.x * 16; off < CODE_PREFETCH; off += NTHREADS * 16) { const u32x4 v = *(const u32x4*)(pcb + off); acc.x ^= v.x; acc.y ^= v.y; acc.z ^= v.z; acc.w ^= v.w; }
        if ((acc.x ^ acc.y ^ acc.z ^ acc.w) == 0x9e3779b9u && threadIdx.x == 12345u) ((volatile LAS unsigned*)lds)[0] = acc.x;
    }
#endif
    volatile LAS unsigned* bst = (volatile LAS unsigned*)(lds + LDS_CTL_OFF);
    if (threadIdx.x < 4) bst[threadIdx.x] = 0u;
    __syncthreads();
    { KPtr kp = kp_fresh(); (void)xcd_barrier_post((unsigned*)(kp->ws + O_CTL), bst); }
#ifndef REPEAT_MASK
#define REPEAT_MASK 0
#endif
#ifndef DRY_MASK
#define DRY_MASK 0
#endif
#ifndef ZS_MASK
#define ZS_MASK 0
#endif
#ifndef EXTRA_SYNCS
#define EXTRA_SYNCS 0
#endif
#ifdef AMP_MASK
    long long t0amp = wall_clock64();
#endif
#pragma unroll 1
    for (int ph = 0; ph < NPH; ++ph) {
      const int reps = (((REPEAT_MASK | DRY_MASK | ZS_MASK) >> ph) & 1) ? 2 : 1;
#pragma unroll 1
      for (int rep = 0; rep < reps; ++rep) {
#ifdef REP_BARRIER
        if (rep > 0) { KPtr kp = kp_fresh(); XcdBarrier xb; xb.bar = (unsigned*)(kp->ws + O_CTL); xb.x = xb_xcc_id(); xb.st = (volatile LAS unsigned*)(lds + LDS_CTL_OFF); xcd_barrier(xb); }
#endif
        if (ph == PH_PRO) {
#ifndef NO_PRO
            prologue_phase(kp_fresh(), lds);
#endif
        }
        else if (ph == PH_MIX) {
#ifndef NO_ROW
            mix_pass(kp_fresh());
#endif
        }
        else if (ph == PH_SCAN) {
#ifndef NO_SCAN
            scan_phase(kp_fresh(), lds);
#endif
        }
        else if (ph == PH_POST) {
#ifndef NO_ROW
            post_pass(kp_fresh());
#endif
        }
        else if (ph == PH_ATTN) {
#ifndef NO_ATTN
            if (gdim_fresh() != 256) {
                vt_build(kp_fresh(), lds, bid_fresh(), gdim_fresh());
                { KPtr kp = kp_fresh(); XcdBarrier xb; xb.bar = (unsigned*)(kp->ws + O_CTL); xb.x = xb_xcc_id(); xb.st = (volatile LAS unsigned*)(lds + LDS_CTL_OFF); xcd_barrier(xb); }
            }
            attn_phase(kp_fresh(), lds);
#endif
        }
        else if (ph == PH_FINAL) {
#ifndef NO_ROW
            final_pass(kp_fresh());
#endif
        }
        else {
#ifndef NO_GEMM
#pragma unroll 1
            for (int pass2 = 0; pass2 < 2; ++pass2) {
                KPtr kp = kp_fresh();
                if (pass2) {
                    if (!(ph == PH_F2I1 && gdim_fresh() == 256 && bid_fresh() >= 252)) break;
                    if (threadIdx.x < 64) {
                        unsigned* dep = (unsigned*)(kp->ws + O_CTL) + CW_DEP + (20 + ph) * 64; unsigned sp = 0;
                        asm volatile("buffer_inv sc1" ::: "memory");
                        while ((unsigned)__builtin_amdgcn_readfirstlane(__hip_atomic_load(dep, __ATOMIC_RELAXED, __HIP_MEMORY_SCOPE_AGENT)) < 4u) { __builtin_amdgcn_s_sleep(2); if (++sp > (1u << 22)) break; }
                        asm volatile("s_waitcnt vmcnt(0)" ::: "memory");
                    }
                    __syncthreads();
                }
                gemm_phase<FB>(kp->ws, kp->out, lds, ph, (rep == 0 && ((DRY_MASK >> ph) & 1)) ? 1 : ((rep == 0 && ((ZS_MASK >> ph) & 1)) ? 2 : 0), pass2);
            }
#endif
            if (ph == PH_QKV && gdim_fresh() == 256 && bid_fresh() >= 12 && bid_fresh() < 126) {
                KPtr kp = kp_fresh();
                if (threadIdx.x < 64) {
                    unsigned* dep = (unsigned*)(kp->ws + O_CTL) + CW_DEP + (48 + PH_QKV) * 64; unsigned sp = 0;
                    asm volatile("buffer_inv sc1" ::: "memory");
                    while ((unsigned)__builtin_amdgcn_readfirstlane(__hip_atomic_load(dep, __ATOMIC_RELAXED, __HIP_MEMORY_SCOPE_AGENT)) < 130u) { __builtin_amdgcn_s_sleep(2); if (++sp > (1u << 22)) break; }
                    asm volatile("s_waitcnt vmcnt(0)" ::: "memory");
                }
                __syncthreads();
                vt_build(kp, lds, bid_fresh() - 12, 114);
            }
        }
      }
        if (ph + 1 < NPH) { KPtr kp = kp_fresh(); XcdBarrier xb; xb.bar = (unsigned*)(kp->ws + O_CTL); xb.x = xb_xcc_id(); xb.st = (volatile LAS unsigned*)(lds + LDS_CTL_OFF);
            size_t woff = 0, woff2 = 0; unsigned wbytes = 0u, wbytes2 = 0u; const bool hasw = phase_weights(ph + 1, woff, wbytes);
            bool hasw2 = false;
            if (is_wi(ph + 1)) { hasw2 = phase_weights(ph + 2, woff2, wbytes2); if (ph + 1 == PH_F2I1) wbytes2 += 4194304u; }
            const int np = ph + 1;
            const bool ngemm = !(np == PH_PRO || np == PH_MIX || np == PH_SCAN || np == PH_POST || np == PH_ATTN || np == PH_FINAL);
            xcd_barrier(xb, hasw ? (const unsigned*)(kp->ws + woff) : nullptr, wbytes >> 7, hasw2 ? (const unsigned*)(kp->ws + woff2) : nullptr, wbytes2 >> 7, kp->ws, ngemm ? np : -1); }
#ifdef AMP_MASK
        if (((AMP_MASK >> ph) & 1) && bid_fresh() == 0) { const long long t1 = wall_clock64(); const long long tend = t1 + (long long)AMP_K * (t1 - t0amp); while (wall_clock64() < tend) __builtin_amdgcn_s_sleep(32); }
        t0amp = wall_clock64();
#endif
    }
}

extern "C" void kernel_launch(void* const* d_in, const int* in_sizes, int n_in, void* d_out, int out_size, void* d_ws, size_t ws_size, hipStream_t stream) {
    static int grid_blocks = 0;
    static const void* kfn = nullptr;
    if (grid_blocks == 0) {
        if (n_in != 36 || ws_size < WS_END) { fprintf(stderr, "kernel_launch: unexpected n_in %d or ws_size %zu (< %zu)\n", n_in, ws_size, (size_t)WS_END); grid_blocks = -1; return; }
        int dev = 0, cus = 0, per_cu = 0;
        hipGetDevice(&dev);
        hipDeviceGetAttribute(&cus, hipDeviceAttributeMultiprocessorCount, dev);
        kfn = (cus >= 192) ? (const void*)fwd_kernel<false> : (const void*)fwd_kernel<true>;
        hipFuncSetAttribute(kfn, hipFuncAttributeMaxDynamicSharedMemorySize, LDS_BYTES);
        hipOccupancyMaxActiveBlocksPerMultiprocessor(&per_cu, kfn, NTHREADS, LDS_BYTES);
        if (per_cu < 1) { fprintf(stderr, "kernel_launch: occupancy query says %d blocks per CU\n", per_cu); grid_blocks = -1; return; }
        grid_blocks = cus;
    }
    if (grid_blocks < 0) return;
    if (hipMemsetAsync((char*)d_ws + O_CTL, 0, CTL_BYTES, stream) != hipSuccess) { fprintf(stderr, "kernel_launch: memset failed\n"); return; }
    Params p{};
    for (int i = 0; i < 36; ++i) p.in[i] = (const float*)d_in[i];
    p.out = (float*)d_out; p.ws = (unsigned char*)d_ws;
    void* args[] = {&p};
    hipError_t e = hipLaunchCooperativeKernel(kfn, dim3(grid_blocks), dim3(NTHREADS), args, LDS_BYTES, stream);
    if (e != hipSuccess) fprintf(stderr, "cooperative launch failed: %s (grid %d)\n", hipGetErrorString(e), grid_blocks);
}
```
